# Optimizing an MI355X kernel written in HIP

```python
import jax, jax.numpy as jnp
from jax import lax
import numpy as np

D_MODEL = 1024
BATCH = 4
SEQ = 8192
DEPTH = 4
DEC_BATCH = 16
DEC_SEQ = 32
PAST_LEN = 2048

CHUNK = 64
N_EVEN = (DEPTH + 1) // 2
N_ODD = DEPTH // 2
EPS = 1e-6

A_CHUNK = 128
A_GROUPS = 4
A_WIDTH = D_MODEL
A_GROUP_DIM = A_WIDTH // A_GROUPS
B_HEAD_DIM = 64
B_WIDTH = D_MODEL
B_HEADS = B_WIDTH // B_HEAD_DIM
B_GROUPS = 2
B_STATE = 128
B_CONV = 4
B_CONV_DIM = B_WIDTH + 2 * B_GROUPS * B_STATE
SSD_BLOCK = 128
C_HEADS = 8
C_HEAD_DIM = D_MODEL // C_HEADS
C_WIDTH = C_HEADS * C_HEAD_DIM
Q_BLOCK = 128

EVEN_IN = 3 * A_WIDTH + B_WIDTH + B_CONV_DIM + B_HEADS
EVEN_SPLITS = (A_WIDTH, 2 * A_WIDTH, 3 * A_WIDTH, 3 * A_WIDTH + B_WIDTH, 3 * A_WIDTH + B_WIDTH + B_CONV_DIM)
ODD_IN = 4 * C_WIDTH + C_HEADS
ODD_SPLITS = (C_WIDTH, 2 * C_WIDTH, 3 * C_WIDTH, 4 * C_WIDTH)

kernel_name = "hybrid_stream_gmlp_ssd_fox_step"


def rmsnorm(x, g):
    xf = x.astype(jnp.float32)
    y = xf * lax.rsqrt(jnp.mean(xf * xf, axis=-1, keepdims=True) + EPS) * g.astype(jnp.float32)
    return y.astype(x.dtype)


def causal_dwconv(x, ctx, w, b):
    L = x.shape[1]
    xp = jnp.concatenate([ctx.astype(x.dtype), x], axis=1)
    y = b.astype(x.dtype) + sum(xp[:, k:k + L] * w[:, k].astype(x.dtype) for k in range(B_CONV))
    return y, xp[:, xp.shape[1] - (B_CONV - 1):]


def gmlp_branch(u, v, z, ws, bs, gv):
    b, L, _ = u.shape
    u = jax.nn.gelu(u, approximate=False)
    v = rmsnorm(jax.nn.gelu(v, approximate=False).reshape(b, L, A_GROUPS, A_GROUP_DIM), gv)
    n = min(L, A_CHUNK)
    nc = L // n
    pos = jnp.arange(n)
    mask = (pos[None, :] // CHUNK) <= (pos[:, None] // CHUNK)
    w = jnp.where(mask[None], ws[:, :n, :n], 0.0).astype(v.dtype)
    s = jnp.einsum('gij,bcjgk->bcigk', w, v.reshape(b, nc, n, A_GROUPS, A_GROUP_DIM))
    s = s + bs[:, :n].T[None, None, :, :, None].astype(s.dtype)
    s = s.reshape(b, L, A_WIDTH)
    return jax.nn.silu(z) * u * s, v.reshape(b, L, A_WIDTH)


def ssd_scan(x, dt, a, bm, cm, s0, blk):
    b, L, H, P = x.shape
    G, N = bm.shape[2], bm.shape[3]
    R = H // G
    nb = L // blk
    x = x.reshape(b, nb, blk, G, R, P)
    dt = dt.reshape(b, nb, blk, G, R)
    acs = jnp.cumsum(dt * a.reshape(G, R), axis=2)
    bm = bm.reshape(b, nb, blk, G, N)
    cm = cm.reshape(b, nb, blk, G, N)
    dtx = dt[..., None] * x
    causal = jnp.tril(jnp.ones((blk, blk), dtype=bool))
    seg = acs[:, :, :, None] - acs[:, :, None, :]
    decay = jnp.exp(jnp.where(causal[:, :, None, None], seg, -jnp.inf))
    cb = jnp.einsum('bclgn,bcsgn->bclsg', cm, bm)
    y_intra = jnp.einsum('bclsg,bclsgr,bcsgrp->bclgrp', cb, decay, dtx)
    to_end = jnp.exp(acs[:, :, -1:] - acs)
    ds = jnp.einsum('bclgr,bclgrp,bclgn->bcgrpn', to_end, dtx, bm)
    blk_decay = jnp.exp(acs[:, :, -1])

    def step(s, inp):
        ds_c, dec_c = inp
        return dec_c[..., None, None] * s + ds_c, s

    s_fin, s_prev = lax.scan(step, s0.reshape(b, G, R, P, N),
                             (jnp.moveaxis(ds, 1, 0), jnp.moveaxis(blk_decay, 1, 0)))
    s_prev = jnp.moveaxis(s_prev, 0, 1)
    y_state = jnp.einsum('bclgn,bcgrpn,bclgr->bclgrp', cm, s_prev, jnp.exp(acs))
    return (y_intra + y_state).reshape(b, L, H, P), s_fin.reshape(b, H, P, N)


def ssd_branch(zb, xbc, dt_raw, conv_ctx, s0, conv_w, conv_b, dt_bias, a_log, d_skip, g_ssd):
    b, L, _ = xbc.shape
    xbc, new_ctx = causal_dwconv(xbc, conv_ctx, conv_w, conv_b)
    xbc = jax.nn.silu(xbc).astype(jnp.float32)
    xs = xbc[..., :B_WIDTH].reshape(b, L, B_HEADS, B_HEAD_DIM)
    bm = xbc[..., B_WIDTH:B_WIDTH + B_GROUPS * B_STATE].reshape(b, L, B_GROUPS, B_STATE)
    cm = xbc[..., B_WIDTH + B_GROUPS * B_STATE:].reshape(b, L, B_GROUPS, B_STATE)
    dt = jax.nn.softplus(dt_raw.astype(jnp.float32) + dt_bias.astype(jnp.float32))
    a = -jnp.exp(a_log.astype(jnp.float32))
    blk = SSD_BLOCK if L % SSD_BLOCK == 0 else L
    y, s_fin = ssd_scan(xs, dt, a, bm, cm, s0.astype(jnp.float32), blk)
    y = y + d_skip.astype(jnp.float32)[:, None] * xs
    y = y.reshape(b, L, B_WIDTH) * jax.nn.silu(zb.astype(jnp.float32))
    y = rmsnorm(y.reshape(b, L, B_GROUPS, B_WIDTH // B_GROUPS),
                g_ssd.reshape(B_GROUPS, B_WIDTH // B_GROUPS)).reshape(b, L, B_WIDTH)
    return y.astype(zb.dtype), s_fin, new_ctx


def fox_branch(q, k, v, z, f_logit, past_k, past_v, past_logf, gq, gk):
    b, L, _ = q.shape
    q = rmsnorm(q.reshape(b, L, C_HEADS, C_HEAD_DIM), gq)
    k = rmsnorm(k.reshape(b, L, C_HEADS, C_HEAD_DIM), gk)
    v = v.reshape(b, L, C_HEADS, C_HEAD_DIM)
    logf = jax.nn.log_sigmoid(f_logit.astype(jnp.float32))
    p0 = past_k.shape[1]
    k_all = jnp.concatenate([past_k.astype(k.dtype), k], axis=1)
    v_all = jnp.concatenate([past_v.astype(v.dtype), v], axis=1)
    f_cum = jnp.cumsum(jnp.concatenate([past_logf.astype(jnp.float32), logf], axis=1), axis=1)
    f_k = jnp.moveaxis(f_cum, 2, 1)
    key_pos = jnp.arange(p0 + L)
    q_pos = p0 + jnp.arange(L)
    qb = Q_BLOCK if L % Q_BLOCK == 0 else L
    nb = L // qb
    scale = C_HEAD_DIM ** -0.5

    def attend(args):
        q_blk, fq_blk, pos_blk = args
        s = jnp.einsum('blhd,bshd->bhls', q_blk, k_all).astype(jnp.float32) * scale
        s = s + jnp.moveaxis(fq_blk, 2, 1)[..., None] - f_k[:, :, None, :]
        s = jnp.where(key_pos[None, :] <= pos_blk[:, None], s, -jnp.inf)
        p = jax.nn.softmax(s, axis=-1).astype(v_all.dtype)
        return jnp.einsum('bhls,bshd->blhd', p, v_all)

    out = lax.map(attend, (jnp.moveaxis(q.reshape(b, nb, qb, C_HEADS, C_HEAD_DIM), 1, 0),
                           jnp.moveaxis(f_cum[:, p0:].reshape(b, nb, qb, C_HEADS), 1, 0),
                           q_pos.reshape(nb, qb)))
    out = jnp.moveaxis(out, 0, 1).reshape(b, L, C_WIDTH)
    return jax.nn.silu(z) * out, k, v, logf


def even_layer(x, g_pre, g_post, w_in, w_out, ws, bs, gv, conv_w, conv_b, dt_bias, a_log, d_skip, g_ssd,
               conv_ctx, s0):
    h = rmsnorm(x, g_pre)
    proj = jnp.einsum('bld,de->ble', h, w_in)
    u, v, za, zb, xbc, dt_raw = jnp.split(proj, EVEN_SPLITS, axis=-1)
    ya, v_rows = gmlp_branch(u, v, za, ws, bs, gv)
    yb, s_fin, new_ctx = ssd_branch(zb, xbc, dt_raw, conv_ctx, s0, conv_w, conv_b, dt_bias, a_log, d_skip, g_ssd)
    o = jnp.einsum('ble,ed->bld', jnp.concatenate([ya, yb.astype(ya.dtype)], axis=-1), w_out)
    return x + rmsnorm(o, g_post), v_rows, s_fin, new_ctx


def odd_layer(x, g_pre, g_post, w_in, b_f, w_out, gq, gk, past_k, past_v, past_logf):
    h = rmsnorm(x, g_pre)
    proj = jnp.einsum('bld,de->ble', h, w_in)
    q, k, v, z, f_logit = jnp.split(proj, ODD_SPLITS, axis=-1)
    yc, k_rows, v_rows, logf_rows = fox_branch(q, k, v, z, f_logit + b_f.astype(f_logit.dtype),
                                               past_k, past_v, past_logf, gq, gk)
    o = jnp.einsum('ble,ed->bld', yc, w_out)
    return x + rmsnorm(o, g_post), k_rows, v_rows, logf_rows


def setup_inputs(seed: int = 0) -> dict:
    key = jax.random.key(seed)
    ks = jax.random.split(key, 32)
    f32 = jnp.float32
    nrm = lambda k, shape, s=1.0: s * jax.random.normal(k, shape, f32)
    dt0 = jnp.exp(jax.random.uniform(ks[0], (N_EVEN, B_HEADS), f32) * (np.log(0.1) - np.log(0.001)) + np.log(0.001))
    return {
        "x_prompt": nrm(ks[1], (BATCH, SEQ, D_MODEL)),
        "x_sample": nrm(ks[2], (DEC_BATCH, DEC_SEQ, D_MODEL)),
        "cache_fox_k": nrm(ks[3], (N_ODD, DEC_BATCH, PAST_LEN, C_HEADS, C_HEAD_DIM)),
        "cache_fox_v": nrm(ks[4], (N_ODD, DEC_BATCH, PAST_LEN, C_HEADS, C_HEAD_DIM)),
        "cache_fox_logf": jax.nn.log_sigmoid(2.0 + nrm(ks[5], (N_ODD, DEC_BATCH, PAST_LEN, C_HEADS), 0.5)),
        "state_ssd": nrm(ks[6], (N_EVEN, DEC_BATCH, B_HEADS, B_HEAD_DIM, B_STATE), 0.1),
        "state_conv": nrm(ks[7], (N_EVEN, DEC_BATCH, B_CONV - 1, B_CONV_DIM)),
        "norm_pre": 1.0 + nrm(ks[8], (DEPTH, D_MODEL), 0.1),
        "norm_post": 1.0 + nrm(ks[9], (DEPTH, D_MODEL), 0.1),
        "w_in_even": nrm(ks[10], (N_EVEN, D_MODEL, EVEN_IN), D_MODEL ** -0.5),
        "w_out_even": nrm(ks[11], (N_EVEN, A_WIDTH + B_WIDTH, D_MODEL), (A_WIDTH + B_WIDTH) ** -0.5),
        "gmlp_ws": nrm(ks[12], (N_EVEN, A_GROUPS, A_CHUNK, A_CHUNK), A_CHUNK ** -0.5),
        "gmlp_bs": 1.0 + nrm(ks[13], (N_EVEN, A_GROUPS, A_CHUNK), 0.1),
        "gmlp_gv": 1.0 + nrm(ks[14], (N_EVEN, A_GROUPS, A_GROUP_DIM), 0.1),
        "ssd_conv_w": nrm(ks[15], (N_EVEN, B_CONV_DIM, B_CONV), B_CONV ** -0.5),
        "ssd_conv_b": nrm(ks[16], (N_EVEN, B_CONV_DIM), 0.01),
        "ssd_dt_bias": dt0 + jnp.log(-jnp.expm1(-dt0)),
        "ssd_a_log": jnp.log(jax.random.uniform(ks[17], (N_EVEN, B_HEADS), f32, 1.0, 16.0)),
        "ssd_d": 1.0 + nrm(ks[18], (N_EVEN, B_HEADS), 0.1),
        "ssd_norm_g": 1.0 + nrm(ks[19], (N_EVEN, B_WIDTH), 0.1),
        "w_in_odd": nrm(ks[20], (N_ODD, D_MODEL, ODD_IN), D_MODEL ** -0.5),
        "fox_b_forget": 2.0 + nrm(ks[21], (N_ODD, C_HEADS), 0.5),
        "w_out_odd": nrm(ks[22], (N_ODD, C_WIDTH, D_MODEL), C_WIDTH ** -0.5),
        "fox_gq": 1.0 + nrm(ks[23], (N_ODD, C_HEAD_DIM), 0.1),
        "fox_gk": 1.0 + nrm(ks[24], (N_ODD, C_HEAD_DIM), 0.1),
    }


def reference(x_prompt, x_sample, cache_fox_k, cache_fox_v, cache_fox_logf, state_ssd, state_conv,
              norm_pre, norm_post, w_in_even, w_out_even, gmlp_ws, gmlp_bs, gmlp_gv,
              ssd_conv_w, ssd_conv_b, ssd_dt_bias, ssd_a_log, ssd_d, ssd_norm_g,
              w_in_odd, fox_b_forget, w_out_odd, fox_gq, fox_gk):
    xp, xs = x_prompt, x_sample
    bp = xp.shape[0]
    kp_l, vp_l, lp_l, sp_l, cp_l = [], [], [], [], []
    ks_l, vs_l, ls_l, ss_l, cs_l, gs_l = [], [], [], [], [], []
    for i in range(DEPTH):
        j = i // 2
        if i % 2 == 0:
            ew = (w_in_even[j], w_out_even[j], gmlp_ws[j], gmlp_bs[j], gmlp_gv[j], ssd_conv_w[j], ssd_conv_b[j],
                  ssd_dt_bias[j], ssd_a_log[j], ssd_d[j], ssd_norm_g[j])
            xp, _, sp, cp = even_layer(xp, norm_pre[i], norm_post[i], *ew,
                                       jnp.zeros((bp, B_CONV - 1, B_CONV_DIM), xp.dtype),
                                       jnp.zeros((bp, B_HEADS, B_HEAD_DIM, B_STATE), jnp.float32))
            xs, gv_s, ss, cs = even_layer(xs, norm_pre[i], norm_post[i], *ew, state_conv[j], state_ssd[j])
            sp_l.append(sp); cp_l.append(cp)
            ss_l.append(ss); cs_l.append(cs); gs_l.append(gv_s)
        else:
            ow = (w_in_odd[j], fox_b_forget[j], w_out_odd[j], fox_gq[j], fox_gk[j])
            xp, kp, vp, lp = odd_layer(xp, norm_pre[i], norm_post[i], *ow,
                                       jnp.zeros((bp, 0, C_HEADS, C_HEAD_DIM), xp.dtype),
                                       jnp.zeros((bp, 0, C_HEADS, C_HEAD_DIM), xp.dtype),
                                       jnp.zeros((bp, 0, C_HEADS), jnp.float32))
            xs, ksr, vsr, lsr = odd_layer(xs, norm_pre[i], norm_post[i], *ow,
                                          cache_fox_k[j], cache_fox_v[j], cache_fox_logf[j])
            kp_l.append(kp); vp_l.append(vp); lp_l.append(lp)
            ks_l.append(ksr); vs_l.append(vsr); ls_l.append(lsr)
    fox_k_prompt = jnp.stack(kp_l)
    fox_v_prompt = jnp.stack(vp_l)
    fox_logf_prompt = jnp.stack(lp_l)
    ssd_state_prompt = jnp.stack(sp_l)
    conv_state_prompt = jnp.stack(cp_l)
    fox_k_sample = jnp.stack(ks_l)
    fox_v_sample = jnp.stack(vs_l)
    fox_logf_sample = jnp.stack(ls_l)
    ssd_state_sample = jnp.stack(ss_l)
    conv_state_sample = jnp.stack(cs_l)
    gmlp_v_sample = jnp.stack(gs_l)
    return (xp, xs, fox_k_prompt, fox_v_prompt, fox_logf_prompt, ssd_state_prompt, conv_state_prompt,
            fox_k_sample, fox_v_sample, fox_logf_sample, ssd_state_sample, conv_state_sample, gmlp_v_sample)
```

```cpp
#include <hip/hip_runtime.h>
#include <hip/hip_cooperative_groups.h>
#include <hip/hip_bf16.h>
#include <cstdio>
#include <cstdint>
namespace cg = cooperative_groups;

constexpr int DM = 1024, NB = 4, SEQ = 8192, NSB = 16, SSEQ = 32, PAST = 2048;
constexpr int TP = NB * SEQ, TS = NSB * SSEQ, TT = TP + TS;
constexpr int EVEN_IN = 5648, EVEN_N = 5632, EVEN_NP = 5888;
constexpr int ODD_IN = 4104, ODD_N = 4096, ODD_NP = 4352;
constexpr int CONV_DIM = 1536, SKS = PAST + 64;
constexpr float EPS = 1e-6f;

constexpr size_t O_YP = 0;
constexpr size_t O_YS = O_YP + (size_t)TP * DM;
constexpr size_t O_KP = O_YS + (size_t)TS * DM;
constexpr size_t O_VP = O_KP + (size_t)2 * TP * DM;
constexpr size_t O_LP = O_VP + (size_t)2 * TP * DM;
constexpr size_t O_SP = O_LP + (size_t)2 * TP * 8;
constexpr size_t O_CP = O_SP + (size_t)2 * NB * 16 * 64 * 128;
constexpr size_t O_KS = O_CP + (size_t)2 * NB * 3 * CONV_DIM;
constexpr size_t O_VS = O_KS + (size_t)2 * TS * DM;
constexpr size_t O_LS = O_VS + (size_t)2 * TS * DM;
constexpr size_t O_SS = O_LS + (size_t)2 * TS * 8;
constexpr size_t O_CS = O_SS + (size_t)2 * NSB * 16 * 64 * 128;
constexpr size_t O_GV = O_CS + (size_t)2 * NSB * 3 * CONV_DIM;
constexpr size_t O_END = O_GV + (size_t)2 * TS * DM;

constexpr size_t MiB = 1u << 20;
constexpr size_t WS_WINE = 0, WS_WOUTE = 24 * MiB, WS_WINO = 32 * MiB, WS_WOUTO = 50 * MiB;
constexpr size_t WS_DTRAW = 54 * MiB, WS_FLOG = 57 * MiB, WS_NFP = 59 * MiB, WS_NFS = 60 * MiB;
constexpr size_t WS_BAR = 61 * MiB + 512 * 1024;
constexpr size_t WS_KMAX = WS_BAR + 32768;
constexpr size_t WS_H = 62 * MiB, WS_O = 127 * MiB, WS_CAT = 192 * MiB, WS_ACT = 322 * MiB, WS_Y = 420 * MiB;
constexpr size_t WS_KS = 322 * MiB, WS_VS = 388 * MiB;
constexpr size_t WS_PROJ = 485 * MiB, WS_RES = 843 * MiB, WS_END = 908 * MiB;
static_assert((size_t)2 * EVEN_NP * 1024 * 2 <= 24 * MiB && (size_t)2 * ODD_NP * 1024 * 2 <= 18 * MiB, "weights");
static_assert((size_t)TT * 16 * 4 <= 3 * MiB && (size_t)TT * 8 * 4 <= 2 * MiB && (size_t)128 * SKS * 4 <= 2 * MiB, "small");
static_assert((size_t)TT * 1024 * 2 <= 65 * MiB && (size_t)TT * 1536 * 2 <= 98 * MiB && (size_t)NSB * SKS * 1024 * 2 <= 66 * MiB, "act");
static_assert((size_t)TT * EVEN_N * 2 <= 358 * MiB, "proj");

constexpr int LDS_BYTES = 131072 + 1024 + 8192 + 1024;

typedef unsigned short bf16;
typedef float f32x4 __attribute__((ext_vector_type(4)));
typedef float f32x2 __attribute__((ext_vector_type(2)));
typedef float f32x16 __attribute__((ext_vector_type(16)));
typedef unsigned u32x4 __attribute__((ext_vector_type(4)));
typedef unsigned u32x2 __attribute__((ext_vector_type(2)));
typedef short bf16x8 __attribute__((ext_vector_type(8)));
typedef short s16x4 __attribute__((ext_vector_type(4)));

__device__ __forceinline__ float bf2f(unsigned b) { return __uint_as_float(b << 16); }
__device__ __forceinline__ float bflo(unsigned w) { return __uint_as_float(w << 16); }
__device__ __forceinline__ float bfhi(unsigned w) { return __uint_as_float(w & 0xffff0000u); }
typedef __bf16 bf16x2_t __attribute__((ext_vector_type(2)));
__device__ __forceinline__ unsigned cvtpk(float lo, float hi) { const f32x2 v = {lo, hi}; const bf16x2_t b = __builtin_convertvector(v, bf16x2_t); return __builtin_bit_cast(unsigned, b); }
__device__ __forceinline__ float wave_sum(float v) {
#pragma unroll
    for (int o = 1; o < 64; o <<= 1) v += __shfl_xor(v, o);
    return v;
}
__device__ __forceinline__ float silu_f(float x) { return x * __builtin_amdgcn_rcpf(1.f + __expf(-x)); }
__device__ __forceinline__ float softplus_f(float x) { return x > 20.f ? x : log1pf(__expf(x)); }
__device__ __forceinline__ float logsigmoid_f(float x) { return fminf(x, 0.f) - log1pf(__expf(-fabsf(x))); }
__device__ __forceinline__ void unpack8(u32x4 w, float* f) {
    f[0] = bflo(w.x); f[1] = bfhi(w.x); f[2] = bflo(w.y); f[3] = bfhi(w.y); f[4] = bflo(w.z); f[5] = bfhi(w.z); f[6] = bflo(w.w); f[7] = bfhi(w.w);
}
__device__ __forceinline__ u32x4 pack8f(const float* f) { u32x4 w; w.x = cvtpk(f[0], f[1]); w.y = cvtpk(f[2], f[3]); w.z = cvtpk(f[4], f[5]); w.w = cvtpk(f[6], f[7]); return w; }

__device__ __forceinline__ int tid_of(int wv) { asm volatile("" : "+s"(wv)); int l; asm volatile("v_mbcnt_lo_u32_b32 %0, -1, 0\n\tv_mbcnt_hi_u32_b32 %0, -1, %0" : "=v"(l)); int t = (wv << 6) | l; asm volatile("" : "+v"(t)); return t; }
__device__ __forceinline__ int bid_here() { int b = blockIdx.x; asm volatile("" : "+s"(b)); return b; }
__device__ __forceinline__ int vcu_here() { const int b = bid_here(), G = (int)gridDim.x; return (G % 8 == 0) ? (b % 8) * (G / 8) + b / 8 : b; }
namespace pg8 {
#define PG8_LAS __attribute__((address_space(3)))
typedef unsigned short bf16_t;
typedef short bf16x8 __attribute__((ext_vector_type(8)));
typedef float f32x4 __attribute__((ext_vector_type(4)));
typedef unsigned u32x4 __attribute__((ext_vector_type(4)));
constexpr int BM = 256, BK = 64, HALF = 128, HTB = HALF * BK * 2  , STAGE_BYTES = 8 * HTB, NXCD = 8, WGM = 8;

__host__ __device__ __forceinline__ int lds_byte(int r, int c) { const int st = (r >> 4) * 2 + (c >> 5), rr = r & 15, cc = c & 31, ob = rr * 64 + cc * 2; return st * 1024 + (ob ^ (((ob >> 9) & 1) << 5)); }
__host__ __device__ __forceinline__ void stage_rc(int b, int& R, int& C) { const int st = b / 1024, sb = b % 1024, swz = sb ^ (((sb >> 9) & 1) << 5); R = (st >> 1) * 16 + swz / 64; C = (st & 1) * 32 + (swz % 64) / 2; }
__host__ __device__ __forceinline__ int perm32(int rho) { const int n = rho >> 4, i = rho & 15; return 8 * (i >> 2) + 4 * n + (i & 3); }

struct Unit { int pm, pn; };
struct Gemm { const bf16_t* A; const bf16_t* Bt; int M, N, K; };

struct StaticOrder {
    int nM, nN, nwg, G, c;
    __host__ __device__ void init(int M, int N, int G_, int c_) { nM = M / BM; nN = N / BM; nwg = nM * nN; G = G_; c = c_; }
    __host__ __device__ bool next(int i, Unit& u) const {
        const long L = (long)i * G + c; if (L >= nwg) return false;
        int wgid = (int)L; { const int q = nwg / NXCD, r = nwg % NXCD, xcd = wgid % NXCD, off = wgid / NXCD; wgid = (xcd < r ? xcd * (q + 1) : r * (q + 1) + (xcd - r) * q) + off; }
        const int nig = WGM * nN, gid = wgid / nig, fm = gid * WGM, gsz = (nM - fm) < WGM ? (nM - fm) : WGM;
        u.pm = fm + ((wgid % nig) % gsz); u.pn = (wgid % nig) / gsz; return true;
    }
    __device__ __forceinline__ void a_ready(const Unit&) const {}
    __device__ __forceinline__ void done(const Unit&) const {}
};

__device__ __forceinline__ unsigned cvt_pk_bf16(float lo, float hi) { unsigned r; asm volatile("v_cvt_pk_bf16_f32 %0, %1, %2" : "=v"(r) : "v"(lo), "v"(hi)); return r; }
typedef float f32x2 __attribute__((ext_vector_type(2)));
__device__ __forceinline__ f32x2 gelu_pk(f32x2 v) {
    const f32x2 av = __builtin_elementwise_abs(v), d = av * 0.2316418882f + 1.0f;
    f32x2 t; t.x = __builtin_amdgcn_rcpf(d.x); t.y = __builtin_amdgcn_rcpf(d.y);
    f32x2 q = t * 0.5307027145f + (-0.7265760135f); q = q * t + 0.7107068705f; q = q * t + (-0.142248368f); q = q * t + 0.127414796f; q = q * t;
    const f32x2 s = (v * v) * (-0.72134752044f);
    f32x2 e; e.x = __builtin_amdgcn_exp2f(s.x); e.y = __builtin_amdgcn_exp2f(s.y);
    const f32x2 m = v * (q * e), r = v - m;
    f32x2 o; o.x = v.x < 0.f ? m.x : r.x; o.y = v.y < 0.f ? m.y : r.y; return o;
}
template <class Epi, class Sched, bool ALIGN_EPI = false, bool SP2 = false>
__device__ __forceinline__ void gemm_phase(PG8_LAS unsigned char* lds, const Gemm g, const Sched& S, const Epi& E, const int wv_in) {
    const int tid = tid_of(wv_in), wid = __builtin_amdgcn_readfirstlane(tid >> 6), lane = tid & 63, wr = wid >> 2, wc = wid & 3, fr = lane & 15, fq = lane >> 4;
    const int K = g.K, nt = K / BK;
    unsigned voffA[2], voffB[2];
#pragma unroll
    for (int i = 0; i < 2; ++i) { int R, C; stage_rc(tid * 16 + i * 8192, R, C); const int Rb = Epi::PERM ? ((R & ~31) + perm32(R & 31)) : R;
        voffA[i] = (unsigned)(R * K + C) * 2u; voffB[i] = (unsigned)(Rb * K + C) * 2u; }
    const size_t kstep = (size_t)(BK * 2);
    const size_t hstep = (size_t)HALF * K * 2;
    const size_t tstep = 2 * hstep;
    const unsigned ldsw = (unsigned)wid * 1024u;
    const int aoff = lds_byte(wr * 64 + fr, fq * 8), boff = lds_byte(wc * 32 + fr, fq * 8);
#define PG8_SA(b, h) (((b) * 2 + (h)) * HTB)
#define PG8_SB(b, h) ((4 + (b) * 2 + (h)) * HTB)
#define PG8_STAGE(bufoff, gbase, voff) do { _Pragma("unroll") for (int _i = 0; _i < 2; ++_i) \
        __builtin_amdgcn_global_load_lds((const unsigned*)((const char*)(gbase) + (voff)[_i]), (PG8_LAS unsigned*)(lds + (bufoff) + ldsw + _i * 8192), 16, 0, 0); } while (0)
#define PG8_LDA(dst, b, h) do { _Pragma("unroll") for (int m = 0; m < 4; ++m) _Pragma("unroll") for (int k = 0; k < 2; ++k) dst[m][k] = *(const PG8_LAS bf16x8*)(lds + PG8_SA(b, h) + aoff + m * 2048 + k * 1024); } while (0)
#define PG8_LDB(dst, b, h) do { _Pragma("unroll") for (int n = 0; n < 2; ++n) _Pragma("unroll") for (int k = 0; k < 2; ++k) dst[n][k] = *(const PG8_LAS bf16x8*)(lds + PG8_SB(b, h) + boff + n * 2048 + k * 1024); } while (0)
#define PG8_MMA(ai, bj, At, Bt) do { __builtin_amdgcn_s_setprio(1); _Pragma("unroll") for (int m = 0; m < 4; ++m) _Pragma("unroll") for (int n = 0; n < 2; ++n) _Pragma("unroll") for (int k = 0; k < 2; ++k) \
        acc[ai][bj][m][n] = __builtin_amdgcn_mfma_f32_16x16x32_bf16(Bt[n][k], At[m][k], acc[ai][bj][m][n], 0, 0, 0); __builtin_amdgcn_s_setprio(0); } while (0)
#define PG8_WAIT_V(n) asm volatile("s_waitcnt vmcnt(" #n ")" ::: "memory")
#define PG8_WAIT_L(n) asm volatile("s_waitcnt lgkmcnt(" #n ")" ::: "memory")
#define PG8_BAR __builtin_amdgcn_s_barrier()
#define PG8_SCHED __builtin_amdgcn_sched_barrier(0)
    Unit cur, nxt; int ui = 0;
    if (!S.next(0, cur)) return;
    f32x4 acc[2][2][4][2];
#pragma unroll
    for (int a = 0; a < 2; ++a)
#pragma unroll
        for (int b = 0; b < 2; ++b)
#pragma unroll
            for (int m = 0; m < 4; ++m)
#pragma unroll
                for (int n = 0; n < 2; ++n) acc[a][b][m][n] = (f32x4){0.f, 0.f, 0.f, 0.f};
    bf16x8 At[4][2], B0[2][2], B1[2][2];
    const char* cA = (const char*)g.A + (size_t)cur.pm * tstep; const char* cB = (const char*)g.Bt + (size_t)cur.pn * tstep;
    S.a_ready(cur);
    if constexpr (SP2) {
        PG8_STAGE(PG8_SB(0, 0), cB, voffB); PG8_STAGE(PG8_SB(0, 1), cB + hstep, voffB); PG8_STAGE(PG8_SA(0, 0), cA, voffA); PG8_STAGE(PG8_SA(0, 1), cA + hstep, voffA);
        if (wr == 1) PG8_BAR;
        PG8_WAIT_V(2); PG8_BAR;
        PG8_STAGE(PG8_SB(1, 0), cB + kstep, voffB); PG8_STAGE(PG8_SA(1, 0), cA + kstep, voffA); PG8_STAGE(PG8_SB(1, 1), cB + hstep + kstep, voffB);
        PG8_WAIT_V(6); PG8_BAR;
    } else {
        PG8_STAGE(PG8_SB(0, 0), cB, voffB); PG8_STAGE(PG8_SA(0, 0), cA, voffA); PG8_STAGE(PG8_SB(0, 1), cB + hstep, voffB); PG8_STAGE(PG8_SA(0, 1), cA + hstep, voffA);
        if (wr == 1) PG8_BAR;
        PG8_WAIT_V(4); PG8_BAR;
        PG8_STAGE(PG8_SB(1, 0), cB + kstep, voffB); PG8_STAGE(PG8_SA(1, 0), cA + kstep, voffA); PG8_STAGE(PG8_SB(1, 1), cB + hstep + kstep, voffB);
        PG8_WAIT_V(6); PG8_BAR;
    }
    for (;;) {
        const bool has_next = S.next(ui + 1, nxt);
        const char* nA = has_next ? (const char*)g.A + (size_t)nxt.pm * tstep : cA; const char* nB = has_next ? (const char*)g.Bt + (size_t)nxt.pn * tstep : cB;
        for (int t = 0; t < nt; t += 2) {
            const bool last = (t == nt - 2);
            const char* a1 = cA + (size_t)(t + 1) * kstep;
            const char* a2 = last ? nA : cA + (size_t)(t + 2) * kstep; const char* b2 = last ? nB : cB + (size_t)(t + 2) * kstep;
            const char* a3 = a2 + kstep; const char* b3 = b2 + kstep;
            if (last && has_next) S.a_ready(nxt);
            if constexpr (SP2) {
            PG8_LDB(B0, 0, 0); PG8_LDB(B1, 0, 1); PG8_SCHED; PG8_LDA(At, 0, 0); PG8_STAGE(PG8_SA(1, 1), a1 + hstep, voffA);
            PG8_WAIT_V(8); PG8_WAIT_L(0); PG8_BAR; PG8_MMA(0, 0, At, B0); PG8_MMA(0, 1, At, B1); PG8_BAR; PG8_SCHED;
            PG8_LDA(At, 0, 1); PG8_STAGE(PG8_SB(0, 0), b2, voffB); PG8_STAGE(PG8_SB(0, 1), b2 + hstep, voffB); PG8_STAGE(PG8_SA(0, 0), a2, voffA);
            PG8_WAIT_V(8); PG8_WAIT_L(0); PG8_BAR; PG8_MMA(1, 0, At, B0); PG8_MMA(1, 1, At, B1); PG8_BAR; PG8_SCHED;
            PG8_LDB(B0, 1, 0); PG8_LDB(B1, 1, 1); PG8_SCHED; PG8_LDA(At, 1, 0); PG8_STAGE(PG8_SA(0, 1), a2 + hstep, voffA);
            PG8_WAIT_V(8); PG8_WAIT_L(0); PG8_BAR; PG8_MMA(0, 0, At, B0); PG8_MMA(0, 1, At, B1); PG8_BAR; PG8_SCHED;
            PG8_LDA(At, 1, 1); PG8_STAGE(PG8_SB(1, 0), b3, voffB); PG8_STAGE(PG8_SB(1, 1), b3 + hstep, voffB); PG8_STAGE(PG8_SA(1, 0), a3, voffA);
            PG8_WAIT_V(8); PG8_WAIT_L(0); PG8_BAR; PG8_MMA(1, 0, At, B0); PG8_MMA(1, 1, At, B1); PG8_BAR; PG8_SCHED;
            } else {
            PG8_LDB(B0, 0, 0); PG8_SCHED; PG8_LDA(At, 0, 0); PG8_STAGE(PG8_SA(1, 1), a1 + hstep, voffA);
            PG8_WAIT_L(8); PG8_BAR; PG8_WAIT_L(0); PG8_MMA(0, 0, At, B0); PG8_BAR; PG8_SCHED;
            PG8_LDB(B1, 0, 1); PG8_STAGE(PG8_SB(0, 0), b2, voffB);
            PG8_BAR; PG8_WAIT_L(0); PG8_MMA(0, 1, At, B1); PG8_BAR;
            PG8_LDA(At, 0, 1); PG8_STAGE(PG8_SA(0, 0), a2, voffA);
            PG8_BAR; PG8_WAIT_L(0); PG8_MMA(1, 0, At, B0); PG8_BAR; PG8_SCHED;
            PG8_STAGE(PG8_SB(0, 1), b2 + hstep, voffB);
            PG8_WAIT_V(6); PG8_BAR; PG8_MMA(1, 1, At, B1); PG8_BAR;
            PG8_LDB(B0, 1, 0); PG8_SCHED; PG8_LDA(At, 1, 0); PG8_STAGE(PG8_SA(0, 1), a2 + hstep, voffA);
            PG8_WAIT_L(8); PG8_BAR; PG8_WAIT_L(0); PG8_MMA(0, 0, At, B0); PG8_BAR; PG8_SCHED;
            PG8_LDB(B1, 1, 1); PG8_STAGE(PG8_SB(1, 0), b3, voffB);
            PG8_BAR; PG8_WAIT_L(0); PG8_MMA(0, 1, At, B1); PG8_BAR;
            PG8_LDA(At, 1, 1); PG8_STAGE(PG8_SA(1, 0), a3, voffA);
            PG8_BAR; PG8_WAIT_L(0); PG8_MMA(1, 0, At, B0); PG8_BAR; PG8_SCHED;
            PG8_STAGE(PG8_SB(1, 1), b3 + hstep, voffB);
            PG8_WAIT_V(6); PG8_BAR; PG8_MMA(1, 1, At, B1); PG8_BAR;
            }
        }
        if constexpr (ALIGN_EPI) { if (wr == 0) PG8_BAR; }
        if constexpr (!Epi::AFTER_DRAIN) { E(acc, cur, wr, wc, fr, fq); S.done(cur); }
        if (!has_next) break;
#pragma unroll
        for (int a = 0; a < 2; ++a)
#pragma unroll
            for (int b = 0; b < 2; ++b)
#pragma unroll
                for (int m = 0; m < 4; ++m)
#pragma unroll
                    for (int n = 0; n < 2; ++n) acc[a][b][m][n] = (f32x4){0.f, 0.f, 0.f, 0.f};
        cur = nxt; cA = nA; cB = nB; ++ui;
        if constexpr (ALIGN_EPI) { if (wr == 1) PG8_BAR; }
    }
    PG8_WAIT_V(0);
    if constexpr (!ALIGN_EPI) { if (wr == 0) PG8_BAR; }
    PG8_BAR;
    if constexpr (Epi::AFTER_DRAIN) { E.fused(acc, cur, wr, wc, fr, fq, lds, wid, lane); S.done(cur); }
#undef PG8_SA
#undef PG8_SB
#undef PG8_STAGE
#undef PG8_LDA
#undef PG8_LDB
#undef PG8_MMA
#undef PG8_WAIT_V
#undef PG8_WAIT_L
#undef PG8_BAR
#undef PG8_SCHED
}
}
namespace fa {
constexpr float SCALE = 0.08838834764831845f;
constexpr float THR = 40.f;
constexpr int D = 128, NW = 8, QBLK = 32, KVBLK = 64, QB = NW * QBLK;
constexpr int SHM_V = KVBLK * D * 2, SHM_K = KVBLK * D * 2;
constexpr int OFF_WS = 2 * SHM_V + 2 * SHM_K, OFF_BIAS = OFF_WS + NW * 64 * 4, FA_LDS = OFF_BIAS + 2 * 64 * 4;
#define KSWZ(row, colB) ((row) * 256 + ((colB) ^ (((row) & 7) << 4)))
#define SBAR() __builtin_amdgcn_sched_barrier(0)
__device__ __forceinline__ int v_st(int k, int c) { const int kk = (k & ~0xC) | ((k & 4) << 1) | ((k & 8) >> 1); return ((kk >> 3) * 4 + (c >> 5)) * 512 + ((kk & 7) * 32 + (c & 31)) * 2; }
__device__ __forceinline__ int v_rd_base(int lane) { return ((lane & 3) << 3) | (((lane >> 2) & 3) << 6) | (((lane >> 4) & 1) << 5) | (((lane >> 5) & 1) << 8); }
constexpr int v_rd_off(int d0, int ks, int half) { return d0 * 512 + ks * 4096 + half * 2048; }
__device__ __forceinline__ int crow(int r, int hi) { return (r & 3) + 8 * (r >> 2) + 4 * hi; }
__device__ __forceinline__ bf16x8 load8(const bf16* p) { return *reinterpret_cast<const bf16x8*>(p); }
__device__ __forceinline__ void mask_tile(f32x16& p0, f32x16& p1, int dq) {
    const float NEG = -__builtin_inff();
#pragma unroll
    for (int r = 0; r < 16; ++r) {
        const int c = (r & 3) + 8 * (r >> 2);
        if (dq - c < 0) p0[r] = NEG;
        if (dq - c - 32 < 0) p1[r] = NEG;
    }
}
__device__ __forceinline__ void partialSM(f32x16& p0, f32x16& p1, float& m_reg, float& mn, float& alpha) {
    float pmax = p0[0];
#pragma unroll
    for (int r = 1; r < 16; ++r) pmax = fmaxf(pmax, p0[r]);
#pragma unroll
    for (int r = 0; r < 16; ++r) pmax = fmaxf(pmax, p1[r]);
    { auto rr = __builtin_amdgcn_permlane32_swap(__float_as_uint(pmax), __float_as_uint(pmax), false, false);
      pmax = fmaxf(__uint_as_float(rr[0]), __uint_as_float(rr[1])); }
    constexpr float C2 = 1.4426950408889634f * SCALE;
    if (__builtin_expect(__all((pmax - m_reg) * SCALE <= THR), 1)) { mn = m_reg; alpha = 1.f; }
    else { mn = fmaxf(m_reg, pmax); alpha = __builtin_amdgcn_exp2f((m_reg - mn) * C2); m_reg = mn; }
    const float mnL = -mn * C2;
#pragma unroll
    for (int r = 0; r < 16; ++r) p0[r] = fmaf(p0[r], C2, mnL);
#pragma unroll
    for (int r = 0; r < 16; ++r) p1[r] = fmaf(p1[r], C2, mnL);
#pragma unroll
    for (int r = 0; r < 16; ++r) p0[r] = __builtin_amdgcn_exp2f(p0[r]);
}
__device__ __forceinline__ void finishSM(f32x16& p0, f32x16& p1, float alpha, float& l_reg, bf16x8& pa0, bf16x8& pa1, bf16x8& pa2, bf16x8& pa3) {
#pragma unroll
    for (int r = 0; r < 16; ++r) p1[r] = __builtin_amdgcn_exp2f(p1[r]);
    float ps = 0;
#pragma unroll
    for (int r = 0; r < 16; ++r) ps += p0[r];
#pragma unroll
    for (int r = 0; r < 16; ++r) ps += p1[r];
    { auto rr = __builtin_amdgcn_permlane32_swap(__float_as_uint(ps), __float_as_uint(ps), false, false);
      ps = __uint_as_float(rr[0]) + __uint_as_float(rr[1]); }
    l_reg = l_reg * alpha + ps;
#define PK4(P, B_, OUT) do { unsigned a0 = cvtpk(P[B_+0], P[B_+1]), a1 = cvtpk(P[B_+2], P[B_+3]);                          \
        unsigned b0 = cvtpk(P[B_+4], P[B_+5]), b1 = cvtpk(P[B_+6], P[B_+7]);                                             \
        auto r0 = __builtin_amdgcn_permlane32_swap(a0, b0, false, false); auto r1 = __builtin_amdgcn_permlane32_swap(a1, b1, false, false); \
        u32x4 w = {r0[0], r1[0], r0[1], r1[1]}; OUT = *reinterpret_cast<bf16x8*>(&w); } while (0)
    PK4(p0, 0, pa0); PK4(p0, 8, pa1); PK4(p1, 0, pa2); PK4(p1, 8, pa3);
#undef PK4
}
template <int KB>
__device__ __forceinline__ void qkt(f32x16& p0, f32x16& p1, const char* K_lds, const float* B_lds, int r32, int hi, const bf16x8* qr) {
    { const float* bp = B_lds + KB * 64 + 4 * hi;
      const f32x4 a0 = *(const f32x4*)(bp), a1 = *(const f32x4*)(bp + 8), a2 = *(const f32x4*)(bp + 16), a3 = *(const f32x4*)(bp + 24);
      const f32x4 c0 = *(const f32x4*)(bp + 32), c1 = *(const f32x4*)(bp + 40), c2 = *(const f32x4*)(bp + 48), c3 = *(const f32x4*)(bp + 56);
      p0 = (f32x16){a0[0], a0[1], a0[2], a0[3], a1[0], a1[1], a1[2], a1[3], a2[0], a2[1], a2[2], a2[3], a3[0], a3[1], a3[2], a3[3]};
      p1 = (f32x16){c0[0], c0[1], c0[2], c0[3], c1[0], c1[1], c1[2], c1[3], c2[0], c2[1], c2[2], c2[3], c3[0], c3[1], c3[2], c3[3]}; }
    const char* kb[4];
#pragma unroll
    for (int dd = 0; dd < 4; ++dd) kb[dd] = K_lds + KB * SHM_K + KSWZ(r32, (dd * 16 + hi * 8) * 2);
#pragma unroll
    for (int d0 = 0; d0 < 8; ++d0) { const char* a = kb[d0 & 3] + (d0 >> 2) * 128;
        bf16x8 b0 = *reinterpret_cast<const bf16x8*>(a);
        bf16x8 b1 = *reinterpret_cast<const bf16x8*>(a + 32 * 256);
        p0 = __builtin_amdgcn_mfma_f32_32x32x16_bf16(b0, qr[d0], p0, 0, 0, 0);
        p1 = __builtin_amdgcn_mfma_f32_32x32x16_bf16(b1, qr[d0], p1, 0, 0, 0); }
}
template <int VB>
__device__ __forceinline__ void pv_tile(f32x16* o, int vb0, bf16x8 pa0, bf16x8 pa1, bf16x8 pa2, bf16x8 pa3) {
#define TRRD(dst, off) asm volatile("ds_read_b64_tr_b16 %0, %1 offset:%2" : "=&v"(dst) : "v"(vb0), "i"(off) : "memory")
#define PV_D0(d0) do { s16x4 l0, l1, l2, l3, h0, h1, h2, h3; constexpr int b_ = VB * SHM_V + v_rd_off(d0, 0, 0); \
        TRRD(l0, b_); TRRD(h0, b_ + 2048); TRRD(l1, b_ + 4096); TRRD(h1, b_ + 6144); TRRD(l2, b_ + 8192); TRRD(h2, b_ + 10240); TRRD(l3, b_ + 12288); TRRD(h3, b_ + 14336); \
        asm volatile("s_waitcnt lgkmcnt(0)" ::: "memory"); SBAR();   \
        o[d0] = __builtin_amdgcn_mfma_f32_32x32x16_bf16(pa0, (bf16x8){l0[0], l0[1], l0[2], l0[3], h0[0], h0[1], h0[2], h0[3]}, o[d0], 0, 0, 0);   \
        o[d0] = __builtin_amdgcn_mfma_f32_32x32x16_bf16(pa1, (bf16x8){l1[0], l1[1], l1[2], l1[3], h1[0], h1[1], h1[2], h1[3]}, o[d0], 0, 0, 0);   \
        o[d0] = __builtin_amdgcn_mfma_f32_32x32x16_bf16(pa2, (bf16x8){l2[0], l2[1], l2[2], l2[3], h2[0], h2[1], h2[2], h2[3]}, o[d0], 0, 0, 0);   \
        o[d0] = __builtin_amdgcn_mfma_f32_32x32x16_bf16(pa3, (bf16x8){l3[0], l3[1], l3[2], l3[3], h3[0], h3[1], h3[2], h3[3]}, o[d0], 0, 0, 0); } while (0)
    PV_D0(0); PV_D0(1); PV_D0(2); PV_D0(3);
#undef PV_D0
#undef TRRD
}
struct BlockRef { const bf16* Q; const bf16* K; const bf16* V; const float* Bias; bf16* O; const bf16* Z; int P0, qpitch, kvpitch, nvalid, skv, canskip; float traw; };
__device__ __forceinline__ int fox_jlo(const BlockRef& r, int lane) { const float traw = r.traw;
    if (!r.canskip) return 0;
    const float bi = r.Bias[r.P0]; const int nt = r.P0 / KVBLK; int cnt = 0;
    for (int t0 = 0; t0 < nt; t0 += 64) { const int t = t0 + lane; const bool c = (t < nt) && (bi - r.Bias[(t < nt ? t : 0) * KVBLK + KVBLK - 1] > traw); cnt += __popcll(__ballot(c)); }
    return __builtin_amdgcn_readfirstlane(cnt);
}
}
struct Params;
template <class PRT> __device__ __forceinline__ fa::BlockRef attn_ref(PRT p, int L, int pass, float traw_p, float qkb, float knew);
namespace fa {
struct Seam { bf16x8 qr[8]; bf16x8 st_v0, st_v1, st_k0, st_k1; float st_b; };
#define VMW() asm volatile("s_waitcnt vmcnt(0)" ::: "memory")
#define VMWN(n) asm volatile("s_waitcnt vmcnt(%0)" :: "i"(n) : "memory")
#define SLOAD_H(Kp, Vp, Bp, pitch, k0) do { const unsigned vo_ = (unsigned)(sr * (pitch) + sc) * 2u; \
        const char* kb_ = (const char*)(Kp) + (size_t)(k0) * (size_t)(pitch) * 2; const char* vb_ = (const char*)(Vp) + (size_t)(k0) * (size_t)(pitch) * 2; const size_t r32_ = (size_t)(pitch) * 64; \
        S.st_v0 = *(const bf16x8*)(vb_ + vo_); S.st_v1 = *(const bf16x8*)(vb_ + r32_ + vo_);              \
        S.st_k0 = *(const bf16x8*)(kb_ + vo_); S.st_k1 = *(const bf16x8*)(kb_ + r32_ + vo_); S.st_b = *(const float*)((const char*)((Bp) + (k0)) + (unsigned)((tid & 63) * 4)); } while (0)
#define SWRITE_HK(bf) do { *(bf16x8*)(K_lds + (bf) * SHM_K + kws) = S.st_k0; *(bf16x8*)(K_lds + (bf) * SHM_K + kws + 32 * 256) = S.st_k1; if (tid < 64) B_lds[(bf) * 64 + tid] = S.st_b; } while (0)
#define SWRITE_HV(bf) do { *(bf16x8*)(V_lds + (bf) * SHM_V + vst0) = S.st_v0; *(bf16x8*)(V_lds + (bf) * SHM_V + vst1) = S.st_v1; } while (0)
#define SWRITE_H(bf) do { SWRITE_HV(bf); SWRITE_HK(bf); } while (0)
#define QLOAD(ref) do { const int qrow_ = wid * QBLK + r32; \
        _Pragma("unroll") for (int d0 = 0; d0 < 8; ++d0) S.qr[d0] = load8((ref).Q + (size_t)qrow_ * (ref).qpitch + d0 * 16 + hi * 8); } while (0)
__device__ __forceinline__ void fox_prime(const BlockRef& cur, char* lds, Seam& S, int wv, int jlo) {
    const int tid = tid_of(wv), wid = __builtin_amdgcn_readfirstlane(tid >> 6), lane = tid & 63, r32 = lane & 31, hi = lane >> 5;
    const int sr = tid >> 4, sc = (tid & 15) * 8, kws = KSWZ(sr, sc * 2); char* K_lds = lds + 2 * SHM_V; float* B_lds = (float*)(lds + OFF_BIAS);
    QLOAD(cur);
    SLOAD_H(cur.K, cur.V, cur.Bias, cur.kvpitch, jlo * KVBLK); VMW(); SWRITE_HK(0);
    __syncthreads();
}
template <class PRT> __device__ __forceinline__ void fox_block(PRT p, int L, int pass, int Ln, int passn, char* lds, Seam& S, int wv, int j_lo, int& jlo_next, float traw, float qkb, float knew) {
    const BlockRef cur = attn_ref<PRT>(p, L, pass, traw, qkb, knew);
    const int tid = tid_of(wv), wid = __builtin_amdgcn_readfirstlane(tid >> 6), lane = tid & 63, r32 = lane & 31, hi = lane >> 5;
    int j_hi = (cur.P0 + QB - 1) / KVBLK + 1; if (j_hi > cur.skv / KVBLK) j_hi = cur.skv / KVBLK;
    const int NT = j_hi - j_lo;
    const int qlo = cur.P0 + wid * QBLK, qm = qlo + r32 - 4 * hi;
    char* V_lds = lds; char* K_lds = lds + 2 * SHM_V;
    float* ws = (float*)(lds + OFF_WS) + wid * 64; float* li_l = ws, * al_l = ws + 32; float* B_lds = (float*)(lds + OFF_BIAS);
    float m_reg = -1e30f, l_reg = 0; f32x16 o[4] = {};
    const int sr = tid >> 4, sc = (tid & 15) * 8, vst0 = v_st(sr, sc), vst1 = v_st(32 + sr, sc), kws = KSWZ(sr, sc * 2);
    const int vb0 = (int)(uintptr_t)V_lds + v_rd_base(lane);
    const bf16* Kh = cur.K; const bf16* Vh = cur.V; const float* Bh = cur.Bias; const int kvp = cur.kvpitch;
#define RESC(a) do { if (__any((a) < 1.f)) { if (hi == 0) al_l[r32] = (a); asm volatile("s_waitcnt lgkmcnt(0)" ::: "memory");              \
                     _Pragma("unroll") for (int d_ = 0; d_ < 4; ++d_) _Pragma("unroll") for (int r = 0; r < 16; ++r) o[d_][r] *= al_l[crow(r, hi)]; } } while (0)
#define KBASE(t) ((j_lo + (t)) * KVBLK)
#define MASKT(P0_, P1_, t) do { const int kb_ = KBASE(t); if (kb_ + KVBLK - 1 > qlo) mask_tile(P0_, P1_, qm - kb_); } while (0)
    f32x16 pA0, pA1, pB0, pB1; float mnA, mnB, alA, alB; bf16x8 pa0, pa1, pa2, pa3;
    SWRITE_HV(0); SBAR();
    if (NT > 1) { SLOAD_H(Kh, Vh, Bh, kvp, KBASE(1)); }
    SBAR(); qkt<0>(pA0, pA1, K_lds, B_lds, r32, hi, S.qr);
    MASKT(pA0, pA1, 0); partialSM(pA0, pA1, m_reg, mnA, alA);
    if (NT > 1) { VMW(); SWRITE_H(1); }
    __syncthreads();
#define HALF_STEP(PX0, PX1, mnX, alX, PY0, PY1, alY, t, KB, VB, SB) do {                                                      \
        SBAR(); qkt<KB>(PX0, PX1, K_lds, B_lds, r32, hi, S.qr);                                             \
        finishSM(PY0, PY1, alY, l_reg, pa0, pa1, pa2, pa3); SBAR();                                                           \
        if ((t) + 1 < NT) { SLOAD_H(Kh, Vh, Bh, kvp, KBASE((t) + 1)); SBAR(); }                                               \
        pv_tile<VB>(o, vb0, pa0, pa1, pa2, pa3); MASKT(PX0, PX1, (t)); partialSM(PX0, PX1, m_reg, mnX, alX);                                        \
        __syncthreads();                                                                                                      \
        if ((t) + 1 < NT) { VMW(); SWRITE_H(SB); }                                                                          \
        RESC(alX); __syncthreads(); } while (0)
    for (int t = 1; t + 1 < NT; t += 2) {
        HALF_STEP(pB0, pB1, mnB, alB, pA0, pA1, alA, t, 1, 0, 0);
        HALF_STEP(pA0, pA1, mnA, alA, pB0, pB1, alB, t + 1, 0, 1, 1);
    }
    const bool even = (NT & 1) == 0;
    if (even) { SBAR(); qkt<1>(pB0, pB1, K_lds, B_lds, r32, hi, S.qr); SBAR(); }
    { int Ln_ = __builtin_amdgcn_readfirstlane(Ln), pn_ = __builtin_amdgcn_readfirstlane(passn); asm volatile("" : "+s"(Ln_), "+s"(pn_)); const BlockRef nxt = attn_ref<PRT>(p, Ln_, pn_, traw, qkb, knew);
      const int jn_ = fox_jlo(nxt, lane); jlo_next = jn_;
      SLOAD_H(nxt.K, nxt.V, nxt.Bias, nxt.kvpitch, jn_ * KVBLK); SBAR();
      QLOAD(nxt); }
    SBAR();
    finishSM(pA0, pA1, alA, l_reg, pa0, pa1, pa2, pa3); SBAR();
    pv_tile<0>(o, vb0, pa0, pa1, pa2, pa3);
    if (even) { MASKT(pB0, pB1, NT - 1); partialSM(pB0, pB1, m_reg, mnB, alB); __syncthreads(); RESC(alB);
        finishSM(pB0, pB1, alB, l_reg, pa0, pa1, pa2, pa3); SBAR(); pv_tile<1>(o, vb0, pa0, pa1, pa2, pa3); }
    SBAR(); VMWN(8); SWRITE_HK(0); SBAR();
    if (hi == 0) li_l[r32] = l_reg; asm volatile("s_waitcnt lgkmcnt(0)" ::: "memory");
    float rli[16];
#pragma unroll
    for (int r = 0; r < 16; ++r) rli[r] = __builtin_amdgcn_rcpf(li_l[crow(r, hi)]);
    int Le_ = __builtin_amdgcn_readfirstlane(L), pe_ = __builtin_amdgcn_readfirstlane(pass); asm volatile("" : "+s"(Le_), "+s"(pe_)); const BlockRef ce = attn_ref<PRT>(p, Le_, pe_, traw, qkb, knew);
#pragma unroll
    for (int r = 0; r < 16; ++r) { const int orow = wid * QBLK + crow(r, hi);
#pragma unroll
        for (int d0 = 0; d0 < 4; ++d0) { const float v = o[d0][r] * rli[r];
            const float vn = __shfl_xor(v, 1);
            if ((r32 & 1) == 0 && orow < ce.nvalid) {
                const unsigned zz = *(const unsigned*)(ce.Z + (size_t)orow * ODD_N + d0 * 32 + r32);
                *(unsigned*)(ce.O + (size_t)orow * DM + d0 * 32 + r32) = cvtpk(v * silu_f(bflo(zz)), vn * silu_f(bfhi(zz))); } } }
    __syncthreads();
#undef RESC
#undef KBASE
#undef MASKT
#undef HALF_STEP
}
#undef ROWP
#undef VMW
#undef VMWN
#undef SLOAD_H
#undef SWRITE_HK
#undef SWRITE_HV
#undef SWRITE_H
#undef QLOAD
#undef SBAR
}
struct Params { const float* in[25]; float* out; unsigned char* ws; };
typedef const __attribute__((address_space(4))) Params& PR;
__device__ __forceinline__ const __attribute__((address_space(4))) Params* params_here() { const __attribute__((address_space(4))) Params* q = (const __attribute__((address_space(4))) Params*)__builtin_amdgcn_kernarg_segment_ptr(); asm volatile("" : "+s"(q)); return q; }
enum { I_XP = 0, I_XS, I_CK, I_CV, I_CLF, I_SSD, I_SCONV, I_NPRE, I_NPOST, I_WINE, I_WOUTE, I_GWS, I_GBS, I_GGV, I_CW, I_CB, I_DTB, I_ALOG, I_DSK, I_GSSD, I_WINO, I_BF, I_WOUTO, I_GQ, I_GK };

template <int MODE> struct EpiProj {
    static constexpr bool PERM = true, AFTER_DRAIN = false;
    unsigned char* ws; float* out; const float* gq; const float* gk; float* xl; int jl;
    __device__ __forceinline__ void operator()(const pg8::f32x4 (&acc)[2][2][4][2], const pg8::Unit& u, int wr, int wc, int fr, int fq) const {
        constexpr int ldc = MODE == 0 ? 1024 : (MODE == 1 ? EVEN_N : ODD_N), n_main = ldc / 256, thin_cols = MODE == 1 ? 16 : 8;
        bf16* O = (bf16*)(ws + (MODE == 0 ? WS_O : WS_PROJ));
        const int row0 = u.pm * 256 + wr * 64 + fr;
        if (MODE == 0 || u.pn < n_main) {
            const int col0 = u.pn * 256 + wc * 32 + 8 * fq;
            const bool isv = MODE == 2 && u.pn >= 8 && u.pn < 12, isqk = MODE == 2 && u.pn < 8, isk = isqk && u.pn >= 4;
            float rs[2][2][4];
            pg8::f32x4 g0 = {1.f, 1.f, 1.f, 1.f}, g1 = {1.f, 1.f, 1.f, 1.f};
            if (MODE == 2 && isqk) {
#pragma unroll
                for (int ai = 0; ai < 2; ++ai)
#pragma unroll
                    for (int bj = 0; bj < 2; ++bj)
#pragma unroll
                        for (int m = 0; m < 4; ++m) { const pg8::f32x4 a = acc[ai][bj][m][0], b = acc[ai][bj][m][1];
                            float s = (a[0] * a[0] + a[1] * a[1]) + (a[2] * a[2] + a[3] * a[3]) + (b[0] * b[0] + b[1] * b[1]) + (b[2] * b[2] + b[3] * b[3]);
                            s += __shfl_xor(s, 16); s += __shfl_xor(s, 32);
                            if (fq == 0) xl[((((wr * 4 + wc) * 2 + ai) * 2 + bj) * 4 + m) * 16 + fr] = s; }
                asm volatile("s_waitcnt lgkmcnt(0)" ::: "memory"); __builtin_amdgcn_s_barrier(); asm volatile("" ::: "memory");
#pragma unroll
                for (int ai = 0; ai < 2; ++ai)
#pragma unroll
                    for (int bj = 0; bj < 2; ++bj)
#pragma unroll
                        for (int m = 0; m < 4; ++m) { float t = 0.f;
#pragma unroll
                            for (int w4 = 0; w4 < 4; ++w4) t += xl[((((wr * 4 + w4) * 2 + ai) * 2 + bj) * 4 + m) * 16 + fr];
                            rs[ai][bj][m] = rsqrtf(t * (1.f / 128.f) + EPS); }
                const float* gp = (isk ? gk : gq) + wc * 32 + 8 * fq; g0 = *(const pg8::f32x4*)gp; g1 = *(const pg8::f32x4*)(gp + 4);
            }
#pragma unroll
            for (int ai = 0; ai < 2; ++ai)
#pragma unroll
                for (int m = 0; m < 4; ++m) { const int row = row0 + ai * 128 + m * 16; bf16* rowp = O + (size_t)row * ldc + col0;
#pragma unroll
                    for (int bj = 0; bj < 2; ++bj) { pg8::f32x4 v0 = acc[ai][bj][m][0], v1 = acc[ai][bj][m][1];
                        if (MODE == 2 && isqk) { v0 = v0 * rs[ai][bj][m] * g0; v1 = v1 * rs[ai][bj][m] * g1; }
                        u32x4 w; w.x = cvtpk(v0[0], v0[1]); w.y = cvtpk(v0[2], v0[3]); w.z = cvtpk(v1[0], v1[1]); w.w = cvtpk(v1[2], v1[3]);
                        *(u32x4*)(rowp + bj * 128) = w;
                        if (MODE == 2 && (isv || isk)) { const int vc = col0 - (isv ? 2048 : 1024) + bj * 128; const bool samp = row >= TP;
                            float* vo = out + (isv ? (samp ? O_VS + ((size_t)jl * TS + (row - TP)) * DM : O_VP + ((size_t)jl * TP + row) * DM)
                                                   : (samp ? O_KS + ((size_t)jl * TS + (row - TP)) * DM : O_KP + ((size_t)jl * TP + row) * DM)) + vc;
                            *(pg8::f32x4*)vo = v0; *(pg8::f32x4*)(vo + 4) = v1;
                            if (samp) { const int sr = row - TP; *(u32x4*)((bf16*)(ws + (isv ? WS_VS : WS_KS)) + ((size_t)(sr / SSEQ) * SKS + PAST + (sr % SSEQ)) * DM + vc) = w; } } } }
        } else if (MODE != 0) {
            if (wc == 0 && 8 * fq < thin_cols) { float* thin = (float*)(ws + (MODE == 1 ? WS_DTRAW : WS_FLOG));
#pragma unroll
                for (int ai = 0; ai < 2; ++ai)
#pragma unroll
                    for (int m = 0; m < 4; ++m) { float* tp = thin + (size_t)(row0 + ai * 128 + m * 16) * thin_cols + 8 * fq;
                        *(pg8::f32x4*)tp = acc[ai][0][m][0]; *(pg8::f32x4*)(tp + 4) = acc[ai][0][m][1]; }
            }
        }
    }
};

__device__ __forceinline__ void transpose_item(const float* W, int K, int N, bf16* WT, float* scr, int item, int nblk, int lane) {
    const int kb = item / nblk, nb = item % nblk, k0 = 64 * kb, n0 = 32 * nb;
    const int ncol = n0 + (lane & 31);
#pragma unroll 8
    for (int i = 0; i < 32; ++i) { const int kk = 2 * i + (lane >> 5); scr[kk * 33 + (lane & 31)] = (ncol < N) ? W[(size_t)(k0 + kk) * N + ncol] : 0.f; }
    asm volatile("s_waitcnt lgkmcnt(0)" ::: "memory");
    const int c = lane & 7;
#pragma unroll
    for (int j = 0; j < 4; ++j) { const int n = (lane >> 3) + 8 * j; const float* s = scr + (8 * c) * 33 + n;
        u32x4 o; o.x = cvtpk(s[0 * 33], s[1 * 33]); o.y = cvtpk(s[2 * 33], s[3 * 33]); o.z = cvtpk(s[4 * 33], s[5 * 33]); o.w = cvtpk(s[6 * 33], s[7 * 33]);
        *(u32x4*)(WT + (size_t)(n0 + n) * K + k0 + 8 * c) = o; }
    asm volatile("s_waitcnt lgkmcnt(0)" ::: "memory");
}
__device__ __forceinline__ void phase_prologue(int wv, PR p, char* lds) {
    const int tid = tid_of(wv), lane = tid & 63, wave = __builtin_amdgcn_readfirstlane(tid >> 6), gw = bid_here() * 8 + wave, NGW = gridDim.x * 8;
    float* scr = (float*)(lds + wave * 8704);
    constexpr int I0 = 16 * (EVEN_NP / 32), I1 = 32 * 32, I2 = 16 * (ODD_NP / 32), I3 = 16 * 32;
    constexpr int NIT = 2 * (I0 + I1 + I2 + I3);
    for (int it = gw; it < NIT; it += NGW) {
        int r = it; const int j = r & 1; r >>= 1;
        if (r < I0) { transpose_item(p.in[I_WINE] + (size_t)j * 1024 * EVEN_IN, 1024, EVEN_IN, (bf16*)(p.ws + WS_WINE) + (size_t)j * EVEN_NP * 1024, scr, r, EVEN_NP / 32, lane); continue; } r -= I0;
        if (r < I1) { transpose_item(p.in[I_WOUTE] + (size_t)j * 2048 * 1024, 2048, 1024, (bf16*)(p.ws + WS_WOUTE) + (size_t)j * 1024 * 2048, scr, r, 32, lane); continue; } r -= I1;
        if (r < I2) { transpose_item(p.in[I_WINO] + (size_t)j * 1024 * ODD_IN, 1024, ODD_IN, (bf16*)(p.ws + WS_WINO) + (size_t)j * ODD_NP * 1024, scr, r, ODD_NP / 32, lane); continue; } r -= I2;
        transpose_item(p.in[I_WOUTO] + (size_t)j * 1024 * 1024, 1024, 1024, (bf16*)(p.ws + WS_WOUTO) + (size_t)j * 1024 * 1024, scr, r, 32, lane);
    }
}

__device__ __forceinline__ void phase_norm(int wv, PR p, int li) {
    const int tid = tid_of(wv), lane = tid & 63, wave = __builtin_amdgcn_readfirstlane(tid >> 6), gw = bid_here() * 8 + wave, NGW = gridDim.x * 8;
    bf16* resb = (bf16*)(p.ws + WS_RES); const bf16* ob = (const bf16*)(p.ws + WS_O); bf16* hb = (bf16*)(p.ws + WS_H);
    const float* gpost = p.in[I_NPOST] + (li > 0 ? (li - 1) * DM : 0); const float* gpre = p.in[I_NPRE] + (li < 4 ? li * DM : 0);
    f32x4 gpo[4], gpr[4];
#pragma unroll
    for (int j = 0; j < 4; ++j) { gpo[j] = *(const f32x4*)(gpost + 4 * lane + 256 * j); gpr[j] = *(const f32x4*)(gpre + 4 * lane + 256 * j); }
    for (int row0 = gw; row0 < TT; row0 += 2 * NGW) {
        int rows[2] = {row0, row0 + NGW}; const bool v1 = rows[1] < TT; if (!v1) rows[1] = row0;
        f32x4 x[2][4]; u32x2 ow[2][4];
#pragma unroll
        for (int k = 0; k < 2; ++k) { const int row = rows[k];
            if (li <= 1) { const float* xin = row < TP ? p.in[I_XP] + (size_t)row * DM : p.in[I_XS] + (size_t)(row - TP) * DM;
#pragma unroll
                for (int j = 0; j < 4; ++j) x[k][j] = *(const f32x4*)(xin + 4 * lane + 256 * j); }
            else {
#pragma unroll
                for (int j = 0; j < 4; ++j) { const u32x2 w = *(const u32x2*)(resb + (size_t)row * DM + 4 * lane + 256 * j); x[k][j] = (f32x4){bflo(w.x), bfhi(w.x), bflo(w.y), bfhi(w.y)}; } }
            if (li > 0) {
#pragma unroll
                for (int j = 0; j < 4; ++j) ow[k][j] = *(const u32x2*)(ob + (size_t)row * DM + 4 * lane + 256 * j); } }
#pragma unroll
        for (int k = 0; k < 2; ++k) { const int row = rows[k]; if (k == 1 && !v1) break;
            if (li > 0) {
                f32x4 o[4]; float s = 0.f;
#pragma unroll
                for (int j = 0; j < 4; ++j) { const u32x2 w = ow[k][j];
                    o[j] = (f32x4){bflo(w.x), bfhi(w.x), bflo(w.y), bfhi(w.y)}; s += (o[j].x * o[j].x + o[j].y * o[j].y) + (o[j].z * o[j].z + o[j].w * o[j].w); }
                const float r = rsqrtf(wave_sum(s) * (1.f / DM) + EPS);
#pragma unroll
                for (int j = 0; j < 4; ++j) { x[k][j] = x[k][j] + o[j] * r * gpo[j];
                    if (li == 4) *(f32x4*)(p.out + (size_t)row * DM + 4 * lane + 256 * j) = x[k][j];
                    else { u32x2 w; w.x = cvtpk(x[k][j].x, x[k][j].y); w.y = cvtpk(x[k][j].z, x[k][j].w); *(u32x2*)(resb + (size_t)row * DM + 4 * lane + 256 * j) = w;
                           x[k][j] = (f32x4){bflo(w.x), bfhi(w.x), bflo(w.y), bfhi(w.y)}; } }
            }
            if (li < 4) {
                float s = 0.f;
#pragma unroll
                for (int j = 0; j < 4; ++j) s += (x[k][j].x * x[k][j].x + x[k][j].y * x[k][j].y) + (x[k][j].z * x[k][j].z + x[k][j].w * x[k][j].w);
                const float r = rsqrtf(wave_sum(s) * (1.f / DM) + EPS);
#pragma unroll
                for (int j = 0; j < 4; ++j) { const f32x4 h = x[k][j] * r * gpr[j];
                    u32x2 w; w.x = cvtpk(h.x, h.y); w.y = cvtpk(h.z, h.w); *(u32x2*)(hb + (size_t)row * DM + 4 * lane + 256 * j) = w; }
            }
        }
    }
}

constexpr int NCHP = TP / 64, NCH = NCHP + NSB;
constexpr size_t A_XT = 0, A_B = A_XT + (size_t)NCH * 16 * 64 * 64 * 2, A_C = A_B + (size_t)NCH * 64 * 256 * 2, A_BT = A_C + (size_t)NCH * 64 * 256 * 2;
constexpr size_t A_DT = A_BT + (size_t)NCH * 2 * 128 * 64 * 2, A_ACS = A_DT + (size_t)NCH * 16 * 64 * 4, A_W = A_ACS + (size_t)NCH * 16 * 64 * 4, A_END = A_W + (size_t)NCH * 16 * 64 * 4;
static_assert(A_END <= 163 * MiB, "act layouts");
__device__ __forceinline__ void phase_conv(int wv, PR p, int jl) {
    const int tid = tid_of(wv), lane = tid & 63, wave = __builtin_amdgcn_readfirstlane(tid >> 6);
    const int gtid = bid_here() * 512 + tid, gthreads = gridDim.x * 512;
    const bf16* proj = (const bf16*)(p.ws + WS_PROJ);
    bf16* XT = (bf16*)(p.ws + WS_ACT + A_XT); bf16* Bact = (bf16*)(p.ws + WS_ACT + A_B); bf16* Cact = (bf16*)(p.ws + WS_ACT + A_C); bf16* BT = (bf16*)(p.ws + WS_ACT + A_BT);
    const float* cw = p.in[I_CW] + (size_t)jl * CONV_DIM * 4; const float* cb = p.in[I_CB] + (size_t)jl * CONV_DIM;
    constexpr int NCG = CONV_DIM / 8;
    for (int idx = gtid; idx < NCH * NCG; idx += gthreads) {
        const int ch = idx / NCG, cgp = idx - ch * NCG, c0 = cgp * 8;
        int row0, Lv, b; bool samp, first, lastc;
        if (ch < NCHP) { b = ch >> 7; const int t0 = (ch & 127) * 64; row0 = b * SEQ + t0; Lv = 64; samp = false; first = (t0 == 0); lastc = (t0 + 64 == SEQ); }
        else { b = ch - NCHP; row0 = TP + b * SSEQ; Lv = SSEQ; samp = true; first = true; lastc = true; }
        float w[8][4], bias[8], xm3[8], xm2[8], xm1[8];
#pragma unroll
        for (int e = 0; e < 8; ++e) { const f32x4 t = *(const f32x4*)(cw + (size_t)(c0 + e) * 4); w[e][0] = t.x; w[e][1] = t.y; w[e][2] = t.z; w[e][3] = t.w; bias[e] = cb[c0 + e]; }
        if (first) {
            if (samp) { const float* sc = p.in[I_SCONV] + ((size_t)(jl * NSB + b) * 3) * CONV_DIM + c0;
#pragma unroll
                for (int e = 0; e < 8; ++e) { xm3[e] = sc[e]; xm2[e] = sc[CONV_DIM + e]; xm1[e] = sc[2 * CONV_DIM + e]; } }
            else {
#pragma unroll
                for (int e = 0; e < 8; ++e) { xm3[e] = 0.f; xm2[e] = 0.f; xm1[e] = 0.f; } }
        } else {
            unpack8(*(const u32x4*)(proj + (size_t)(row0 - 3) * EVEN_N + 4096 + c0), xm3);
            unpack8(*(const u32x4*)(proj + (size_t)(row0 - 2) * EVEN_N + 4096 + c0), xm2);
            unpack8(*(const u32x4*)(proj + (size_t)(row0 - 1) * EVEN_N + 4096 + c0), xm1);
        }
        u32x4 nx[8];
#pragma unroll
        for (int t = 0; t < 8; ++t) nx[t] = *(const u32x4*)(proj + (size_t)(row0 + t) * EVEN_N + 4096 + c0);
#pragma unroll 1
        for (int tb = 0; tb < 8; ++tb) {
            float v[8][8];
            if (8 * tb < Lv) {
                u32x4 cur[8];
#pragma unroll
                for (int t = 0; t < 8; ++t) cur[t] = nx[t];
                if (8 * (tb + 1) < Lv) {
#pragma unroll
                    for (int t = 0; t < 8; ++t) nx[t] = *(const u32x4*)(proj + (size_t)(row0 + 8 * (tb + 1) + t) * EVEN_N + 4096 + c0); }
#pragma unroll
                for (int t = 0; t < 8; ++t) { float x[8]; unpack8(cur[t], x);
#pragma unroll
                    for (int e = 0; e < 8; ++e) { const float y = bias[e] + xm3[e] * w[e][0] + xm2[e] * w[e][1] + xm1[e] * w[e][2] + x[e] * w[e][3]; v[t][e] = silu_f(y); xm3[e] = xm2[e]; xm2[e] = xm1[e]; xm1[e] = x[e]; } }
            } else {
#pragma unroll
                for (int t = 0; t < 8; ++t)
#pragma unroll
                    for (int e = 0; e < 8; ++e) v[t][e] = 0.f;
            }
            if (c0 < 1024 || (c0 >= 1024 && c0 < 1280)) {
                bf16* dst = (c0 < 1024) ? XT + ((((size_t)ch * 16 + (c0 >> 6)) * 8 + tb) * 64 + (c0 & 63)) * 8 : BT + ((((size_t)ch * 2 + ((c0 - 1024) >> 7)) * 8 + tb) * 128 + ((c0 - 1024) & 127)) * 8;
#pragma unroll
                for (int e = 0; e < 8; ++e) { u32x4 o; o.x = cvtpk(v[0][e], v[1][e]); o.y = cvtpk(v[2][e], v[3][e]); o.z = cvtpk(v[4][e], v[5][e]); o.w = cvtpk(v[6][e], v[7][e]); *(u32x4*)(dst + (size_t)e * 8) = o; }
            }
            if (c0 >= 1024) {
                bf16* dst = (c0 < 1280 ? Bact + (c0 - 1024) : Cact + (c0 - 1280)) + ((size_t)ch * 64 + 8 * tb) * 256;
#pragma unroll
                for (int t = 0; t < 8; ++t) *(u32x4*)(dst + (size_t)t * 256) = pack8f(v[t]);
            }
        }
        if (lastc) {
            float* co = p.out + (samp ? O_CS + ((size_t)(jl * NSB + b) * 3) * CONV_DIM : O_CP + ((size_t)(jl * NB + b) * 3) * CONV_DIM) + c0;
#pragma unroll
            for (int e = 0; e < 8; ++e) { co[e] = xm3[e]; co[CONV_DIM + e] = xm2[e]; co[2 * CONV_DIM + e] = xm1[e]; }
        }
    }
    { const float* dtraw = (const float*)(p.ws + WS_DTRAW); float* DT = (float*)(p.ws + WS_ACT + A_DT); float* ACS = (float*)(p.ws + WS_ACT + A_ACS); float* WW = (float*)(p.ws + WS_ACT + A_W);
      const int gw = bid_here() * 8 + wave, NGW = gridDim.x * 8;
      for (int it = gw; it < NCH * 16; it += NGW) { const int ch = it >> 4, h = it & 15;
          const int row = (ch < NCHP) ? ch * 64 + lane : TP + (ch - NCHP) * SSEQ + lane; const bool valid = (ch < NCHP) || lane < SSEQ;
          float dt = 0.f; if (valid) dt = softplus_f(dtraw[(size_t)row * 16 + h] + p.in[I_DTB][jl * 16 + h]);
          const float a_h = -__expf(p.in[I_ALOG][jl * 16 + h]);
          float acs = dt * a_h;
#pragma unroll
          for (int o = 1; o < 64; o <<= 1) { const float t = __shfl_up(acs, o); if (lane >= o) acs += t; }
          const float alast = __shfl(acs, 63);
          DT[(size_t)it * 64 + lane] = dt; ACS[(size_t)it * 64 + lane] = acs; WW[(size_t)it * 64 + lane] = dt * __expf(alast - acs); } }
}

constexpr int GM_WSTR = 136;
__device__ __forceinline__ void phase_gmlp(int wv, PR p, int jl, char* lds) {
    const int tid = tid_of(wv), lane = tid & 63, wave = tid >> 6;
    const bf16* proj = (const bf16*)(p.ws + WS_PROJ); bf16* cat = (bf16*)(p.ws + WS_CAT);
    bf16* Wl = (bf16*)lds; bf16* vT = (bf16*)(lds + 128 * GM_WSTR * 2);
    constexpr int NU = (TP / 128 + NSB) * 4;
    for (int u = bid_here(); u < NU; u += gridDim.x) {
        const int g = u & 3, cu = u >> 2;
        int row0, n; bool samp; int sb = 0;
        if (cu < TP / 128) { row0 = cu * 128; n = 128; samp = false; } else { sb = cu - TP / 128; row0 = TP + sb * SSEQ; n = SSEQ; samp = true; }
        __syncthreads();
        { const int j = tid >> 2, q = tid & 3; const bool valid = j < n;
          float v[64]; float ss = 0.f;
          const float* gv = p.in[I_GGV] + (size_t)(jl * 4 + g) * 256;
#pragma unroll
          for (int i = 0; i < 8; ++i) { const int cc = (q + 4 * i) * 8;
              u32x4 w = {0u, 0u, 0u, 0u}; if (valid) w = *(const u32x4*)(proj + (size_t)(row0 + j) * EVEN_N + 1024 + g * 256 + cc);
              float f[8]; unpack8(w, f);
#pragma unroll
              for (int e = 0; e < 8; e += 2) { const f32x2 gg = pg8::gelu_pk((f32x2){f[e], f[e + 1]}); v[i * 8 + e] = gg.x; v[i * 8 + e + 1] = gg.y; ss += gg.x * gg.x + gg.y * gg.y; } }
          ss += __shfl_xor(ss, 1); ss += __shfl_xor(ss, 2);
          const float r = rsqrtf(ss * (1.f / 256.f) + EPS);
#pragma unroll
          for (int i = 0; i < 8; ++i) { const int cc = (q + 4 * i) * 8;
#pragma unroll
              for (int e = 0; e < 8; ++e) v[i * 8 + e] = v[i * 8 + e] * r * gv[cc + e];
              if (samp && valid) { float* go = p.out + O_GV + ((size_t)(jl * NSB + sb) * SSEQ + j) * DM + g * 256 + cc;
                  *(f32x4*)go = (f32x4){v[i * 8], v[i * 8 + 1], v[i * 8 + 2], v[i * 8 + 3]}; *(f32x4*)(go + 4) = (f32x4){v[i * 8 + 4], v[i * 8 + 5], v[i * 8 + 6], v[i * 8 + 7]}; }
#pragma unroll
              for (int e = 0; e < 8; e += 2) { const unsigned pk = cvtpk(v[i * 8 + e], v[i * 8 + e + 1]); vT[(cc + e) * GM_WSTR + j] = (bf16)(pk & 0xffffu); vT[(cc + e + 1) * GM_WSTR + j] = (bf16)(pk >> 16); } }
        }
        { const int i = tid >> 2, jq = tid & 3; const float* wsrc = p.in[I_GWS] + ((size_t)(jl * 4 + g) * 128 + i) * 128 + jq * 32;
#pragma unroll
          for (int c = 0; c < 4; ++c) { float f[8];
              const f32x4 a = *(const f32x4*)(wsrc + c * 8), b = *(const f32x4*)(wsrc + c * 8 + 4);
              f[0] = a.x; f[1] = a.y; f[2] = a.z; f[3] = a.w; f[4] = b.x; f[5] = b.y; f[6] = b.z; f[7] = b.w;
              const int j0 = jq * 32 + c * 8;
              const bool keep = (i < n) && (j0 < n) && ((j0 >> 6) <= (i >> 6));
              if (!keep) {
#pragma unroll
                  for (int e = 0; e < 8; ++e) f[e] = 0.f; }
              *(u32x4*)(Wl + i * GM_WSTR + j0) = pack8f(f); } }
        __syncthreads();
        const int wi = wave >> 2, wj = wave & 3, fr = lane & 15, fq = lane >> 4;
        f32x4 acc[4][4];
#pragma unroll
        for (int a = 0; a < 4; ++a)
#pragma unroll
            for (int b = 0; b < 4; ++b) acc[a][b] = (f32x4){0.f, 0.f, 0.f, 0.f};
        const int nks = (wi == 0) ? 2 : 4;
        for (int ks = 0; ks < nks; ++ks) {
            bf16x8 af[4], bfr[4];
#pragma unroll
            for (int mi = 0; mi < 4; ++mi) af[mi] = *(const bf16x8*)(Wl + (64 * wi + 16 * mi + fr) * GM_WSTR + ks * 32 + fq * 8);
#pragma unroll
            for (int ni = 0; ni < 4; ++ni) bfr[ni] = *(const bf16x8*)(vT + (64 * wj + 16 * ni + fr) * GM_WSTR + ks * 32 + fq * 8);
#pragma unroll
            for (int ni = 0; ni < 4; ++ni)
#pragma unroll
                for (int mi = 0; mi < 4; ++mi) acc[ni][mi] = __builtin_amdgcn_mfma_f32_16x16x32_bf16(bfr[ni], af[mi], acc[ni][mi], 0, 0, 0);
        }
        const float* bs = p.in[I_GBS] + (size_t)(jl * 4 + g) * 128;
#pragma unroll
        for (int mi = 0; mi < 4; ++mi) { const int i = 64 * wi + 16 * mi + fr;
            if (i < n) { const float bsi = bs[i]; const size_t rb = (size_t)(row0 + i) * EVEN_N;
#pragma unroll
                for (int ni = 0; ni < 4; ++ni) { const int col = g * 256 + 64 * wj + 16 * ni + 4 * fq;
                    const u32x2 uu = *(const u32x2*)(proj + rb + col), zz = *(const u32x2*)(proj + rb + 2048 + col);
                    const f32x2 g0 = pg8::gelu_pk((f32x2){bflo(uu.x), bfhi(uu.x)}), g1 = pg8::gelu_pk((f32x2){bflo(uu.y), bfhi(uu.y)});
                    const f32x4 s = acc[ni][mi] + bsi;
                    u32x2 o; o.x = cvtpk(silu_f(bflo(zz.x)) * g0.x * s.x, silu_f(bfhi(zz.x)) * g0.y * s.y); o.y = cvtpk(silu_f(bflo(zz.y)) * g1.x * s.z, silu_f(bfhi(zz.y)) * g1.y * s.w);
                    *(u32x2*)(cat + (size_t)(row0 + i) * 2048 + col) = o; } } }
    }
}

__device__ __forceinline__ void phase_scan(int wv, PR p, int jl, char* lds) {
    const int tid = tid_of(wv), lane = tid & 63, wave = __builtin_amdgcn_readfirstlane(tid >> 6), fr = lane & 15, fq = lane >> 4;
    const bf16* XT = (const bf16*)(p.ws + WS_ACT + A_XT); const bf16* Bact = (const bf16*)(p.ws + WS_ACT + A_B); const bf16* Cact = (const bf16*)(p.ws + WS_ACT + A_C); const bf16* BT = (const bf16*)(p.ws + WS_ACT + A_BT);
    const float* DT = (const float*)(p.ws + WS_ACT + A_DT); const float* ACS = (const float*)(p.ws + WS_ACT + A_ACS); const float* WW = (const float*)(p.ws + WS_ACT + A_W);
    bf16* yb = (bf16*)(p.ws + WS_O);
    bf16* Cs = (bf16*)lds; bf16* Bs = Cs + 64 * 136; bf16* BTs = Bs + 64 * 136; bf16* XTs = BTs + 128 * 72; bf16* Ms = XTs + 16 * 72; bf16* Sb = Ms + 64 * 72;
    float* DTs = (float*)(Sb + 2 * 16 * 136); float* ACSs = DTs + 64; float* Ws = ACSs + 64;
    constexpr int NITEM = NB * 64 + NSB * 64;
    for (int it = vcu_here(); it < NITEM; it += gridDim.x) {
        int seq, h, pq, ch0, nch; bool samp;
        if (it < NB * 64) { seq = it >> 6; h = (it >> 2) & 15; pq = it & 3; ch0 = seq * 128; nch = 128; samp = false; }
        else { const int r = it - NB * 64; seq = r >> 6; h = (r >> 2) & 15; pq = r & 3; ch0 = NCHP + seq; nch = 1; samp = true; }
        const int g = h >> 3; const float dsk = p.in[I_DSK][jl * 16 + h];
        f32x4 accS = {0.f, 0.f, 0.f, 0.f};
        __syncthreads();
        { float* st = nullptr; if (samp) st = (float*)p.in[I_SSD] + (((size_t)(jl * NSB + seq) * 16 + h) * 64 + 16 * pq) * 128;
#pragma unroll
          for (int e = 0; e < 4; ++e) { if (samp) accS[e] = st[(size_t)(4 * fq + e) * 128 + 16 * wave + fr]; Sb[(4 * fq + e) * 136 + 16 * wave + fr] = (bf16)(cvtpk(accS[e], 0.f) & 0xffffu); } }
        u32x4 rC0, rC1, rB0, rB1, rT0, rT1, rX; float rS = 0.f;
#define SSD_LOAD(ch) do { const size_t cb_ = (size_t)(ch) * 64 * 256 + g * 128; \
        rC0 = *(const u32x4*)(Cact + cb_ + (size_t)(tid >> 4) * 256 + (tid & 15) * 8); rC1 = *(const u32x4*)(Cact + cb_ + (size_t)(32 + (tid >> 4)) * 256 + (tid & 15) * 8); \
        rB0 = *(const u32x4*)(Bact + cb_ + (size_t)(tid >> 4) * 256 + (tid & 15) * 8); rB1 = *(const u32x4*)(Bact + cb_ + (size_t)(32 + (tid >> 4)) * 256 + (tid & 15) * 8); \
        const bf16* bt_ = BT + ((size_t)(ch) * 2 + g) * 128 * 64; rT0 = *(const u32x4*)(bt_ + ((size_t)(tid & 7) * 128 + (tid >> 3)) * 8); rT1 = *(const u32x4*)(bt_ + ((size_t)(tid & 7) * 128 + 64 + (tid >> 3)) * 8); \
        if (tid < 128) rX = *(const u32x4*)(XT + ((((size_t)(ch) * 16 + h) * 8 + (tid & 7)) * 64 + 16 * pq + (tid >> 3)) * 8); \
        else if (tid < 320) { const int k_ = (tid - 128) >> 6; const float* src_ = k_ == 0 ? DT : (k_ == 1 ? ACS : WW); rS = src_[((size_t)(ch) * 16 + h) * 64 + (tid & 63)]; } } while (0)
        SSD_LOAD(ch0);
        for (int c = 0; c < nch; ++c) {
            const int ch = ch0 + c;
            __syncthreads();
            *(u32x4*)(Cs + (tid >> 4) * 136 + (tid & 15) * 8) = rC0; *(u32x4*)(Cs + (32 + (tid >> 4)) * 136 + (tid & 15) * 8) = rC1;
            *(u32x4*)(Bs + (tid >> 4) * 136 + (tid & 15) * 8) = rB0; *(u32x4*)(Bs + (32 + (tid >> 4)) * 136 + (tid & 15) * 8) = rB1;
            *(u32x4*)(BTs + (tid >> 3) * 72 + (tid & 7) * 8) = rT0; *(u32x4*)(BTs + (64 + (tid >> 3)) * 72 + (tid & 7) * 8) = rT1;
            if (tid < 128) *(u32x4*)(XTs + (tid >> 3) * 72 + (tid & 7) * 8) = rX;
            else if (tid < 320) DTs[tid - 128] = rS;
            __syncthreads();
            if (c + 1 < nch) SSD_LOAD(ch + 1);
            { const int lt = wave >> 1, sth = wave & 1;
              f32x4 a0 = {0.f, 0.f, 0.f, 0.f}, a1 = {0.f, 0.f, 0.f, 0.f};
              if (2 * sth <= lt) {
#pragma unroll
                  for (int kk = 0; kk < 4; ++kk) { const bf16x8 yf = *(const bf16x8*)(Cs + (16 * lt + fr) * 136 + 32 * kk + 8 * fq);
                      const bf16x8 x0 = *(const bf16x8*)(Bs + (32 * sth + fr) * 136 + 32 * kk + 8 * fq), x1 = *(const bf16x8*)(Bs + (32 * sth + 16 + fr) * 136 + 32 * kk + 8 * fq);
                      a0 = __builtin_amdgcn_mfma_f32_16x16x32_bf16(x0, yf, a0, 0, 0, 0); a1 = __builtin_amdgcn_mfma_f32_16x16x32_bf16(x1, yf, a1, 0, 0, 0); } }
              const int l = 16 * lt + fr; const float al = ACSs[l];
#pragma unroll
              for (int j = 0; j < 2; ++j) { const int s0 = 32 * sth + 16 * j + 4 * fq; const f32x4 as = *(const f32x4*)(ACSs + s0), ds = *(const f32x4*)(DTs + s0); const f32x4 ga = j ? a1 : a0; float m[4];
#pragma unroll
                  for (int e = 0; e < 4; ++e) m[e] = (s0 + e <= l) ? ga[e] * __expf(al - as[e]) * ds[e] : 0.f;
                  u32x2 o; o.x = cvtpk(m[0], m[1]); o.y = cvtpk(m[2], m[3]); *(u32x2*)(Ms + l * 72 + s0) = o; } }
            { const float dec = __expf(ACSs[63]);
#pragma unroll
              for (int e = 0; e < 4; ++e) accS[e] *= dec;
#pragma unroll
              for (int kk = 0; kk < 2; ++kk) { float xf[8]; unpack8(*(const u32x4*)(XTs + fr * 72 + 32 * kk + 8 * fq), xf);
                  const f32x4 w0 = *(const f32x4*)(Ws + 32 * kk + 8 * fq), w1 = *(const f32x4*)(Ws + 32 * kk + 8 * fq + 4);
                  xf[0] *= w0.x; xf[1] *= w0.y; xf[2] *= w0.z; xf[3] *= w0.w; xf[4] *= w1.x; xf[5] *= w1.y; xf[6] *= w1.z; xf[7] *= w1.w;
                  const u32x4 xw = pack8f(xf); const bf16x8 bfrag = *(const bf16x8*)(BTs + (16 * wave + fr) * 72 + 32 * kk + 8 * fq);
                  accS = __builtin_amdgcn_mfma_f32_16x16x32_bf16(*(const bf16x8*)&xw, bfrag, accS, 0, 0, 0); }
              bf16* sbn = Sb + ((c + 1) & 1) * 16 * 136;
#pragma unroll
              for (int e = 0; e < 4; ++e) sbn[(4 * fq + e) * 136 + 16 * wave + fr] = (bf16)(cvtpk(accS[e], 0.f) & 0xffffu); }
            __syncthreads();
            if (wave < 4) { const bf16* sbc = Sb + (c & 1) * 16 * 136; f32x4 ay = {0.f, 0.f, 0.f, 0.f};
#pragma unroll
                for (int kk = 0; kk < 4; ++kk) ay = __builtin_amdgcn_mfma_f32_16x16x32_bf16(*(const bf16x8*)(sbc + fr * 136 + 32 * kk + 8 * fq), *(const bf16x8*)(Cs + (16 * wave + fr) * 136 + 32 * kk + 8 * fq), ay, 0, 0, 0);
                const float el = __expf(ACSs[16 * wave + fr]);
#pragma unroll
                for (int e = 0; e < 4; ++e) ay[e] *= el;
                ay = __builtin_amdgcn_mfma_f32_16x16x32_bf16(*(const bf16x8*)(XTs + fr * 72 + 8 * fq), *(const bf16x8*)(Ms + (16 * wave + fr) * 72 + 8 * fq), ay, 0, 0, 0);
                if (wave >= 2) ay = __builtin_amdgcn_mfma_f32_16x16x32_bf16(*(const bf16x8*)(XTs + fr * 72 + 32 + 8 * fq), *(const bf16x8*)(Ms + (16 * wave + fr) * 72 + 32 + 8 * fq), ay, 0, 0, 0);
                const int l = 16 * wave + fr;
#pragma unroll
                for (int e = 0; e < 4; ++e) ay[e] += dsk * bf2f(XTs[(4 * fq + e) * 72 + l]);
                if (!samp || l < SSEQ) { const size_t row = samp ? (size_t)TP + seq * SSEQ + l : (size_t)ch * 64 + l;
                    u32x2 o; o.x = cvtpk(ay[0], ay[1]); o.y = cvtpk(ay[2], ay[3]); *(u32x2*)(yb + row * DM + h * 64 + 16 * pq + 4 * fq) = o; } }
        }
#undef SSD_LOAD
        { float* so = p.out + (samp ? O_SS + (((size_t)(jl * NSB + seq) * 16 + h) * 64 + 16 * pq) * 128 : O_SP + (((size_t)(jl * NB + seq) * 16 + h) * 64 + 16 * pq) * 128);
#pragma unroll
          for (int e = 0; e < 4; ++e) so[(size_t)(4 * fq + e) * 128 + 16 * wave + fr] = accS[e]; }
    }
}

__device__ __forceinline__ void phase_gate(int wv, PR p, int jl) {
    const int tid = tid_of(wv), lane = tid & 63, wave = __builtin_amdgcn_readfirstlane(tid >> 6), gw = bid_here() * 8 + wave, NGW = gridDim.x * 8;
    const bf16* proj = (const bf16*)(p.ws + WS_PROJ); const bf16* yb = (const bf16*)(p.ws + WS_O); bf16* cat = (bf16*)(p.ws + WS_CAT);
    const float* gs = p.in[I_GSSD] + (size_t)jl * 1024;
    float gsv[2][8];
#pragma unroll
    for (int gg = 0; gg < 2; ++gg)
#pragma unroll
        for (int e = 0; e < 8; ++e) gsv[gg][e] = gs[gg * 512 + 8 * lane + e];
    for (int row0 = gw; row0 < TT; row0 += 2 * NGW) {
        int rows[2] = {row0, row0 + NGW}; const bool v1 = rows[1] < TT; if (!v1) rows[1] = row0;
        u32x4 yw[2][2], zw[2][2];
#pragma unroll
        for (int k = 0; k < 2; ++k)
#pragma unroll
            for (int gg = 0; gg < 2; ++gg) { const int c = gg * 512 + 8 * lane; yw[k][gg] = *(const u32x4*)(yb + (size_t)rows[k] * DM + c); zw[k][gg] = *(const u32x4*)(proj + (size_t)rows[k] * EVEN_N + 3072 + c); }
#pragma unroll
        for (int k = 0; k < 2; ++k) { if (k == 1 && !v1) break;
#pragma unroll
            for (int gg = 0; gg < 2; ++gg) { const int c = gg * 512 + 8 * lane; float y[8], z[8]; unpack8(yw[k][gg], y); unpack8(zw[k][gg], z);
                float ss = 0.f;
#pragma unroll
                for (int e = 0; e < 8; ++e) { y[e] *= silu_f(z[e]); ss += y[e] * y[e]; }
                const float r = rsqrtf(wave_sum(ss) * (1.f / 512.f) + EPS);
#pragma unroll
                for (int e = 0; e < 8; ++e) y[e] = y[e] * r * gsv[gg][e];
                *(u32x4*)(cat + (size_t)rows[k] * 2048 + 1024 + c) = pack8f(y); } }
    }
}

template <int PER, bool SAMP> __device__ __forceinline__ void cumsum_item(PR p, int jl, int bh, int tid, int lane, int wave, float* wsum, const float* flog, const float* bfg) {
    constexpr float INV_SCALE = 11.313708498984761f; constexpr int n = SAMP ? PAST + SSEQ : SEQ, tot = SAMP ? SKS : SEQ;
    const int b = bh >> 3, h = bh & 7, e0 = tid * PER; const float bfh = bfg[h];
    float lf[PER]; float sum = 0.f;
#pragma unroll
    for (int i = 0; i < PER; ++i) { const int e = e0 + i; float v = 0.f;
        if (e < n) { if (SAMP) v = (e < PAST) ? p.in[I_CLF][(((size_t)jl * NSB + b) * PAST + e) * 8 + h] : logsigmoid_f(flog[(size_t)(TP + b * SSEQ + e - PAST) * 8 + h] + bfh);
                     else v = logsigmoid_f(flog[(size_t)(b * SEQ + e) * 8 + h] + bfh); }
        if (e < n && (!SAMP || e >= PAST)) p.out[SAMP ? O_LS + ((size_t)jl * TS + b * SSEQ + (e - PAST)) * 8 + h : O_LP + ((size_t)jl * TP + b * SEQ + e) * 8 + h] = v;
        sum += v; lf[i] = sum; }
    float incl = sum;
#pragma unroll
    for (int o = 1; o < 64; o <<= 1) { const float t = __shfl_up(incl, o); if (lane >= o) incl += t; }
    __syncthreads();
    if (lane == 63) wsum[wave] = incl;
    __syncthreads();
    float off = incl - sum;
#pragma unroll
    for (int w8 = 0; w8 < 8; ++w8) off += (w8 < wave) ? wsum[w8] : 0.f;
    float* dst = (float*)(p.ws + (SAMP ? WS_NFS : WS_NFP)) + (size_t)bh * tot;
#pragma unroll
    for (int i = 0; i < PER; ++i) { const int e = e0 + i; if (e < tot) dst[e] = (e < n) ? -(off + lf[i]) * INV_SCALE : 0.f; }
}
__device__ __forceinline__ void phase_qk_cache(int wv, PR p, int jl, int first) {
    const int tid = tid_of(wv), lane = tid & 63, wave = __builtin_amdgcn_readfirstlane(tid >> 6); const int bid = bid_here(); if (bid < first) return;
    const int gw = (bid - first) * 8 + wave, NGW = ((int)gridDim.x - first) * 8;
    bf16* Ks = (bf16*)(p.ws + WS_KS); bf16* Vs = (bf16*)(p.ws + WS_VS);
    { const int NR = 2 * NSB * (PAST + 32), per = (NR + NGW - 1) / NGW, r0 = gw * per, r1 = (r0 + per < NR) ? r0 + per : NR;
      float mx = 0.f; int curb = -1;
      for (int r = r0; r < r1; ++r) { const int which = r / (NSB * (PAST + 32)), rr = r - which * (NSB * (PAST + 32)), b = rr / (PAST + 32), t = rr - b * (PAST + 32);
          if (b != curb) { if (curb >= 0 && (lane & 7) == 0) atomicMax((unsigned*)(p.ws + WS_KMAX) + jl * 128 + curb * 8 + (lane >> 3), __float_as_uint(mx)); mx = 0.f; curb = b; }
          bf16* dst = (which ? Vs : Ks) + ((size_t)b * SKS + (t < PAST ? t : t + 32)) * DM + 16 * lane;
          if (t < PAST) { const float* src = p.in[which ? I_CV : I_CK] + (((size_t)jl * NSB + b) * PAST + t) * DM + 16 * lane; float f[16];
#pragma unroll
              for (int e = 0; e < 16; e += 4) { const f32x4 v = __builtin_nontemporal_load((const f32x4*)(src + e)); f[e] = v.x; f[e + 1] = v.y; f[e + 2] = v.z; f[e + 3] = v.w; }
              if (which == 0) { float ss = 0.f;
#pragma unroll
                  for (int e = 0; e < 16; ++e) ss += f[e] * f[e];
                  ss += __shfl_xor(ss, 1); ss += __shfl_xor(ss, 2); ss += __shfl_xor(ss, 4); mx = fmaxf(mx, ss); }
              *(u32x4*)dst = pack8f(f); *(u32x4*)(dst + 8) = pack8f(f + 8); }
          else { *(u32x4*)dst = (u32x4){0u, 0u, 0u, 0u}; *(u32x4*)(dst + 8) = (u32x4){0u, 0u, 0u, 0u}; } }
      if (curb >= 0 && (lane & 7) == 0) atomicMax((unsigned*)(p.ws + WS_KMAX) + jl * 128 + curb * 8 + (lane >> 3), __float_as_uint(mx)); }
}
__device__ __forceinline__ void phase_qk_cumsum(int wv, PR p, int jl, char* lds) {
    const int tid = tid_of(wv), lane = tid & 63, wave = __builtin_amdgcn_readfirstlane(tid >> 6), gw = bid_here() * 8 + wave, NGW = gridDim.x * 8;
    const float* flog = (const float*)(p.ws + WS_FLOG); const float* bfg = p.in[I_BF] + jl * 8;
    { float* wsum = (float*)lds;
      for (int it = bid_here(); it < NB * 8; it += gridDim.x) cumsum_item<16, false>(p, jl, it, tid, lane, wave, wsum, flog, bfg);
      for (int it = (int)gridDim.x - 1 - bid_here(); it < NSB * 8; it += gridDim.x) cumsum_item<5, true>(p, jl, it, tid, lane, wave, wsum, flog, bfg); }
}

template <class PRT> __device__ __forceinline__ fa::BlockRef attn_ref(PRT p, int id, int jl, float traw_p, float qkb, float knew) {
    const bf16* proj = (const bf16*)(p.ws + WS_PROJ); bf16* yc = (bf16*)(p.ws + WS_CAT);
    fa::BlockRef r;
    if (id < 1024) { const int bh = id >> 5, qb = id & 31, b = bh >> 3, h = bh & 7; const size_t rq = (size_t)b * SEQ + qb * 256;
        r.Q = proj + rq * ODD_N + h * 128; r.K = proj + (size_t)b * SEQ * ODD_N + 1024 + h * 128; r.V = r.K + 1024; r.Bias = (const float*)(p.ws + WS_NFP) + (size_t)bh * SEQ;
        r.O = yc + rq * DM + h * 128; r.Z = proj + rq * ODD_N + 3072 + h * 128; r.P0 = qb * 256; r.qpitch = ODD_N; r.kvpitch = ODD_N; r.nvalid = 256; r.skv = SEQ; r.canskip = 1; r.traw = traw_p; }
    else { const int bh = id - 1024, b = bh >> 3, h = bh & 7; const size_t rq = (size_t)TP + b * SSEQ;
        r.Q = proj + rq * ODD_N + h * 128; r.K = (const bf16*)(p.ws + WS_KS) + (size_t)b * SKS * DM + h * 128; r.V = (const bf16*)(p.ws + WS_VS) + (size_t)b * SKS * DM + h * 128;
        r.Bias = (const float*)(p.ws + WS_NFS) + (size_t)bh * SKS; r.O = yc + rq * DM + h * 128; r.Z = proj + rq * ODD_N + 3072 + h * 128; r.P0 = PAST; r.qpitch = ODD_N; r.kvpitch = DM; r.nvalid = SSEQ; r.skv = SKS; r.canskip = 1;
        { const float kc = sqrtf(__uint_as_float(((const unsigned*)(p.ws + WS_KMAX))[jl * 128 + bh])) * 1.01f; const float kb = fmaxf(kc, knew);
          r.traw = (2.f * (qkb * kb) + 30.f) * 11.313708f; } }
    return r;
}
__device__ __forceinline__ int attn_item(int w, int G, int i) {
    if (G == 256) { if (w < 128) { if (i == 0) return 1024 + w; return i < 5 ? 4 * w + (i - 1) : -1; } return i < 4 ? 512 + 4 * (w - 128) + i : -1; }
    const int id = w + i * G; return id < 1152 ? id : -1;
}
__device__ __forceinline__ void phase_attn(int wv, PR p, int jl, char* lds) {
    const int w = vcu_here(), G = gridDim.x;
    int i = 0, id = attn_item(w, G, 0); if (id < 0) return;
    float traw, qkb, knew;
    { const int lane = tid_of(wv) & 63; const float* gq = p.in[I_GQ] + jl * 128; const float* gk = p.in[I_GK] + jl * 128;
      float mq = fmaxf(fabsf(gq[lane]), fabsf(gq[lane + 64])), mk = fmaxf(fabsf(gk[lane]), fabsf(gk[lane + 64]));
#pragma unroll
      for (int o = 1; o < 64; o <<= 1) { mq = fmaxf(mq, __shfl_xor(mq, o)); mk = fmaxf(mk, __shfl_xor(mk, o)); }
      const float B = 11.313708f * 1.02f * mq * mk; traw = __int_as_float(__builtin_amdgcn_readfirstlane(__float_as_int((2.f * B + 30.f) * 11.313708f)));
      qkb = __int_as_float(__builtin_amdgcn_readfirstlane(__float_as_int(11.313708f * 1.01f * mq * 0.08838834764831845f)));
      knew = __int_as_float(__builtin_amdgcn_readfirstlane(__float_as_int(11.313708f * 1.01f * mk))); }
    fa::Seam S; int jlo;
    { const fa::BlockRef cur = attn_ref<PR>(p, id, jl, traw, qkb, knew); jlo = fa::fox_jlo(cur, tid_of(wv) & 63); fa::fox_prime(cur, lds, S, wv, jlo); }
    for (;;) {
        int idn = attn_item(w, G, i + 1); const bool last = idn < 0; if (last) idn = id;
        int jlon = 0;
        fa::fox_block<PR>(p, id, jl, idn, jl, lds, S, wv, jlo, jlon, traw, qkb, knew);
        if (last) break;
        id = idn; jlo = jlon; ++i;
    }
}
#define LAS __attribute__((address_space(3)))
#define XB_TMO      128
#define XB_XCNT(j)  (256  + 64 * (j))
#define XB_XSUB(j)  (1280 + 64 * (j))
#define XB_XGEN(j)  (2304 + 64 * (j))
#define XB_TOP      3328
#define XB_TOPGEN   3392
#define XCD_BAR_WORDS 3456
#define XB_SPIN_CAP (1u << 18)

__device__ __forceinline__ unsigned xb_ld(unsigned* p)              { return __hip_atomic_load(p, __ATOMIC_RELAXED, __HIP_MEMORY_SCOPE_AGENT); }
__device__ __forceinline__ unsigned xb_add(unsigned* p, unsigned v) { return __hip_atomic_fetch_add(p, v, __ATOMIC_RELAXED, __HIP_MEMORY_SCOPE_AGENT); }
__device__ __forceinline__ unsigned xb_xcc_id() { return (unsigned)__builtin_amdgcn_s_getreg((3 << 11) | 20) & 0xFu; }
#define XB_SPIN(cond, bar) do { unsigned _sp = 0; while (cond) { __builtin_amdgcn_s_sleep(1); \
    if ((++_sp & 255u) == 0u) { if (xb_ld(&(bar)[XB_TMO])) break; if (_sp > XB_SPIN_CAP) { atomicAdd(&(bar)[XB_TMO], 1u); break; } } } } while (0)

struct XcdBarrier {
    unsigned* bar; unsigned x;
    volatile LAS unsigned* st;
};

__device__ __forceinline__ XcdBarrier xcd_barrier_post(unsigned* bar, volatile LAS unsigned* st, int xb_tid) {
    XcdBarrier b; b.bar = bar; b.x = xb_xcc_id(); b.st = st;
    if (xb_tid == 0) (void)xb_add(&bar[XB_XCNT(b.x)], 1u);
    return b;
}
__device__ __forceinline__ void xcd_barrier_complete(unsigned* bar, unsigned x, unsigned& nloc, unsigned& nx) {
    const unsigned G = gridDim.x * gridDim.y * gridDim.z;
    unsigned sum, cnt, mine, sp = 0u;
    for (;;) {
        sum = 0u; cnt = 0u; mine = 0u;
#pragma unroll
        for (unsigned j = 0; j < 16; ++j) { const unsigned c = xb_ld(&bar[XB_XCNT(j)]); sum += c; cnt += (c > 0u) ? 1u : 0u; mine = (j == x) ? c : mine; }
        if (sum == G) break;
        __builtin_amdgcn_s_sleep(1);
        if ((++sp & 255u) == 0u) { if (xb_ld(&bar[XB_TMO])) break; if (sp > XB_SPIN_CAP) { atomicAdd(&bar[XB_TMO], 1u); break; } }
    }
    nloc = mine > 0u ? mine : 1u; nx = cnt > 0u ? cnt : 1u;
}

__device__ __forceinline__ void xcd_barrier(const XcdBarrier& b, int wv_) {
    const int xb_tid = tid_of(wv_);
    asm volatile("s_waitcnt vmcnt(0)" ::: "memory");
    __syncthreads();
    if (xb_tid == 0) {
        unsigned* bar = b.bar;
        __builtin_amdgcn_s_waitcnt(0);
        unsigned nloc = b.st[0], nx = b.st[1];
        if (nloc == 0u) { xcd_barrier_complete(bar, b.x, nloc, nx); b.st[0] = nloc; b.st[1] = nx; }
        const unsigned old = xb_add(&bar[XB_XSUB(b.x)], 1u);
        const unsigned gen = old / nloc;
        if (old + 1u == (gen + 1u) * nloc) {
            __builtin_amdgcn_fence(__ATOMIC_RELEASE, "agent");
            asm volatile("s_waitcnt vmcnt(0)" ::: "memory");
            const unsigned og = xb_add(&bar[XB_TOP], 1u);
            const unsigned tg = og / nx;
            if (og + 1u == (tg + 1u) * nx) xb_add(&bar[XB_TOPGEN], 1u);
            else XB_SPIN(xb_ld(&bar[XB_TOPGEN]) == tg, bar);
            __builtin_amdgcn_fence(__ATOMIC_ACQUIRE, "agent");
            xb_add(&bar[XB_XGEN(b.x)], 1u);
            asm volatile("s_waitcnt vmcnt(0)" ::: "memory");
        } else {
            XB_SPIN(xb_ld(&bar[XB_XGEN(b.x)]) == gen, bar);
            __builtin_amdgcn_fence(__ATOMIC_ACQUIRE, "agent");
            asm volatile("s_waitcnt vmcnt(0)" ::: "memory");
        }
    }
    __syncthreads();
}
#ifndef PH_MASK
#define PH_MASK 0xFFFF
#endif
#ifndef DUP_MASK
#define DUP_MASK 0
#endif
#define PH(b) for (int rep_ = 0; rep_ < ((DUP_MASK >> (b)) & 1) + 1; ++rep_) if (PH_MASK & (1 << (b)))
#define PHX(b) PH(b)
template <int MODE> __device__ __forceinline__ void run_gemm(int wv, char* lds, PR p, const bf16* A, const bf16* Bt, int N, int K, int jl) {
    pg8::Gemm g{A, Bt, TT, N, K}; pg8::StaticOrder S; S.init(TT, N, (int)gridDim.x, bid_here());
    EpiProj<MODE> E{p.ws, p.out, MODE == 2 ? p.in[I_GQ] + jl * 128 : nullptr, MODE == 2 ? p.in[I_GK] + jl * 128 : nullptr, (float*)(lds + 131072 + 1024), jl};
    pg8::gemm_phase<EpiProj<MODE>, pg8::StaticOrder, true, true>((PG8_LAS unsigned char*)lds, g, S, E, wv);
}

template <int jl> __device__ __forceinline__ void layer_pair(int wv, char* lds, const XcdBarrier& xb) {
        PHX(2) { PR p = *params_here(); run_gemm<1>(wv, lds, p, (const bf16*)(p.ws + WS_H), (const bf16*)(p.ws + WS_WINE) + (size_t)jl * EVEN_NP * 1024, EVEN_NP, 1024, jl); }
        xcd_barrier(xb, wv);
        PHX(3) { PR p = *params_here(); phase_conv(wv, p, jl); }
        PHX(4) { PR p = *params_here(); phase_gmlp(wv, p, jl, lds); }
        xcd_barrier(xb, wv);
        PHX(5) { PR p = *params_here(); phase_scan(wv, p, jl, lds); }
        xcd_barrier(xb, wv);
        PHX(6) { PR p = *params_here(); phase_gate(wv, p, jl); }
        xcd_barrier(xb, wv);
        PHX(7) { PR p = *params_here(); run_gemm<0>(wv, lds, p, (const bf16*)(p.ws + WS_CAT), (const bf16*)(p.ws + WS_WOUTE) + (size_t)jl * 1024 * 2048, 1024, 2048, jl); }
        PHX(14) { PR p = *params_here(); const int G_ = (int)gridDim.x, nu_ = (TT / 256) * 4; phase_qk_cache(wv, p, jl, (nu_ > 2 * G_ && nu_ < 3 * G_) ? nu_ - 2 * G_ : 0); }
        xcd_barrier(xb, wv);
        PHX(8) { PR p = *params_here(); phase_norm(wv, p, 2 * jl + 1); }
        xcd_barrier(xb, wv);
        PHX(9) { PR p = *params_here(); run_gemm<2>(wv, lds, p, (const bf16*)(p.ws + WS_H), (const bf16*)(p.ws + WS_WINO) + (size_t)jl * ODD_NP * 1024, ODD_NP, 1024, jl); }
        xcd_barrier(xb, wv);
        PHX(10) { { PR p = *params_here(); phase_qk_cumsum(wv, p, jl, lds); } }
        xcd_barrier(xb, wv);
        PHX(11) { PR p = *params_here(); phase_attn(wv, p, jl, lds); }
        xcd_barrier(xb, wv);
        PHX(12) { PR p = *params_here(); run_gemm<0>(wv, lds, p, (const bf16*)(p.ws + WS_CAT), (const bf16*)(p.ws + WS_WOUTO) + (size_t)jl * 1024 * 1024, 1024, 1024, jl); }
        xcd_barrier(xb, wv);
        PHX(13) { PR p = *params_here(); phase_norm(wv, p, 2 * jl + 2); }
        xcd_barrier(xb, wv);
}

__global__ void __launch_bounds__(512, 2) hybrid_fwd(Params p_unused) {
    extern __shared__ __attribute__((aligned(16))) unsigned char lds_raw[];
    char* lds = (char*)lds_raw;
    cg::grid_group grid = cg::this_grid();
    const int wv = __builtin_amdgcn_readfirstlane((int)threadIdx.x >> 6);
    volatile LAS unsigned* xst = (volatile LAS unsigned*)((LAS unsigned char*)lds_raw + 131072 + 64);
    if (threadIdx.x < 2) xst[threadIdx.x] = 0u;
    __syncthreads();
    const XcdBarrier xb = xcd_barrier_post((unsigned*)(p_unused.ws + WS_BAR), xst, (int)threadIdx.x);

    PH(0) { PR p = *params_here(); phase_prologue(wv, p, lds); }
    PH(1) { PR p = *params_here(); phase_norm(wv, p, 0); }
    grid.sync();
    layer_pair<0>(wv, lds, xb);
    layer_pair<1>(wv, lds, xb);
}

extern "C" void kernel_launch(void* const* d_in, const int* in_sizes, int n_in, void* d_out, int out_size, void* d_ws, size_t ws_size, hipStream_t stream) {
    static int grid = 0;
    if (grid == 0) {
        if (n_in != 25 || (size_t)out_size != O_END || ws_size < WS_END) {
            fprintf(stderr, "kernel_launch: unexpected shapes: n_in %d out %d (want %zu) ws %zu (need %zu)\n", n_in, out_size, (size_t)O_END, ws_size, (size_t)WS_END);
            grid = -1; return; }
        int dev = 0, cus = 0, per_cu = 0;
        (void)hipGetDevice(&dev);
        (void)hipDeviceGetAttribute(&cus, hipDeviceAttributeMultiprocessorCount, dev);
        if (hipFuncSetAttribute((const void*)hybrid_fwd, hipFuncAttributeMaxDynamicSharedMemorySize, LDS_BYTES) != hipSuccess) fprintf(stderr, "kernel_launch: hipFuncSetAttribute failed\n");
        if (hipOccupancyMaxActiveBlocksPerMultiprocessor(&per_cu, (const void*)hybrid_fwd, 512, LDS_BYTES) != hipSuccess || per_cu < 1) { fprintf(stderr, "kernel_launch: occupancy query gave %d\n", per_cu); per_cu = 1; }
        (void)hipGetLastError();
        if (cus <= 0) cus = 256;
        grid = cus;
    }
    if (grid < 0) return;
    (void)hipMemsetAsync((char*)d_ws + WS_BAR, 0, 65536, stream);
    Params p{};
    for (int i = 0; i < 25; ++i) p.in[i] = (const float*)d_in[i];
    p.out = (float*)d_out; p.ws = (unsigned char*)d_ws;
    void* args[] = {&p};
    hipError_t e = hipLaunchCooperativeKernel((const void*)hybrid_fwd, dim3(grid), dim3(512), args, LDS_BYTES, stream);
    if (e != hipSuccess) fprintf(stderr, "kernel_launch: cooperative launch failed: %s (grid %d)\n", hipGetErrorString(e), grid);
}
```

```cpp
#include <hip/hip_runtime.h>
#include <hip/hip_cooperative_groups.h>
#include <hip/hip_bf16.h>
#include <cstdio>
#include <cstdint>
namespace cg = cooperative_groups;

constexpr int DM = 1024, NB = 4, SEQ = 8192, NSB = 16, SSEQ = 32, PAST = 2048;
constexpr int TP = NB * SEQ, TS = NSB * SSEQ, TT = TP + TS;
constexpr int EVEN_IN = 5648, EVEN_N = 5632, EVEN_NP = 5888;
constexpr int ODD_IN = 4104, ODD_N = 4096, ODD_NP = 4352;
constexpr int CONV_DIM = 1536, SKS = PAST + 64;
constexpr float EPS = 1e-6f;

constexpr size_t O_YP = 0;
constexpr size_t O_YS = O_YP + (size_t)TP * DM;
constexpr size_t O_KP = O_YS + (size_t)TS * DM;
constexpr size_t O_VP = O_KP + (size_t)2 * TP * DM;
constexpr size_t O_LP = O_VP + (size_t)2 * TP * DM;
constexpr size_t O_SP = O_LP + (size_t)2 * TP * 8;
constexpr size_t O_CP = O_SP + (size_t)2 * NB * 16 * 64 * 128;
constexpr size_t O_KS = O_CP + (size_t)2 * NB * 3 * CONV_DIM;
constexpr size_t O_VS = O_KS + (size_t)2 * TS * DM;
constexpr size_t O_LS = O_VS + (size_t)2 * TS * DM;
constexpr size_t O_SS = O_LS + (size_t)2 * TS * 8;
constexpr size_t O_CS = O_SS + (size_t)2 * NSB * 16 * 64 * 128;
constexpr size_t O_GV = O_CS + (size_t)2 * NSB * 3 * CONV_DIM;
constexpr size_t O_END = O_GV + (size_t)2 * TS * DM;

constexpr size_t MiB = 1u << 20;
constexpr size_t WS_WINE = 0, WS_WOUTE = 24 * MiB, WS_WINO = 32 * MiB, WS_WOUTO = 50 * MiB;
constexpr size_t WS_DTRAW = 54 * MiB, WS_FLOG = 57 * MiB, WS_NFP = 59 * MiB, WS_NFS = 60 * MiB;
constexpr size_t WS_BAR = 61 * MiB + 512 * 1024;
constexpr size_t WS_KMAX = WS_BAR + 32768;
constexpr size_t WS_H = 62 * MiB, WS_O = 127 * MiB, WS_CAT = 192 * MiB, WS_ACT = 322 * MiB, WS_Y = 420 * MiB;
constexpr size_t WS_KS = 322 * MiB, WS_VS = 388 * MiB;
constexpr size_t WS_PROJ = 485 * MiB, WS_RES = 843 * MiB, WS_END = 908 * MiB;
static_assert((size_t)2 * EVEN_NP * 1024 * 2 <= 24 * MiB && (size_t)2 * ODD_NP * 1024 * 2 <= 18 * MiB, "weights");
static_assert((size_t)TT * 16 * 4 <= 3 * MiB && (size_t)TT * 8 * 4 <= 2 * MiB && (size_t)128 * SKS * 4 <= 2 * MiB, "small");
static_assert((size_t)TT * 1024 * 2 <= 65 * MiB && (size_t)TT * 1536 * 2 <= 98 * MiB && (size_t)NSB * SKS * 1024 * 2 <= 66 * MiB, "act");
static_assert((size_t)TT * EVEN_N * 2 <= 358 * MiB, "proj");

constexpr int LDS_BYTES = 131072 + 1024 + 8192 + 1024;

typedef unsigned short bf16;
typedef float f32x4 __attribute__((ext_vector_type(4)));
typedef float f32x2 __attribute__((ext_vector_type(2)));
typedef float f32x16 __attribute__((ext_vector_type(16)));
typedef unsigned u32x4 __attribute__((ext_vector_type(4)));
typedef unsigned u32x2 __attribute__((ext_vector_type(2)));
typedef short bf16x8 __attribute__((ext_vector_type(8)));
typedef short s16x4 __attribute__((ext_vector_type(4)));

__device__ __forceinline__ float bf2f(unsigned b) { return __uint_as_float(b << 16); }
__device__ __forceinline__ float bflo(unsigned w) { return __uint_as_float(w << 16); }
__device__ __forceinline__ float bfhi(unsigned w) { return __uint_as_float(w & 0xffff0000u); }
typedef __bf16 bf16x2_t __attribute__((ext_vector_type(2)));
__device__ __forceinline__ unsigned cvtpk(float lo, float hi) { const f32x2 v = {lo, hi}; const bf16x2_t b = __builtin_convertvector(v, bf16x2_t); return __builtin_bit_cast(unsigned, b); }
__device__ __forceinline__ float wave_sum(float v) {
#pragma unroll
    for (int o = 1; o < 64; o <<= 1) v += __shfl_xor(v, o);
    return v;
}
__device__ __forceinline__ float silu_f(float x) { return x * __builtin_amdgcn_rcpf(1.f + __expf(-x)); }
__device__ __forceinline__ float softplus_f(float x) { return x > 20.f ? x : log1pf(__expf(x)); }
__device__ __forceinline__ float logsigmoid_f(float x) { return fminf(x, 0.f) - log1pf(__expf(-fabsf(x))); }
__device__ __forceinline__ void unpack8(u32x4 w, float* f) {
    f[0] = bflo(w.x); f[1] = bfhi(w.x); f[2] = bflo(w.y); f[3] = bfhi(w.y); f[4] = bflo(w.z); f[5] = bfhi(w.z); f[6] = bflo(w.w); f[7] = bfhi(w.w);
}
__device__ __forceinline__ u32x4 pack8f(const float* f) { u32x4 w; w.x = cvtpk(f[0], f[1]); w.y = cvtpk(f[2], f[3]); w.z = cvtpk(f[4], f[5]); w.w = cvtpk(f[6], f[7]); return w; }

__device__ __forceinline__ int tid_of(int wv) { asm volatile("" : "+s"(wv)); int l; asm volatile("v_mbcnt_lo_u32_b32 %0, -1, 0\n\tv_mbcnt_hi_u32_b32 %0, -1, %0" : "=v"(l)); int t = (wv << 6) | l; asm volatile("" : "+v"(t)); return t; }
__device__ __forceinline__ int bid_here() { int b = blockIdx.x; asm volatile("" : "+s"(b)); return b; }
__device__ __forceinline__ int vcu_here() { const int b = bid_here(), G = (int)gridDim.x; return (G % 8 == 0) ? (b % 8) * (G / 8) + b / 8 : b; }
namespace pg8 {
#define PG8_LAS __attribute__((address_space(3)))
typedef unsigned short bf16_t;
typedef short bf16x8 __attribute__((ext_vector_type(8)));
typedef float f32x4 __attribute__((ext_vector_type(4)));
typedef unsigned u32x4 __attribute__((ext_vector_type(4)));
constexpr int BM = 256, BK = 64, HALF = 128, HTB = HALF * BK * 2  , STAGE_BYTES = 8 * HTB, NXCD = 8, WGM = 8;

__host__ __device__ __forceinline__ int lds_byte(int r, int c) { const int st = (r >> 4) * 2 + (c >> 5), rr = r & 15, cc = c & 31, ob = rr * 64 + cc * 2; return st * 1024 + (ob ^ (((ob >> 9) & 1) << 5)); }
__host__ __device__ __forceinline__ void stage_rc(int b, int& R, int& C) { const int st = b / 1024, sb = b % 1024, swz = sb ^ (((sb >> 9) & 1) << 5); R = (st >> 1) * 16 + swz / 64; C = (st & 1) * 32 + (swz % 64) / 2; }
__host__ __device__ __forceinline__ int perm32(int rho) { const int n = rho >> 4, i = rho & 15; return 8 * (i >> 2) + 4 * n + (i & 3); }

struct Unit { int pm, pn; };
struct Gemm { const bf16_t* A; const bf16_t* Bt; int M, N, K; };

struct StaticOrder {
    int nM, nN, nwg, G, c;
    __host__ __device__ void init(int M, int N, int G_, int c_) { nM = M / BM; nN = N / BM; nwg = nM * nN; G = G_; c = c_; }
    __host__ __device__ bool next(int i, Unit& u) const {
        const long L = (long)i * G + c; if (L >= nwg) return false;
        int wgid = (int)L; { const int q = nwg / NXCD, r = nwg % NXCD, xcd = wgid % NXCD, off = wgid / NXCD; wgid = (xcd < r ? xcd * (q + 1) : r * (q + 1) + (xcd - r) * q) + off; }
        const int nig = WGM * nN, gid = wgid / nig, fm = gid * WGM, gsz = (nM - fm) < WGM ? (nM - fm) : WGM;
        u.pm = fm + ((wgid % nig) % gsz); u.pn = (wgid % nig) / gsz; return true;
    }
    __device__ __forceinline__ void a_ready(const Unit&) const {}
    __device__ __forceinline__ void done(const Unit&) const {}
};

__device__ __forceinline__ unsigned cvt_pk_bf16(float lo, float hi) { unsigned r; asm volatile("v_cvt_pk_bf16_f32 %0, %1, %2" : "=v"(r) : "v"(lo), "v"(hi)); return r; }
typedef float f32x2 __attribute__((ext_vector_type(2)));
__device__ __forceinline__ f32x2 gelu_pk(f32x2 v) {
    const f32x2 av = __builtin_elementwise_abs(v), d = av * 0.2316418882f + 1.0f;
    f32x2 t; t.x = __builtin_amdgcn_rcpf(d.x); t.y = __builtin_amdgcn_rcpf(d.y);
    f32x2 q = t * 0.5307027145f + (-0.7265760135f); q = q * t + 0.7107068705f; q = q * t + (-0.142248368f); q = q * t + 0.127414796f; q = q * t;
    const f32x2 s = (v * v) * (-0.72134752044f);
    f32x2 e; e.x = __builtin_amdgcn_exp2f(s.x); e.y = __builtin_amdgcn_exp2f(s.y);
    const f32x2 m = v * (q * e), r = v - m;
    f32x2 o; o.x = v.x < 0.f ? m.x : r.x; o.y = v.y < 0.f ? m.y : r.y; return o;
}
template <class Epi, class Sched, bool ALIGN_EPI = false, bool SP2 = false>
__device__ __forceinline__ void gemm_phase(PG8_LAS unsigned char* lds, const Gemm g, const Sched& S, const Epi& E, const int wv_in) {
    const int tid = tid_of(wv_in), wid = __builtin_amdgcn_readfirstlane(tid >> 6), lane = tid & 63, wr = wid >> 2, wc = wid & 3, fr = lane & 15, fq = lane >> 4;
    const int K = g.K, nt = K / BK;
    unsigned voffA[2], voffB[2];
#pragma unroll
    for (int i = 0; i < 2; ++i) { int R, C; stage_rc(tid * 16 + i * 8192, R, C); const int Rb = Epi::PERM ? ((R & ~31) + perm32(R & 31)) : R;
        voffA[i] = (unsigned)(R * K + C) * 2u; voffB[i] = (unsigned)(Rb * K + C) * 2u; }
    const size_t kstep = (size_t)(BK * 2);
    const size_t hstep = (size_t)HALF * K * 2;
    const size_t tstep = 2 * hstep;
    const unsigned ldsw = (unsigned)wid * 1024u;
    const int aoff = lds_byte(wr * 64 + fr, fq * 8), boff = lds_byte(wc * 32 + fr, fq * 8);
#define PG8_SA(b, h) (((b) * 2 + (h)) * HTB)
#define PG8_SB(b, h) ((4 + (b) * 2 + (h)) * HTB)
#define PG8_STAGE(bufoff, gbase, voff) do { _Pragma("unroll") for (int _i = 0; _i < 2; ++_i) \
        __builtin_amdgcn_global_load_lds((const unsigned*)((const char*)(gbase) + (voff)[_i]), (PG8_LAS unsigned*)(lds + (bufoff) + ldsw + _i * 8192), 16, 0, 0); } while (0)
#define PG8_LDA(dst, b, h) do { _Pragma("unroll") for (int m = 0; m < 4; ++m) _Pragma("unroll") for (int k = 0; k < 2; ++k) dst[m][k] = *(const PG8_LAS bf16x8*)(lds + PG8_SA(b, h) + aoff + m * 2048 + k * 1024); } while (0)
#define PG8_LDB(dst, b, h) do { _Pragma("unroll") for (int n = 0; n < 2; ++n) _Pragma("unroll") for (int k = 0; k < 2; ++k) dst[n][k] = *(const PG8_LAS bf16x8*)(lds + PG8_SB(b, h) + boff + n * 2048 + k * 1024); } while (0)
#define PG8_MMA(ai, bj, At, Bt) do { __builtin_amdgcn_s_setprio(1); _Pragma("unroll") for (int m = 0; m < 4; ++m) _Pragma("unroll") for (int n = 0; n < 2; ++n) _Pragma("unroll") for (int k = 0; k < 2; ++k) \
        acc[ai][bj][m][n] = __builtin_amdgcn_mfma_f32_16x16x32_bf16(Bt[n][k], At[m][k], acc[ai][bj][m][n], 0, 0, 0); __builtin_amdgcn_s_setprio(0); } while (0)
#define PG8_WAIT_V(n) asm volatile("s_waitcnt vmcnt(" #n ")" ::: "memory")
#define PG8_WAIT_L(n) asm volatile("s_waitcnt lgkmcnt(" #n ")" ::: "memory")
#define PG8_BAR __builtin_amdgcn_s_barrier()
#define PG8_SCHED __builtin_amdgcn_sched_barrier(0)
    Unit cur, nxt; int ui = 0;
    if (!S.next(0, cur)) return;
    f32x4 acc[2][2][4][2];
#pragma unroll
    for (int a = 0; a < 2; ++a)
#pragma unroll
        for (int b = 0; b < 2; ++b)
#pragma unroll
            for (int m = 0; m < 4; ++m)
#pragma unroll
                for (int n = 0; n < 2; ++n) acc[a][b][m][n] = (f32x4){0.f, 0.f, 0.f, 0.f};
    bf16x8 At[4][2], B0[2][2], B1[2][2];
    const char* cA = (const char*)g.A + (size_t)cur.pm * tstep; const char* cB = (const char*)g.Bt + (size_t)cur.pn * tstep;
    S.a_ready(cur);
    if constexpr (SP2) {
        PG8_STAGE(PG8_SB(0, 0), cB, voffB); PG8_STAGE(PG8_SB(0, 1), cB + hstep, voffB); PG8_STAGE(PG8_SA(0, 0), cA, voffA); PG8_STAGE(PG8_SA(0, 1), cA + hstep, voffA);
        if (wr == 1) PG8_BAR;
        PG8_WAIT_V(2); PG8_BAR;
        PG8_STAGE(PG8_SB(1, 0), cB + kstep, voffB); PG8_STAGE(PG8_SA(1, 0), cA + kstep, voffA); PG8_STAGE(PG8_SB(1, 1), cB + hstep + kstep, voffB);
        PG8_WAIT_V(6); PG8_BAR;
    } else {
        PG8_STAGE(PG8_SB(0, 0), cB, voffB); PG8_STAGE(PG8_SA(0, 0), cA, voffA); PG8_STAGE(PG8_SB(0, 1), cB + hstep, voffB); PG8_STAGE(PG8_SA(0, 1), cA + hstep, voffA);
        if (wr == 1) PG8_BAR;
        PG8_WAIT_V(4); PG8_BAR;
        PG8_STAGE(PG8_SB(1, 0), cB + kstep, voffB); PG8_STAGE(PG8_SA(1, 0), cA + kstep, voffA); PG8_STAGE(PG8_SB(1, 1), cB + hstep + kstep, voffB);
        PG8_WAIT_V(6); PG8_BAR;
    }
    for (;;) {
        const bool has_next = S.next(ui + 1, nxt);
        const char* nA = has_next ? (const char*)g.A + (size_t)nxt.pm * tstep : cA; const char* nB = has_next ? (const char*)g.Bt + (size_t)nxt.pn * tstep : cB;
        for (int t = 0; t < nt; t += 2) {
            const bool last = (t == nt - 2);
            const char* a1 = cA + (size_t)(t + 1) * kstep;
            const char* a2 = last ? nA : cA + (size_t)(t + 2) * kstep; const char* b2 = last ? nB : cB + (size_t)(t + 2) * kstep;
            const char* a3 = a2 + kstep; const char* b3 = b2 + kstep;
            if (last && has_next) S.a_ready(nxt);
            if constexpr (SP2) {
            PG8_LDB(B0, 0, 0); PG8_LDB(B1, 0, 1); PG8_SCHED; PG8_LDA(At, 0, 0); PG8_STAGE(PG8_SA(1, 1), a1 + hstep, voffA);
            PG8_WAIT_V(8); PG8_WAIT_L(0); PG8_BAR; PG8_MMA(0, 0, At, B0); PG8_MMA(0, 1, At, B1); PG8_BAR; PG8_SCHED;
            PG8_LDA(At, 0, 1); PG8_STAGE(PG8_SB(0, 0), b2, voffB); PG8_STAGE(PG8_SB(0, 1), b2 + hstep, voffB); PG8_STAGE(PG8_SA(0, 0), a2, voffA);
            PG8_WAIT_V(8); PG8_WAIT_L(0); PG8_BAR; PG8_MMA(1, 0, At, B0); PG8_MMA(1, 1, At, B1); PG8_BAR; PG8_SCHED;
            PG8_LDB(B0, 1, 0); PG8_LDB(B1, 1, 1); PG8_SCHED; PG8_LDA(At, 1, 0); PG8_STAGE(PG8_SA(0, 1), a2 + hstep, voffA);
            PG8_WAIT_V(8); PG8_WAIT_L(0); PG8_BAR; PG8_MMA(0, 0, At, B0); PG8_MMA(0, 1, At, B1); PG8_BAR; PG8_SCHED;
            PG8_LDA(At, 1, 1); PG8_STAGE(PG8_SB(1, 0), b3, voffB); PG8_STAGE(PG8_SB(1, 1), b3 + hstep, voffB); PG8_STAGE(PG8_SA(1, 0), a3, voffA);
            PG8_WAIT_V(8); PG8_WAIT_L(0); PG8_BAR; PG8_MMA(1, 0, At, B0); PG8_MMA(1, 1, At, B1); PG8_BAR; PG8_SCHED;
            } else {
            PG8_LDB(B0, 0, 0); PG8_SCHED; PG8_LDA(At, 0, 0); PG8_STAGE(PG8_SA(1, 1), a1 + hstep, voffA);
            PG8_WAIT_L(8); PG8_BAR; PG8_WAIT_L(0); PG8_MMA(0, 0, At, B0); PG8_BAR; PG8_SCHED;
            PG8_LDB(B1, 0, 1); PG8_STAGE(PG8_SB(0, 0), b2, voffB);
            PG8_BAR; PG8_WAIT_L(0); PG8_MMA(0, 1, At, B1); PG8_BAR;
            PG8_LDA(At, 0, 1); PG8_STAGE(PG8_SA(0, 0), a2, voffA);
            PG8_BAR; PG8_WAIT_L(0); PG8_MMA(1, 0, At, B0); PG8_BAR; PG8_SCHED;
            PG8_STAGE(PG8_SB(0, 1), b2 + hstep, voffB);
            PG8_WAIT_V(6); PG8_BAR; PG8_MMA(1, 1, At, B1); PG8_BAR;
            PG8_LDB(B0, 1, 0); PG8_SCHED; PG8_LDA(At, 1, 0); PG8_STAGE(PG8_SA(0, 1), a2 + hstep, voffA);
            PG8_WAIT_L(8); PG8_BAR; PG8_WAIT_L(0); PG8_MMA(0, 0, At, B0); PG8_BAR; PG8_SCHED;
            PG8_LDB(B1, 1, 1); PG8_STAGE(PG8_SB(1, 0), b3, voffB);
            PG8_BAR; PG8_WAIT_L(0); PG8_MMA(0, 1, At, B1); PG8_BAR;
            PG8_LDA(At, 1, 1); PG8_STAGE(PG8_SA(1, 0), a3, voffA);
            PG8_BAR; PG8_WAIT_L(0); PG8_MMA(1, 0, At, B0); PG8_BAR; PG8_SCHED;
            PG8_STAGE(PG8_SB(1, 1), b3 + hstep, voffB);
            PG8_WAIT_V(6); PG8_BAR; PG8_MMA(1, 1, At, B1); PG8_BAR;
            }
        }
        if constexpr (ALIGN_EPI) { if (wr == 0) PG8_BAR; }
        if constexpr (!Epi::AFTER_DRAIN) { E(acc, cur, wr, wc, fr, fq); S.done(cur); }
        if (!has_next) break;
#pragma unroll
        for (int a = 0; a < 2; ++a)
#pragma unroll
            for (int b = 0; b < 2; ++b)
#pragma unroll
                for (int m = 0; m < 4; ++m)
#pragma unroll
                    for (int n = 0; n < 2; ++n) acc[a][b][m][n] = (f32x4){0.f, 0.f, 0.f, 0.f};
        cur = nxt; cA = nA; cB = nB; ++ui;
        if constexpr (ALIGN_EPI) { if (wr == 1) PG8_BAR; }
    }
    PG8_WAIT_V(0);
    if constexpr (!ALIGN_EPI) { if (wr == 0) PG8_BAR; }
    PG8_BAR;
    if constexpr (Epi::AFTER_DRAIN) { E.fused(acc, cur, wr, wc, fr, fq, lds, wid, lane); S.done(cur); }
#undef PG8_SA
#undef PG8_SB
#undef PG8_STAGE
#undef PG8_LDA
#undef PG8_LDB
#undef PG8_MMA
#undef PG8_WAIT_V
#undef PG8_WAIT_L
#undef PG8_BAR
#undef PG8_SCHED
}
}
namespace fa {
constexpr float SCALE = 0.08838834764831845f;
constexpr float THR = 40.f;
constexpr int D = 128, NW = 8, QBLK = 32, KVBLK = 64, QB = NW * QBLK;
constexpr int SHM_V = KVBLK * D * 2, SHM_K = KVBLK * D * 2;
constexpr int OFF_WS = 2 * SHM_V + 2 * SHM_K, OFF_BIAS = OFF_WS + NW * 64 * 4, FA_LDS = OFF_BIAS + 2 * 64 * 4;
#define KSWZ(row, colB) ((row) * 256 + ((colB) ^ (((row) & 7) << 4)))
#define SBAR() __builtin_amdgcn_sched_barrier(0)
__device__ __forceinline__ int v_st(int k, int c) { const int kk = (k & ~0xC) | ((k & 4) << 1) | ((k & 8) >> 1); return ((kk >> 3) * 4 + (c >> 5)) * 512 + ((kk & 7) * 32 + (c & 31)) * 2; }
__device__ __forceinline__ int v_rd_base(int lane) { return ((lane & 3) << 3) | (((lane >> 2) & 3) << 6) | (((lane >> 4) & 1) << 5) | (((lane >> 5) & 1) << 8); }
constexpr int v_rd_off(int d0, int ks, int half) { return d0 * 512 + ks * 4096 + half * 2048; }
__device__ __forceinline__ int crow(int r, int hi) { return (r & 3) + 8 * (r >> 2) + 4 * hi; }
__device__ __forceinline__ bf16x8 load8(const bf16* p) { return *reinterpret_cast<const bf16x8*>(p); }
__device__ __forceinline__ void mask_tile(f32x16& p0, f32x16& p1, int dq) {
    const float NEG = -__builtin_inff();
#pragma unroll
    for (int r = 0; r < 16; ++r) {
        const int c = (r & 3) + 8 * (r >> 2);
        if (dq - c < 0) p0[r] = NEG;
        if (dq - c - 32 < 0) p1[r] = NEG;
    }
}
__device__ __forceinline__ void partialSM(f32x16& p0, f32x16& p1, float& m_reg, float& mn, float& alpha) {
    float pmax = p0[0];
#pragma unroll
    for (int r = 1; r < 16; ++r) pmax = fmaxf(pmax, p0[r]);
#pragma unroll
    for (int r = 0; r < 16; ++r) pmax = fmaxf(pmax, p1[r]);
    { auto rr = __builtin_amdgcn_permlane32_swap(__float_as_uint(pmax), __float_as_uint(pmax), false, false);
      pmax = fmaxf(__uint_as_float(rr[0]), __uint_as_float(rr[1])); }
    constexpr float C2 = 1.4426950408889634f * SCALE;
    if (__builtin_expect(__all((pmax - m_reg) * SCALE <= THR), 1)) { mn = m_reg; alpha = 1.f; }
    else { mn = fmaxf(m_reg, pmax); alpha = __builtin_amdgcn_exp2f((m_reg - mn) * C2); m_reg = mn; }
    const float mnL = -mn * C2;
#pragma unroll
    for (int r = 0; r < 16; ++r) p0[r] = fmaf(p0[r], C2, mnL);
#pragma unroll
    for (int r = 0; r < 16; ++r) p1[r] = fmaf(p1[r], C2, mnL);
#pragma unroll
    for (int r = 0; r < 16; ++r) p0[r] = __builtin_amdgcn_exp2f(p0[r]);
}
__device__ __forceinline__ void finishSM(f32x16& p0, f32x16& p1, float alpha, float& l_reg, bf16x8& pa0, bf16x8& pa1, bf16x8& pa2, bf16x8& pa3) {
#pragma unroll
    for (int r = 0; r < 16; ++r) p1[r] = __builtin_amdgcn_exp2f(p1[r]);
    float ps = 0;
#pragma unroll
    for (int r = 0; r < 16; ++r) ps += p0[r];
#pragma unroll
    for (int r = 0; r < 16; ++r) ps += p1[r];
    { auto rr = __builtin_amdgcn_permlane32_swap(__float_as_uint(ps), __float_as_uint(ps), false, false);
      ps = __uint_as_float(rr[0]) + __uint_as_float(rr[1]); }
    l_reg = l_reg * alpha + ps;
#define PK4(P, B_, OUT) do { unsigned a0 = cvtpk(P[B_+0], P[B_+1]), a1 = cvtpk(P[B_+2], P[B_+3]);                          \
        unsigned b0 = cvtpk(P[B_+4], P[B_+5]), b1 = cvtpk(P[B_+6], P[B_+7]);                                             \
        auto r0 = __builtin_amdgcn_permlane32_swap(a0, b0, false, false); auto r1 = __builtin_amdgcn_permlane32_swap(a1, b1, false, false); \
        u32x4 w = {r0[0], r1[0], r0[1], r1[1]}; OUT = *reinterpret_cast<bf16x8*>(&w); } while (0)
    PK4(p0, 0, pa0); PK4(p0, 8, pa1); PK4(p1, 0, pa2); PK4(p1, 8, pa3);
#undef PK4
}
template <int KB>
__device__ __forceinline__ void qkt(f32x16& p0, f32x16& p1, const char* K_lds, const float* B_lds, int r32, int hi, const bf16x8* qr) {
    { const float* bp = B_lds + KB * 64 + 4 * hi;
      const f32x4 a0 = *(const f32x4*)(bp), a1 = *(const f32x4*)(bp + 8), a2 = *(const f32x4*)(bp + 16), a3 = *(const f32x4*)(bp + 24);
      const f32x4 c0 = *(const f32x4*)(bp + 32), c1 = *(const f32x4*)(bp + 40), c2 = *(const f32x4*)(bp + 48), c3 = *(const f32x4*)(bp + 56);
      p0 = (f32x16){a0[0], a0[1], a0[2], a0[3], a1[0], a1[1], a1[2], a1[3], a2[0], a2[1], a2[2], a2[3], a3[0], a3[1], a3[2], a3[3]};
      p1 = (f32x16){c0[0], c0[1], c0[2], c0[3], c1[0], c1[1], c1[2], c1[3], c2[0], c2[1], c2[2], c2[3], c3[0], c3[1], c3[2], c3[3]}; }
    const char* kb[4];
#pragma unroll
    for (int dd = 0; dd < 4; ++dd) kb[dd] = K_lds + KB * SHM_K + KSWZ(r32, (dd * 16 + hi * 8) * 2);
#pragma unroll
    for (int d0 = 0; d0 < 8; ++d0) { const char* a = kb[d0 & 3] + (d0 >> 2) * 128;
        bf16x8 b0 = *reinterpret_cast<const bf16x8*>(a);
        bf16x8 b1 = *reinterpret_cast<const bf16x8*>(a + 32 * 256);
        p0 = __builtin_amdgcn_mfma_f32_32x32x16_bf16(b0, qr[d0], p0, 0, 0, 0);
        p1 = __builtin_amdgcn_mfma_f32_32x32x16_bf16(b1, qr[d0], p1, 0, 0, 0); }
}
template <int VB>
__device__ __forceinline__ void pv_tile(f32x16* o, int vb0, bf16x8 pa0, bf16x8 pa1, bf16x8 pa2, bf16x8 pa3) {
#define TRRD(dst, off) asm volatile("ds_read_b64_tr_b16 %0, %1 offset:%2" : "=&v"(dst) : "v"(vb0), "i"(off) : "memory")
#define PV_D0(d0) do { s16x4 l0, l1, l2, l3, h0, h1, h2, h3; constexpr int b_ = VB * SHM_V + v_rd_off(d0, 0, 0); \
        TRRD(l0, b_); TRRD(h0, b_ + 2048); TRRD(l1, b_ + 4096); TRRD(h1, b_ + 6144); TRRD(l2, b_ + 8192); TRRD(h2, b_ + 10240); TRRD(l3, b_ + 12288); TRRD(h3, b_ + 14336); \
        asm volatile("s_waitcnt lgkmcnt(0)" ::: "memory"); SBAR();   \
        o[d0] = __builtin_amdgcn_mfma_f32_32x32x16_bf16(pa0, (bf16x8){l0[0], l0[1], l0[2], l0[3], h0[0], h0[1], h0[2], h0[3]}, o[d0], 0, 0, 0);   \
        o[d0] = __builtin_amdgcn_mfma_f32_32x32x16_bf16(pa1, (bf16x8){l1[0], l1[1], l1[2], l1[3], h1[0], h1[1], h1[2], h1[3]}, o[d0], 0, 0, 0);   \
        o[d0] = __builtin_amdgcn_mfma_f32_32x32x16_bf16(pa2, (bf16x8){l2[0], l2[1], l2[2], l2[3], h2[0], h2[1], h2[2], h2[3]}, o[d0], 0, 0, 0);   \
        o[d0] = __builtin_amdgcn_mfma_f32_32x32x16_bf16(pa3, (bf16x8){l3[0], l3[1], l3[2], l3[3], h3[0], h3[1], h3[2], h3[3]}, o[d0], 0, 0, 0); } while (0)
    PV_D0(0); PV_D0(1); PV_D0(2); PV_D0(3);
#undef PV_D0
#undef TRRD
}
struct BlockRef { const bf16* Q; const bf16* K; const bf16* V; const float* Bias; bf16* O; const bf16* Z; int P0, qpitch, kvpitch, nvalid, skv, canskip; float traw; };
__device__ __forceinline__ int fox_jlo(const BlockRef& r, int lane) { const float traw = r.traw;
    if (!r.canskip) return 0;
    const float bi = r.Bias[r.P0]; const int nt = r.P0 / KVBLK; int cnt = 0;
    for (int t0 = 0; t0 < nt; t0 += 64) { const int t = t0 + lane; const bool c = (t < nt) && (bi - r.Bias[(t < nt ? t : 0) * KVBLK + KVBLK - 1] > traw); cnt += __popcll(__ballot(c)); }
    return __builtin_amdgcn_readfirstlane(cnt);
}
}
struct Params;
template <class PRT> __device__ __forceinline__ fa::BlockRef attn_ref(PRT p, int L, int pass, float traw_p, float qkb, float knew);
namespace fa {
struct Seam { bf16x8 qr[8]; bf16x8 st_v0, st_v1, st_k0, st_k1; float st_b; };
#define VMW() asm volatile("s_waitcnt vmcnt(0)" ::: "memory")
#define VMWN(n) asm volatile("s_waitcnt vmcnt(%0)" :: "i"(n) : "memory")
#define SLOAD_H(Kp, Vp, Bp, pitch, k0) do { const unsigned vo_ = (unsigned)(sr * (pitch) + sc) * 2u; \
        const char* kb_ = (const char*)(Kp) + (size_t)(k0) * (size_t)(pitch) * 2; const char* vb_ = (const char*)(Vp) + (size_t)(k0) * (size_t)(pitch) * 2; const size_t r32_ = (size_t)(pitch) * 64; \
        S.st_v0 = *(const bf16x8*)(vb_ + vo_); S.st_v1 = *(const bf16x8*)(vb_ + r32_ + vo_);              \
        S.st_k0 = *(const bf16x8*)(kb_ + vo_); S.st_k1 = *(const bf16x8*)(kb_ + r32_ + vo_); S.st_b = *(const float*)((const char*)((Bp) + (k0)) + (unsigned)((tid & 63) * 4)); } while (0)
#define SWRITE_HK(bf) do { *(bf16x8*)(K_lds + (bf) * SHM_K + kws) = S.st_k0; *(bf16x8*)(K_lds + (bf) * SHM_K + kws + 32 * 256) = S.st_k1; if (tid < 64) B_lds[(bf) * 64 + tid] = S.st_b; } while (0)
#define SWRITE_HV(bf) do { *(bf16x8*)(V_lds + (bf) * SHM_V + vst0) = S.st_v0; *(bf16x8*)(V_lds + (bf) * SHM_V + vst1) = S.st_v1; } while (0)
#define SWRITE_H(bf) do { SWRITE_HV(bf); SWRITE_HK(bf); } while (0)
#define QLOAD(ref) do { const int qrow_ = wid * QBLK + r32; \
        _Pragma("unroll") for (int d0 = 0; d0 < 8; ++d0) S.qr[d0] = load8((ref).Q + (size_t)qrow_ * (ref).qpitch + d0 * 16 + hi * 8); } while (0)
__device__ __forceinline__ void fox_prime(const BlockRef& cur, char* lds, Seam& S, int wv, int jlo) {
    const int tid = tid_of(wv), wid = __builtin_amdgcn_readfirstlane(tid >> 6), lane = tid & 63, r32 = lane & 31, hi = lane >> 5;
    const int sr = tid >> 4, sc = (tid & 15) * 8, kws = KSWZ(sr, sc * 2); char* K_lds = lds + 2 * SHM_V; float* B_lds = (float*)(lds + OFF_BIAS);
    QLOAD(cur);
    SLOAD_H(cur.K, cur.V, cur.Bias, cur.kvpitch, jlo * KVBLK); VMW(); SWRITE_HK(0);
    __syncthreads();
}
template <class PRT> __device__ __forceinline__ void fox_block(PRT p, int L, int pass, int Ln, int passn, char* lds, Seam& S, int wv, int j_lo, int& jlo_next, float traw, float qkb, float knew) {
    const BlockRef cur = attn_ref<PRT>(p, L, pass, traw, qkb, knew);
    const int tid = tid_of(wv), wid = __builtin_amdgcn_readfirstlane(tid >> 6), lane = tid & 63, r32 = lane & 31, hi = lane >> 5;
    int j_hi = (cur.P0 + QB - 1) / KVBLK + 1; if (j_hi > cur.skv / KVBLK) j_hi = cur.skv / KVBLK;
    const int NT = j_hi - j_lo;
    const int qlo = cur.P0 + wid * QBLK, qm = qlo + r32 - 4 * hi;
    char* V_lds = lds; char* K_lds = lds + 2 * SHM_V;
    float* ws = (float*)(lds + OFF_WS) + wid * 64; float* li_l = ws, * al_l = ws + 32; float* B_lds = (float*)(lds + OFF_BIAS);
    float m_reg = -1e30f, l_reg = 0; f32x16 o[4] = {};
    const int sr = tid >> 4, sc = (tid & 15) * 8, vst0 = v_st(sr, sc), vst1 = v_st(32 + sr, sc), kws = KSWZ(sr, sc * 2);
    const int vb0 = (int)(uintptr_t)V_lds + v_rd_base(lane);
    const bf16* Kh = cur.K; const bf16* Vh = cur.V; const float* Bh = cur.Bias; const int kvp = cur.kvpitch;
#define RESC(a) do { if (__any((a) < 1.f)) { if (hi == 0) al_l[r32] = (a); asm volatile("s_waitcnt lgkmcnt(0)" ::: "memory");              \
                     _Pragma("unroll") for (int d_ = 0; d_ < 4; ++d_) _Pragma("unroll") for (int r = 0; r < 16; ++r) o[d_][r] *= al_l[crow(r, hi)]; } } while (0)
#define KBASE(t) ((j_lo + (t)) * KVBLK)
#define MASKT(P0_, P1_, t) do { const int kb_ = KBASE(t); if (kb_ + KVBLK - 1 > qlo) mask_tile(P0_, P1_, qm - kb_); } while (0)
    f32x16 pA0, pA1, pB0, pB1; float mnA, mnB, alA, alB; bf16x8 pa0, pa1, pa2, pa3;
    SWRITE_HV(0); SBAR();
    if (NT > 1) { SLOAD_H(Kh, Vh, Bh, kvp, KBASE(1)); }
    SBAR(); qkt<0>(pA0, pA1, K_lds, B_lds, r32, hi, S.qr);
    MASKT(pA0, pA1, 0); partialSM(pA0, pA1, m_reg, mnA, alA);
    if (NT > 1) { VMW(); SWRITE_H(1); }
    __syncthreads();
#define HALF_STEP(PX0, PX1, mnX, alX, PY0, PY1, alY, t, KB, VB, SB) do {                                                      \
        SBAR(); qkt<KB>(PX0, PX1, K_lds, B_lds, r32, hi, S.qr);                                             \
        finishSM(PY0, PY1, alY, l_reg, pa0, pa1, pa2, pa3); SBAR();                                                           \
        if ((t) + 1 < NT) { SLOAD_H(Kh, Vh, Bh, kvp, KBASE((t) + 1)); SBAR(); }                                               \
        pv_tile<VB>(o, vb0, pa0, pa1, pa2, pa3); MASKT(PX0, PX1, (t)); partialSM(PX0, PX1, m_reg, mnX, alX);                                        \
        __syncthreads();                                                                                                      \
        if ((t) + 1 < NT) { VMW(); SWRITE_H(SB); }                                                                          \
        RESC(alX); __syncthreads(); } while (0)
    for (int t = 1; t + 1 < NT; t += 2) {
        HALF_STEP(pB0, pB1, mnB, alB, pA0, pA1, alA, t, 1, 0, 0);
        HALF_STEP(pA0, pA1, mnA, alA, pB0, pB1, alB, t + 1, 0, 1, 1);
    }
    const bool even = (NT & 1) == 0;
    if (even) { SBAR(); qkt<1>(pB0, pB1, K_lds, B_lds, r32, hi, S.qr); SBAR(); }
    { int Ln_ = __builtin_amdgcn_readfirstlane(Ln), pn_ = __builtin_amdgcn_readfirstlane(passn); asm volatile("" : "+s"(Ln_), "+s"(pn_)); const BlockRef nxt = attn_ref<PRT>(p, Ln_, pn_, traw, qkb, knew);
      const int jn_ = fox_jlo(nxt, lane); jlo_next = jn_;
      SLOAD_H(nxt.K, nxt.V, nxt.Bias, nxt.kvpitch, jn_ * KVBLK); SBAR();
      QLOAD(nxt); }
    SBAR();
    finishSM(pA0, pA1, alA, l_reg, pa0, pa1, pa2, pa3); SBAR();
    pv_tile<0>(o, vb0, pa0, pa1, pa2, pa3);
    if (even) { MASKT(pB0, pB1, NT - 1); partialSM(pB0, pB1, m_reg, mnB, alB); __syncthreads(); RESC(alB);
        finishSM(pB0, pB1, alB, l_reg, pa0, pa1, pa2, pa3); SBAR(); pv_tile<1>(o, vb0, pa0, pa1, pa2, pa3); }
    SBAR(); VMWN(8); SWRITE_HK(0); SBAR();
    if (hi == 0) li_l[r32] = l_reg; asm volatile("s_waitcnt lgkmcnt(0)" ::: "memory");
    float rli[16];
#pragma unroll
    for (int r = 0; r < 16; ++r) rli[r] = __builtin_amdgcn_rcpf(li_l[crow(r, hi)]);
    int Le_ = __builtin_amdgcn_readfirstlane(L), pe_ = __builtin_amdgcn_readfirstlane(pass); asm volatile("" : "+s"(Le_), "+s"(pe_)); const BlockRef ce = attn_ref<PRT>(p, Le_, pe_, traw, qkb, knew);
#pragma unroll
    for (int r = 0; r < 16; ++r) { const int orow = wid * QBLK + crow(r, hi);
#pragma unroll
        for (int d0 = 0; d0 < 4; ++d0) { const float v = o[d0][r] * rli[r];
            const float vn = __shfl_xor(v, 1);
            if ((r32 & 1) == 0 && orow < ce.nvalid) {
                const unsigned zz = *(const unsigned*)(ce.Z + (size_t)orow * ODD_N + d0 * 32 + r32);
                *(unsigned*)(ce.O + (size_t)orow * DM + d0 * 32 + r32) = cvtpk(v * silu_f(bflo(zz)), vn * silu_f(bfhi(zz))); } } }
    __syncthreads();
#undef RESC
#undef KBASE
#undef MASKT
#undef HALF_STEP
}
#undef ROWP
#undef VMW
#undef VMWN
#undef SLOAD_H
#undef SWRITE_HK
#undef SWRITE_HV
#undef SWRITE_H
#undef QLOAD
#undef SBAR
}
struct Params { const float* in[25]; float* out; unsigned char* ws; };
typedef const __attribute__((address_space(4))) Params& PR;
__device__ __forceinline__ const __attribute__((address_space(4))) Params* params_here() { const __attribute__((address_space(4))) Params* q = (const __attribute__((address_space(4))) Params*)__builtin_amdgcn_kernarg_segment_ptr(); asm volatile("" : "+s"(q)); return q; }
enum { I_XP = 0, I_XS, I_CK, I_CV, I_CLF, I_SSD, I_SCONV, I_NPRE, I_NPOST, I_WINE, I_WOUTE, I_GWS, I_GBS, I_GGV, I_CW, I_CB, I_DTB, I_ALOG, I_DSK, I_GSSD, I_WINO, I_BF, I_WOUTO, I_GQ, I_GK };

template <int MODE> struct EpiProj {
    static constexpr bool PERM = true, AFTER_DRAIN = false;
    unsigned char* ws; float* out; const float* gq; const float* gk; float* xl; int jl;
    __device__ __forceinline__ void operator()(const pg8::f32x4 (&acc)[2][2][4][2], const pg8::Unit& u, int wr, int wc, int fr, int fq) const {
        constexpr int ldc = MODE == 0 ? 1024 : (MODE == 1 ? EVEN_N : ODD_N), n_main = ldc / 256, thin_cols = MODE == 1 ? 16 : 8;
        bf16* O = (bf16*)(ws + (MODE == 0 ? WS_O : WS_PROJ));
        const int row0 = u.pm * 256 + wr * 64 + fr;
        if (MODE == 0 || u.pn < n_main) {
            const int col0 = u.pn * 256 + wc * 32 + 8 * fq;
            const bool isv = MODE == 2 && u.pn >= 8 && u.pn < 12, isqk = MODE == 2 && u.pn < 8, isk = isqk && u.pn >= 4;
            float rs[2][2][4];
            pg8::f32x4 g0 = {1.f, 1.f, 1.f, 1.f}, g1 = {1.f, 1.f, 1.f, 1.f};
            if (MODE == 2 && isqk) {
#pragma unroll
                for (int ai = 0; ai < 2; ++ai)
#pragma unroll
                    for (int bj = 0; bj < 2; ++bj)
#pragma unroll
                        for (int m = 0; m < 4; ++m) { const pg8::f32x4 a = acc[ai][bj][m][0], b = acc[ai][bj][m][1];
                            float s = (a[0] * a[0] + a[1] * a[1]) + (a[2] * a[2] + a[3] * a[3]) + (b[0] * b[0] + b[1] * b[1]) + (b[2] * b[2] + b[3] * b[3]);
                            s += __shfl_xor(s, 16); s += __shfl_xor(s, 32);
                            if (fq == 0) xl[((((wr * 4 + wc) * 2 + ai) * 2 + bj) * 4 + m) * 16 + fr] = s; }
                asm volatile("s_waitcnt lgkmcnt(0)" ::: "memory"); __builtin_amdgcn_s_barrier(); asm volatile("" ::: "memory");
#pragma unroll
                for (int ai = 0; ai < 2; ++ai)
#pragma unroll
                    for (int bj = 0; bj < 2; ++bj)
#pragma unroll
                        for (int m = 0; m < 4; ++m) { float t = 0.f;
#pragma unroll
                            for (int w4 = 0; w4 < 4; ++w4) t += xl[((((wr * 4 + w4) * 2 + ai) * 2 + bj) * 4 + m) * 16 + fr];
                            rs[ai][bj][m] = rsqrtf(t * (1.f / 128.f) + EPS); }
                const float* gp = (isk ? gk : gq) + wc * 32 + 8 * fq; g0 = *(const pg8::f32x4*)gp; g1 = *(const pg8::f32x4*)(gp + 4);
            }
#pragma unroll
            for (int ai = 0; ai < 2; ++ai)
#pragma unroll
                for (int m = 0; m < 4; ++m) { const int row = row0 + ai * 128 + m * 16; bf16* rowp = O + (size_t)row * ldc + col0;
#pragma unroll
                    for (int bj = 0; bj < 2; ++bj) { pg8::f32x4 v0 = acc[ai][bj][m][0], v1 = acc[ai][bj][m][1];
                        if (MODE == 2 && isqk) { v0 = v0 * rs[ai][bj][m] * g0; v1 = v1 * rs[ai][bj][m] * g1; }
                        u32x4 w; w.x = cvtpk(v0[0], v0[1]); w.y = cvtpk(v0[2], v0[3]); w.z = cvtpk(v1[0], v1[1]); w.w = cvtpk(v1[2], v1[3]);
                        *(u32x4*)(rowp + bj * 128) = w;
                        if (MODE == 2 && (isv || isk)) { const int vc = col0 - (isv ? 2048 : 1024) + bj * 128; const bool samp = row >= TP;
                            float* vo = out + (isv ? (samp ? O_VS + ((size_t)jl * TS + (row - TP)) * DM : O_VP + ((size_t)jl * TP + row) * DM)
                                                   : (samp ? O_KS + ((size_t)jl * TS + (row - TP)) * DM : O_KP + ((size_t)jl * TP + row) * DM)) + vc;
                            *(pg8::f32x4*)vo = v0; *(pg8::f32x4*)(vo + 4) = v1;
                            if (samp) { const int sr = row - TP; *(u32x4*)((bf16*)(ws + (isv ? WS_VS : WS_KS)) + ((size_t)(sr / SSEQ) * SKS + PAST + (sr % SSEQ)) * DM + vc) = w; } } } }
        } else if (MODE != 0) {
            if (wc == 0 && 8 * fq < thin_cols) { float* thin = (float*)(ws + (MODE == 1 ? WS_DTRAW : WS_FLOG));
#pragma unroll
                for (int ai = 0; ai < 2; ++ai)
#pragma unroll
                    for (int m = 0; m < 4; ++m) { float* tp = thin + (size_t)(row0 + ai * 128 + m * 16) * thin_cols + 8 * fq;
                        *(pg8::f32x4*)tp = acc[ai][0][m][0]; *(pg8::f32x4*)(tp + 4) = acc[ai][0][m][1]; }
            }
        }
    }
};

__device__ __forceinline__ void transpose_item(const float* W, int K, int N, bf16* WT, float* scr, int item, int nblk, int lane) {
    const int kb = item / nblk, nb = item % nblk, k0 = 64 * kb, n0 = 32 * nb;
    const int ncol = n0 + (lane & 31);
#pragma unroll 8
    for (int i = 0; i < 32; ++i) { const int kk = 2 * i + (lane >> 5); scr[kk * 33 + (lane & 31)] = (ncol < N) ? W[(size_t)(k0 + kk) * N + ncol] : 0.f; }
    asm volatile("s_waitcnt lgkmcnt(0)" ::: "memory");
    const int c = lane & 7;
#pragma unroll
    for (int j = 0; j < 4; ++j) { const int n = (lane >> 3) + 8 * j; const float* s = scr + (8 * c) * 33 + n;
        u32x4 o; o.x = cvtpk(s[0 * 33], s[1 * 33]); o.y = cvtpk(s[2 * 33], s[3 * 33]); o.z = cvtpk(s[4 * 33], s[5 * 33]); o.w = cvtpk(s[6 * 33], s[7 * 33]);
        *(u32x4*)(WT + (size_t)(n0 + n) * K + k0 + 8 * c) = o; }
    asm volatile("s_waitcnt lgkmcnt(0)" ::: "memory");
}
__device__ __forceinline__ void phase_prologue(int wv, PR p, char* lds) {
    const int tid = tid_of(wv), lane = tid & 63, wave = __builtin_amdgcn_readfirstlane(tid >> 6), gw = bid_here() * 8 + wave, NGW = gridDim.x * 8;
    float* scr = (float*)(lds + wave * 8704);
    constexpr int I0 = 16 * (EVEN_NP / 32), I1 = 32 * 32, I2 = 16 * (ODD_NP / 32), I3 = 16 * 32;
    constexpr int NIT = 2 * (I0 + I1 + I2 + I3);
    for (int it = gw; it < NIT; it += NGW) {
        int r = it; const int j = r & 1; r >>= 1;
        if (r < I0) { transpose_item(p.in[I_WINE] + (size_t)j * 1024 * EVEN_IN, 1024, EVEN_IN, (bf16*)(p.ws + WS_WINE) + (size_t)j * EVEN_NP * 1024, scr, r, EVEN_NP / 32, lane); continue; } r -= I0;
        if (r < I1) { transpose_item(p.in[I_WOUTE] + (size_t)j * 2048 * 1024, 2048, 1024, (bf16*)(p.ws + WS_WOUTE) + (size_t)j * 1024 * 2048, scr, r, 32, lane); continue; } r -= I1;
        if (r < I2) { transpose_item(p.in[I_WINO] + (size_t)j * 1024 * ODD_IN, 1024, ODD_IN, (bf16*)(p.ws + WS_WINO) + (size_t)j * ODD_NP * 1024, scr, r, ODD_NP / 32, lane); continue; } r -= I2;
        transpose_item(p.in[I_WOUTO] + (size_t)j * 1024 * 1024, 1024, 1024, (bf16*)(p.ws + WS_WOUTO) + (size_t)j * 1024 * 1024, scr, r, 32, lane);
    }
}

#define NCOL(jj) (512 * ((jj) >> 1) + 8 * lane + 4 * ((jj) & 1))
__device__ __forceinline__ void phase_norm(int wv, PR p, int li) {
    const int tid = tid_of(wv), lane = tid & 63, wave = __builtin_amdgcn_readfirstlane(tid >> 6), gw = bid_here() * 8 + wave, NGW = gridDim.x * 8;
    bf16* resb = (bf16*)(p.ws + WS_RES); const bf16* ob = (const bf16*)(p.ws + WS_O); bf16* hb = (bf16*)(p.ws + WS_H);
    const float* gpost = p.in[I_NPOST] + (li > 0 ? (li - 1) * DM : 0); const float* gpre = p.in[I_NPRE] + (li < 4 ? li * DM : 0);
    f32x4 gpo[4], gpr[4];
#pragma unroll
    for (int j = 0; j < 4; ++j) { gpo[j] = *(const f32x4*)(gpost + NCOL(j)); gpr[j] = *(const f32x4*)(gpre + NCOL(j)); }
    for (int row0 = gw; row0 < TT; row0 += 2 * NGW) {
        int rows[2] = {row0, row0 + NGW}; const bool v1 = rows[1] < TT; if (!v1) rows[1] = row0;
        f32x4 x[2][4]; u32x4 ow[2][2];
#pragma unroll
        for (int k = 0; k < 2; ++k) { const int row = rows[k];
            if (li <= 1) { const float* xin = row < TP ? p.in[I_XP] + (size_t)row * DM : p.in[I_XS] + (size_t)(row - TP) * DM;
#pragma unroll
                for (int j = 0; j < 4; ++j) x[k][j] = *(const f32x4*)(xin + NCOL(j)); }
            else {
#pragma unroll
                for (int hf = 0; hf < 2; ++hf) { const u32x4 w = *(const u32x4*)(resb + (size_t)row * DM + 512 * hf + 8 * lane);
                    x[k][2 * hf] = (f32x4){bflo(w.x), bfhi(w.x), bflo(w.y), bfhi(w.y)}; x[k][2 * hf + 1] = (f32x4){bflo(w.z), bfhi(w.z), bflo(w.w), bfhi(w.w)}; } }
            if (li > 0) {
#pragma unroll
                for (int hf = 0; hf < 2; ++hf) ow[k][hf] = *(const u32x4*)(ob + (size_t)row * DM + 512 * hf + 8 * lane); } }
#pragma unroll
        for (int k = 0; k < 2; ++k) { const int row = rows[k]; if (k == 1 && !v1) break;
            if (li > 0) {
                f32x4 o[4]; float s = 0.f;
#pragma unroll
                for (int hf = 0; hf < 2; ++hf) { const u32x4 w = ow[k][hf];
                    o[2 * hf] = (f32x4){bflo(w.x), bfhi(w.x), bflo(w.y), bfhi(w.y)}; o[2 * hf + 1] = (f32x4){bflo(w.z), bfhi(w.z), bflo(w.w), bfhi(w.w)}; }
#pragma unroll
                for (int j = 0; j < 4; ++j) s += (o[j].x * o[j].x + o[j].y * o[j].y) + (o[j].z * o[j].z + o[j].w * o[j].w);
                const float r = rsqrtf(wave_sum(s) * (1.f / DM) + EPS);
#pragma unroll
                for (int j = 0; j < 4; ++j) x[k][j] = x[k][j] + o[j] * r * gpo[j];
                if (li == 4) {
#pragma unroll
                    for (int j = 0; j < 4; ++j) *(f32x4*)(p.out + (size_t)row * DM + NCOL(j)) = x[k][j]; }
                else {
#pragma unroll
                    for (int hf = 0; hf < 2; ++hf) { const f32x4 a = x[k][2 * hf], b = x[k][2 * hf + 1]; u32x4 w; w.x = cvtpk(a.x, a.y); w.y = cvtpk(a.z, a.w); w.z = cvtpk(b.x, b.y); w.w = cvtpk(b.z, b.w);
                        *(u32x4*)(resb + (size_t)row * DM + 512 * hf + 8 * lane) = w;
                        x[k][2 * hf] = (f32x4){bflo(w.x), bfhi(w.x), bflo(w.y), bfhi(w.y)}; x[k][2 * hf + 1] = (f32x4){bflo(w.z), bfhi(w.z), bflo(w.w), bfhi(w.w)}; } }
            }
            if (li < 4) {
                float s = 0.f;
#pragma unroll
                for (int j = 0; j < 4; ++j) s += (x[k][j].x * x[k][j].x + x[k][j].y * x[k][j].y) + (x[k][j].z * x[k][j].z + x[k][j].w * x[k][j].w);
                const float r = rsqrtf(wave_sum(s) * (1.f / DM) + EPS);
#pragma unroll
                for (int hf = 0; hf < 2; ++hf) { const f32x4 a = x[k][2 * hf] * r * gpr[2 * hf], b = x[k][2 * hf + 1] * r * gpr[2 * hf + 1];
                    u32x4 w; w.x = cvtpk(a.x, a.y); w.y = cvtpk(a.z, a.w); w.z = cvtpk(b.x, b.y); w.w = cvtpk(b.z, b.w); *(u32x4*)(hb + (size_t)row * DM + 512 * hf + 8 * lane) = w; }
            }
        }
    }
}
#undef NCOL

constexpr int NCHP = TP / 64, NCH = NCHP + NSB;
constexpr size_t A_XT = 0, A_B = A_XT + (size_t)NCH * 16 * 64 * 64 * 2, A_C = A_B + (size_t)NCH * 64 * 256 * 2, A_BT = A_C + (size_t)NCH * 64 * 256 * 2;
constexpr size_t A_DT = A_BT + (size_t)NCH * 2 * 128 * 64 * 2, A_ACS = A_DT + (size_t)NCH * 16 * 64 * 4, A_W = A_ACS + (size_t)NCH * 16 * 64 * 4, A_END = A_W + (size_t)NCH * 16 * 64 * 4;
static_assert(A_END <= 163 * MiB, "act layouts");
__device__ __forceinline__ void phase_conv(int wv, PR p, int jl) {
    const int tid = tid_of(wv), lane = tid & 63, wave = __builtin_amdgcn_readfirstlane(tid >> 6);
    const int gtid = bid_here() * 512 + tid, gthreads = gridDim.x * 512;
    const bf16* proj = (const bf16*)(p.ws + WS_PROJ);
    bf16* XT = (bf16*)(p.ws + WS_ACT + A_XT); bf16* Bact = (bf16*)(p.ws + WS_ACT + A_B); bf16* Cact = (bf16*)(p.ws + WS_ACT + A_C); bf16* BT = (bf16*)(p.ws + WS_ACT + A_BT);
    const float* cw = p.in[I_CW] + (size_t)jl * CONV_DIM * 4; const float* cb = p.in[I_CB] + (size_t)jl * CONV_DIM;
    constexpr int NCG = CONV_DIM / 8;
    for (int idx = gtid; idx < NCH * NCG; idx += gthreads) {
        const int ch = idx / NCG, cgp = idx - ch * NCG, c0 = cgp * 8;
        int row0, Lv, b; bool samp, first, lastc;
        if (ch < NCHP) { b = ch >> 7; const int t0 = (ch & 127) * 64; row0 = b * SEQ + t0; Lv = 64; samp = false; first = (t0 == 0); lastc = (t0 + 64 == SEQ); }
        else { b = ch - NCHP; row0 = TP + b * SSEQ; Lv = SSEQ; samp = true; first = true; lastc = true; }
        float w[8][4], bias[8], xm3[8], xm2[8], xm1[8];
#pragma unroll
        for (int e = 0; e < 8; ++e) { const f32x4 t = *(const f32x4*)(cw + (size_t)(c0 + e) * 4); w[e][0] = t.x; w[e][1] = t.y; w[e][2] = t.z; w[e][3] = t.w; bias[e] = cb[c0 + e]; }
        if (first) {
            if (samp) { const float* sc = p.in[I_SCONV] + ((size_t)(jl * NSB + b) * 3) * CONV_DIM + c0;
#pragma unroll
                for (int e = 0; e < 8; ++e) { xm3[e] = sc[e]; xm2[e] = sc[CONV_DIM + e]; xm1[e] = sc[2 * CONV_DIM + e]; } }
            else {
#pragma unroll
                for (int e = 0; e < 8; ++e) { xm3[e] = 0.f; xm2[e] = 0.f; xm1[e] = 0.f; } }
        } else {
            unpack8(*(const u32x4*)(proj + (size_t)(row0 - 3) * EVEN_N + 4096 + c0), xm3);
            unpack8(*(const u32x4*)(proj + (size_t)(row0 - 2) * EVEN_N + 4096 + c0), xm2);
            unpack8(*(const u32x4*)(proj + (size_t)(row0 - 1) * EVEN_N + 4096 + c0), xm1);
        }
        u32x4 nx[8];
#pragma unroll
        for (int t = 0; t < 8; ++t) nx[t] = *(const u32x4*)(proj + (size_t)(row0 + t) * EVEN_N + 4096 + c0);
#pragma unroll 1
        for (int tb = 0; tb < 8; ++tb) {
            float v[8][8];
            if (8 * tb < Lv) {
                u32x4 cur[8];
#pragma unroll
                for (int t = 0; t < 8; ++t) cur[t] = nx[t];
                if (8 * (tb + 1) < Lv) {
#pragma unroll
                    for (int t = 0; t < 8; ++t) nx[t] = *(const u32x4*)(proj + (size_t)(row0 + 8 * (tb + 1) + t) * EVEN_N + 4096 + c0); }
#pragma unroll
                for (int t = 0; t < 8; ++t) { float x[8]; unpack8(cur[t], x);
#pragma unroll
                    for (int e = 0; e < 8; ++e) { const float y = bias[e] + xm3[e] * w[e][0] + xm2[e] * w[e][1] + xm1[e] * w[e][2] + x[e] * w[e][3]; v[t][e] = silu_f(y); xm3[e] = xm2[e]; xm2[e] = xm1[e]; xm1[e] = x[e]; } }
            } else {
#pragma unroll
                for (int t = 0; t < 8; ++t)
#pragma unroll
                    for (int e = 0; e < 8; ++e) v[t][e] = 0.f;
            }
            if (c0 < 1024 || (c0 >= 1024 && c0 < 1280)) {
                bf16* dst = (c0 < 1024) ? XT + ((((size_t)ch * 16 + (c0 >> 6)) * 8 + tb) * 64 + (c0 & 63)) * 8 : BT + ((((size_t)ch * 2 + ((c0 - 1024) >> 7)) * 8 + tb) * 128 + ((c0 - 1024) & 127)) * 8;
#pragma unroll
                for (int e = 0; e < 8; ++e) { u32x4 o; o.x = cvtpk(v[0][e], v[1][e]); o.y = cvtpk(v[2][e], v[3][e]); o.z = cvtpk(v[4][e], v[5][e]); o.w = cvtpk(v[6][e], v[7][e]); *(u32x4*)(dst + (size_t)e * 8) = o; }
            }
            if (c0 >= 1024) {
                bf16* dst = (c0 < 1280 ? Bact + (c0 - 1024) : Cact + (c0 - 1280)) + ((size_t)ch * 64 + 8 * tb) * 256;
#pragma unroll
                for (int t = 0; t < 8; ++t) *(u32x4*)(dst + (size_t)t * 256) = pack8f(v[t]);
            }
        }
        if (lastc) {
            float* co = p.out + (samp ? O_CS + ((size_t)(jl * NSB + b) * 3) * CONV_DIM : O_CP + ((size_t)(jl * NB + b) * 3) * CONV_DIM) + c0;
#pragma unroll
            for (int e = 0; e < 8; ++e) { co[e] = xm3[e]; co[CONV_DIM + e] = xm2[e]; co[2 * CONV_DIM + e] = xm1[e]; }
        }
    }
    { const float* dtraw = (const float*)(p.ws + WS_DTRAW); float* DT = (float*)(p.ws + WS_ACT + A_DT); float* ACS = (float*)(p.ws + WS_ACT + A_ACS); float* WW = (float*)(p.ws + WS_ACT + A_W);
      const int gw = bid_here() * 8 + wave, NGW = gridDim.x * 8;
      for (int it = gw; it < NCH * 16; it += NGW) { const int ch = it >> 4, h = it & 15;
          const int row = (ch < NCHP) ? ch * 64 + lane : TP + (ch - NCHP) * SSEQ + lane; const bool valid = (ch < NCHP) || lane < SSEQ;
          float dt = 0.f; if (valid) dt = softplus_f(dtraw[(size_t)row * 16 + h] + p.in[I_DTB][jl * 16 + h]);
          const float a_h = -__expf(p.in[I_ALOG][jl * 16 + h]);
          float acs = dt * a_h;
#pragma unroll
          for (int o = 1; o < 64; o <<= 1) { const float t = __shfl_up(acs, o); if (lane >= o) acs += t; }
          const float alast = __shfl(acs, 63);
          DT[(size_t)it * 64 + lane] = dt; ACS[(size_t)it * 64 + lane] = acs; WW[(size_t)it * 64 + lane] = dt * __expf(alast - acs); } }
}

constexpr int GM_WSTR = 136;
__device__ __forceinline__ void phase_gmlp(int wv, PR p, int jl, char* lds) {
    const int tid = tid_of(wv), lane = tid & 63, wave = tid >> 6;
    const bf16* proj = (const bf16*)(p.ws + WS_PROJ); bf16* cat = (bf16*)(p.ws + WS_CAT);
    bf16* Wl = (bf16*)lds; bf16* vT = (bf16*)(lds + 128 * GM_WSTR * 2);
    constexpr int NU = (TP / 128 + NSB) * 4;
    for (int u = bid_here(); u < NU; u += gridDim.x) {
        const int g = u & 3, cu = u >> 2;
        int row0, n; bool samp; int sb = 0;
        if (cu < TP / 128) { row0 = cu * 128; n = 128; samp = false; } else { sb = cu - TP / 128; row0 = TP + sb * SSEQ; n = SSEQ; samp = true; }
        __syncthreads();
        { const int j = tid >> 2, q = tid & 3; const bool valid = j < n;
          float v[64]; float ss = 0.f;
          const float* gv = p.in[I_GGV] + (size_t)(jl * 4 + g) * 256;
#pragma unroll
          for (int i = 0; i < 8; ++i) { const int cc = (q + 4 * i) * 8;
              u32x4 w = {0u, 0u, 0u, 0u}; if (valid) w = *(const u32x4*)(proj + (size_t)(row0 + j) * EVEN_N + 1024 + g * 256 + cc);
              float f[8]; unpack8(w, f);
#pragma unroll
              for (int e = 0; e < 8; e += 2) { const f32x2 gg = pg8::gelu_pk((f32x2){f[e], f[e + 1]}); v[i * 8 + e] = gg.x; v[i * 8 + e + 1] = gg.y; ss += gg.x * gg.x + gg.y * gg.y; } }
          ss += __shfl_xor(ss, 1); ss += __shfl_xor(ss, 2);
          const float r = rsqrtf(ss * (1.f / 256.f) + EPS);
#pragma unroll
          for (int i = 0; i < 8; ++i) { const int cc = (q + 4 * i) * 8;
#pragma unroll
              for (int e = 0; e < 8; ++e) v[i * 8 + e] = v[i * 8 + e] * r * gv[cc + e];
              if (samp && valid) { float* go = p.out + O_GV + ((size_t)(jl * NSB + sb) * SSEQ + j) * DM + g * 256 + cc;
                  *(f32x4*)go = (f32x4){v[i * 8], v[i * 8 + 1], v[i * 8 + 2], v[i * 8 + 3]}; *(f32x4*)(go + 4) = (f32x4){v[i * 8 + 4], v[i * 8 + 5], v[i * 8 + 6], v[i * 8 + 7]}; }
#pragma unroll
              for (int e = 0; e < 8; e += 2) { const unsigned pk = cvtpk(v[i * 8 + e], v[i * 8 + e + 1]); vT[(cc + e) * GM_WSTR + j] = (bf16)(pk & 0xffffu); vT[(cc + e + 1) * GM_WSTR + j] = (bf16)(pk >> 16); } }
        }
        { const int i = tid >> 2, jq = tid & 3; const float* wsrc = p.in[I_GWS] + ((size_t)(jl * 4 + g) * 128 + i) * 128 + jq * 32;
#pragma unroll
          for (int c = 0; c < 4; ++c) { float f[8];
              const f32x4 a = *(const f32x4*)(wsrc + c * 8), b = *(const f32x4*)(wsrc + c * 8 + 4);
              f[0] = a.x; f[1] = a.y; f[2] = a.z; f[3] = a.w; f[4] = b.x; f[5] = b.y; f[6] = b.z; f[7] = b.w;
              const int j0 = jq * 32 + c * 8;
              const bool keep = (i < n) && (j0 < n) && ((j0 >> 6) <= (i >> 6));
              if (!keep) {
#pragma unroll
                  for (int e = 0; e < 8; ++e) f[e] = 0.f; }
              *(u32x4*)(Wl + i * GM_WSTR + j0) = pack8f(f); } }
        __syncthreads();
        const int wi = wave >> 2, wj = wave & 3, fr = lane & 15, fq = lane >> 4;
        f32x4 acc[4][4];
#pragma unroll
        for (int a = 0; a < 4; ++a)
#pragma unroll
            for (int b = 0; b < 4; ++b) acc[a][b] = (f32x4){0.f, 0.f, 0.f, 0.f};
        const int nks = (wi == 0) ? 2 : 4;
        for (int ks = 0; ks < nks; ++ks) {
            bf16x8 af[4], bfr[4];
#pragma unroll
            for (int mi = 0; mi < 4; ++mi) af[mi] = *(const bf16x8*)(Wl + (64 * wi + 16 * mi + fr) * GM_WSTR + ks * 32 + fq * 8);
#pragma unroll
            for (int ni = 0; ni < 4; ++ni) bfr[ni] = *(const bf16x8*)(vT + (64 * wj + 16 * ni + fr) * GM_WSTR + ks * 32 + fq * 8);
#pragma unroll
            for (int ni = 0; ni < 4; ++ni)
#pragma unroll
                for (int mi = 0; mi < 4; ++mi) acc[ni][mi] = __builtin_amdgcn_mfma_f32_16x16x32_bf16(bfr[ni], af[mi], acc[ni][mi], 0, 0, 0);
        }
        const float* bs = p.in[I_GBS] + (size_t)(jl * 4 + g) * 128;
#pragma unroll
        for (int mi = 0; mi < 4; ++mi) { const int i = 64 * wi + 16 * mi + fr;
            if (i < n) { const float bsi = bs[i]; const size_t rb = (size_t)(row0 + i) * EVEN_N;
#pragma unroll
                for (int ni = 0; ni < 4; ++ni) { const int col = g * 256 + 64 * wj + 16 * ni + 4 * fq;
                    const u32x2 uu = *(const u32x2*)(proj + rb + col), zz = *(const u32x2*)(proj + rb + 2048 + col);
                    const f32x2 g0 = pg8::gelu_pk((f32x2){bflo(uu.x), bfhi(uu.x)}), g1 = pg8::gelu_pk((f32x2){bflo(uu.y), bfhi(uu.y)});
                    const f32x4 s = acc[ni][mi] + bsi;
                    u32x2 o; o.x = cvtpk(silu_f(bflo(zz.x)) * g0.x * s.x, silu_f(bfhi(zz.x)) * g0.y * s.y); o.y = cvtpk(silu_f(bflo(zz.y)) * g1.x * s.z, silu_f(bfhi(zz.y)) * g1.y * s.w);
                    *(u32x2*)(cat + (size_t)(row0 + i) * 2048 + col) = o; } } }
    }
}

__device__ __forceinline__ void phase_scan(int wv, PR p, int jl, char* lds) {
    const int tid = tid_of(wv), lane = tid & 63, wave = __builtin_amdgcn_readfirstlane(tid >> 6), fr = lane & 15, fq = lane >> 4;
    const bf16* XT = (const bf16*)(p.ws + WS_ACT + A_XT); const bf16* Bact = (const bf16*)(p.ws + WS_ACT + A_B); const bf16* Cact = (const bf16*)(p.ws + WS_ACT + A_C); const bf16* BT = (const bf16*)(p.ws + WS_ACT + A_BT);
    const float* DT = (const float*)(p.ws + WS_ACT + A_DT); const float* ACS = (const float*)(p.ws + WS_ACT + A_ACS); const float* WW = (const float*)(p.ws + WS_ACT + A_W);
    bf16* yb = (bf16*)(p.ws + WS_O);
    bf16* Cs = (bf16*)lds; bf16* Bs = Cs + 64 * 136; bf16* BTs = Bs + 64 * 136; bf16* XTs = BTs + 128 * 72; bf16* Ms = XTs + 16 * 72; bf16* Sb = Ms + 64 * 72;
    float* DTs = (float*)(Sb + 2 * 16 * 136); float* ACSs = DTs + 64; float* Ws = ACSs + 64;
    constexpr int NITEM = NB * 64 + NSB * 64;
    for (int it = vcu_here(); it < NITEM; it += gridDim.x) {
        int seq, h, pq, ch0, nch; bool samp;
        if (it < NB * 64) { seq = it >> 6; h = (it >> 2) & 15; pq = it & 3; ch0 = seq * 128; nch = 128; samp = false; }
        else { const int r = it - NB * 64; seq = r >> 6; h = (r >> 2) & 15; pq = r & 3; ch0 = NCHP + seq; nch = 1; samp = true; }
        const int g = h >> 3; const float dsk = p.in[I_DSK][jl * 16 + h];
        f32x4 accS = {0.f, 0.f, 0.f, 0.f};
        __syncthreads();
        { float* st = nullptr; if (samp) st = (float*)p.in[I_SSD] + (((size_t)(jl * NSB + seq) * 16 + h) * 64 + 16 * pq) * 128;
#pragma unroll
          for (int e = 0; e < 4; ++e) { if (samp) accS[e] = st[(size_t)(4 * fq + e) * 128 + 16 * wave + fr]; Sb[(4 * fq + e) * 136 + 16 * wave + fr] = (bf16)(cvtpk(accS[e], 0.f) & 0xffffu); } }
        u32x4 rC0, rC1, rB0, rB1, rT0, rT1, rX; float rS = 0.f;
#define SSD_LOAD(ch) do { const size_t cb_ = (size_t)(ch) * 64 * 256 + g * 128; \
        rC0 = *(const u32x4*)(Cact + cb_ + (size_t)(tid >> 4) * 256 + (tid & 15) * 8); rC1 = *(const u32x4*)(Cact + cb_ + (size_t)(32 + (tid >> 4)) * 256 + (tid & 15) * 8); \
        rB0 = *(const u32x4*)(Bact + cb_ + (size_t)(tid >> 4) * 256 + (tid & 15) * 8); rB1 = *(const u32x4*)(Bact + cb_ + (size_t)(32 + (tid >> 4)) * 256 + (tid & 15) * 8); \
        const bf16* bt_ = BT + ((size_t)(ch) * 2 + g) * 128 * 64; rT0 = *(const u32x4*)(bt_ + ((size_t)(tid & 7) * 128 + (tid >> 3)) * 8); rT1 = *(const u32x4*)(bt_ + ((size_t)(tid & 7) * 128 + 64 + (tid >> 3)) * 8); \
        if (tid < 128) rX = *(const u32x4*)(XT + ((((size_t)(ch) * 16 + h) * 8 + (tid & 7)) * 64 + 16 * pq + (tid >> 3)) * 8); \
        else if (tid < 320) { const int k_ = (tid - 128) >> 6; const float* src_ = k_ == 0 ? DT : (k_ == 1 ? ACS : WW); rS = src_[((size_t)(ch) * 16 + h) * 64 + (tid & 63)]; } } while (0)
        SSD_LOAD(ch0);
        for (int c = 0; c < nch; ++c) {
            const int ch = ch0 + c;
            __syncthreads();
            *(u32x4*)(Cs + (tid >> 4) * 136 + (tid & 15) * 8) = rC0; *(u32x4*)(Cs + (32 + (tid >> 4)) * 136 + (tid & 15) * 8) = rC1;
            *(u32x4*)(Bs + (tid >> 4) * 136 + (tid & 15) * 8) = rB0; *(u32x4*)(Bs + (32 + (tid >> 4)) * 136 + (tid & 15) * 8) = rB1;
            *(u32x4*)(BTs + (tid >> 3) * 72 + (tid & 7) * 8) = rT0; *(u32x4*)(BTs + (64 + (tid >> 3)) * 72 + (tid & 7) * 8) = rT1;
            if (tid < 128) *(u32x4*)(XTs + (tid >> 3) * 72 + (tid & 7) * 8) = rX;
            else if (tid < 320) DTs[tid - 128] = rS;
            __syncthreads();
            if (c + 1 < nch) SSD_LOAD(ch + 1);
            { const int lt = wave >> 1, sth = wave & 1;
              f32x4 a0 = {0.f, 0.f, 0.f, 0.f}, a1 = {0.f, 0.f, 0.f, 0.f};
              if (2 * sth <= lt) {
#pragma unroll
                  for (int kk = 0; kk < 4; ++kk) { const bf16x8 yf = *(const bf16x8*)(Cs + (16 * lt + fr) * 136 + 32 * kk + 8 * fq);
                      const bf16x8 x0 = *(const bf16x8*)(Bs + (32 * sth + fr) * 136 + 32 * kk + 8 * fq), x1 = *(const bf16x8*)(Bs + (32 * sth + 16 + fr) * 136 + 32 * kk + 8 * fq);
                      a0 = __builtin_amdgcn_mfma_f32_16x16x32_bf16(x0, yf, a0, 0, 0, 0); a1 = __builtin_amdgcn_mfma_f32_16x16x32_bf16(x1, yf, a1, 0, 0, 0); } }
              const int l = 16 * lt + fr; const float al = ACSs[l];
#pragma unroll
              for (int j = 0; j < 2; ++j) { const int s0 = 32 * sth + 16 * j + 4 * fq; const f32x4 as = *(const f32x4*)(ACSs + s0), ds = *(const f32x4*)(DTs + s0); const f32x4 ga = j ? a1 : a0; float m[4];
#pragma unroll
                  for (int e = 0; e < 4; ++e) m[e] = (s0 + e <= l) ? ga[e] * __expf(al - as[e]) * ds[e] : 0.f;
                  u32x2 o; o.x = cvtpk(m[0], m[1]); o.y = cvtpk(m[2], m[3]); *(u32x2*)(Ms + l * 72 + s0) = o; } }
            { const float dec = __expf(ACSs[63]);
#pragma unroll
              for (int e = 0; e < 4; ++e) accS[e] *= dec;
#pragma unroll
              for (int kk = 0; kk < 2; ++kk) { float xf[8]; unpack8(*(const u32x4*)(XTs + fr * 72 + 32 * kk + 8 * fq), xf);
                  const f32x4 w0 = *(const f32x4*)(Ws + 32 * kk + 8 * fq), w1 = *(const f32x4*)(Ws + 32 * kk + 8 * fq + 4);
                  xf[0] *= w0.x; xf[1] *= w0.y; xf[2] *= w0.z; xf[3] *= w0.w; xf[4] *= w1.x; xf[5] *= w1.y; xf[6] *= w1.z; xf[7] *= w1.w;
                  const u32x4 xw = pack8f(xf); const bf16x8 bfrag = *(const bf16x8*)(BTs + (16 * wave + fr) * 72 + 32 * kk + 8 * fq);
                  accS = __builtin_amdgcn_mfma_f32_16x16x32_bf16(*(const bf16x8*)&xw, bfrag, accS, 0, 0, 0); }
              bf16* sbn = Sb + ((c + 1) & 1) * 16 * 136;
#pragma unroll
              for (int e = 0; e < 4; ++e) sbn[(4 * fq + e) * 136 + 16 * wave + fr] = (bf16)(cvtpk(accS[e], 0.f) & 0xffffu); }
            __syncthreads();
            if (wave < 4) { const bf16* sbc = Sb + (c & 1) * 16 * 136; f32x4 ay = {0.f, 0.f, 0.f, 0.f};
#pragma unroll
                for (int kk = 0; kk < 4; ++kk) ay = __builtin_amdgcn_mfma_f32_16x16x32_bf16(*(const bf16x8*)(sbc + fr * 136 + 32 * kk + 8 * fq), *(const bf16x8*)(Cs + (16 * wave + fr) * 136 + 32 * kk + 8 * fq), ay, 0, 0, 0);
                const float el = __expf(ACSs[16 * wave + fr]);
#pragma unroll
                for (int e = 0; e < 4; ++e) ay[e] *= el;
                ay = __builtin_amdgcn_mfma_f32_16x16x32_bf16(*(const bf16x8*)(XTs + fr * 72 + 8 * fq), *(const bf16x8*)(Ms + (16 * wave + fr) * 72 + 8 * fq), ay, 0, 0, 0);
                if (wave >= 2) ay = __builtin_amdgcn_mfma_f32_16x16x32_bf16(*(const bf16x8*)(XTs + fr * 72 + 32 + 8 * fq), *(const bf16x8*)(Ms + (16 * wave + fr) * 72 + 32 + 8 * fq), ay, 0, 0, 0);
                const int l = 16 * wave + fr;
#pragma unroll
                for (int e = 0; e < 4; ++e) ay[e] += dsk * bf2f(XTs[(4 * fq + e) * 72 + l]);
                if (!samp || l < SSEQ) { const size_t row = samp ? (size_t)TP + seq * SSEQ + l : (size_t)ch * 64 + l;
                    u32x2 o; o.x = cvtpk(ay[0], ay[1]); o.y = cvtpk(ay[2], ay[3]); *(u32x2*)(yb + row * DM + h * 64 + 16 * pq + 4 * fq) = o; } }
        }
#undef SSD_LOAD
        { float* so = p.out + (samp ? O_SS + (((size_t)(jl * NSB + seq) * 16 + h) * 64 + 16 * pq) * 128 : O_SP + (((size_t)(jl * NB + seq) * 16 + h) * 64 + 16 * pq) * 128);
#pragma unroll
          for (int e = 0; e < 4; ++e) so[(size_t)(4 * fq + e) * 128 + 16 * wave + fr] = accS[e]; }
    }
}

__device__ __forceinline__ void phase_gate(int wv, PR p, int jl) {
    const int tid = tid_of(wv), lane = tid & 63, wave = __builtin_amdgcn_readfirstlane(tid >> 6), gw = bid_here() * 8 + wave, NGW = gridDim.x * 8;
    const bf16* proj = (const bf16*)(p.ws + WS_PROJ); const bf16* yb = (const bf16*)(p.ws + WS_O); bf16* cat = (bf16*)(p.ws + WS_CAT);
    const float* gs = p.in[I_GSSD] + (size_t)jl * 1024;
    float gsv[2][8];
#pragma unroll
    for (int gg = 0; gg < 2; ++gg)
#pragma unroll
        for (int e = 0; e < 8; ++e) gsv[gg][e] = gs[gg * 512 + 8 * lane + e];
    for (int row0 = gw; row0 < TT; row0 += 2 * NGW) {
        int rows[2] = {row0, row0 + NGW}; const bool v1 = rows[1] < TT; if (!v1) rows[1] = row0;
        u32x4 yw[2][2], zw[2][2];
#pragma unroll
        for (int k = 0; k < 2; ++k)
#pragma unroll
            for (int gg = 0; gg < 2; ++gg) { const int c = gg * 512 + 8 * lane; yw[k][gg] = *(const u32x4*)(yb + (size_t)rows[k] * DM + c); zw[k][gg] = *(const u32x4*)(proj + (size_t)rows[k] * EVEN_N + 3072 + c); }
#pragma unroll
        for (int k = 0; k < 2; ++k) { if (k == 1 && !v1) break;
#pragma unroll
            for (int gg = 0; gg < 2; ++gg) { const int c = gg * 512 + 8 * lane; float y[8], z[8]; unpack8(yw[k][gg], y); unpack8(zw[k][gg], z);
                float ss = 0.f;
#pragma unroll
                for (int e = 0; e < 8; ++e) { y[e] *= silu_f(z[e]); ss += y[e] * y[e]; }
                const float r = rsqrtf(wave_sum(ss) * (1.f / 512.f) + EPS);
#pragma unroll
                for (int e = 0; e < 8; ++e) y[e] = y[e] * r * gsv[gg][e];
                *(u32x4*)(cat + (size_t)rows[k] * 2048 + 1024 + c) = pack8f(y); } }
    }
}

template <int PER, bool SAMP> __device__ __forceinline__ void cumsum_item(PR p, int jl, int bh, int tid, int lane, int wave, float* wsum, const float* flog, const float* bfg) {
    constexpr float INV_SCALE = 11.313708498984761f; constexpr int n = SAMP ? PAST + SSEQ : SEQ, tot = SAMP ? SKS : SEQ;
    const int b = bh >> 3, h = bh & 7, e0 = tid * PER; const float bfh = bfg[h];
    float lf[PER]; float sum = 0.f;
#pragma unroll
    for (int i = 0; i < PER; ++i) { const int e = e0 + i; float v = 0.f;
        if (e < n) { if (SAMP) v = (e < PAST) ? p.in[I_CLF][(((size_t)jl * NSB + b) * PAST + e) * 8 + h] : logsigmoid_f(flog[(size_t)(TP + b * SSEQ + e - PAST) * 8 + h] + bfh);
                     else v = logsigmoid_f(flog[(size_t)(b * SEQ + e) * 8 + h] + bfh); }
        if (e < n && (!SAMP || e >= PAST)) p.out[SAMP ? O_LS + ((size_t)jl * TS + b * SSEQ + (e - PAST)) * 8 + h : O_LP + ((size_t)jl * TP + b * SEQ + e) * 8 + h] = v;
        sum += v; lf[i] = sum; }
    float incl = sum;
#pragma unroll
    for (int o = 1; o < 64; o <<= 1) { const float t = __shfl_up(incl, o); if (lane >= o) incl += t; }
    __syncthreads();
    if (lane == 63) wsum[wave] = incl;
    __syncthreads();
    float off = incl - sum;
#pragma unroll
    for (int w8 = 0; w8 < 8; ++w8) off += (w8 < wave) ? wsum[w8] : 0.f;
    float* dst = (float*)(p.ws + (SAMP ? WS_NFS : WS_NFP)) + (size_t)bh * tot;
#pragma unroll
    for (int i = 0; i < PER; ++i) { const int e = e0 + i; if (e < tot) dst[e] = (e < n) ? -(off + lf[i]) * INV_SCALE : 0.f; }
}
__device__ __forceinline__ void phase_qk_cache(int wv, PR p, int jl, int first) {
    const int tid = tid_of(wv), lane = tid & 63, wave = __builtin_amdgcn_readfirstlane(tid >> 6); const int bid = bid_here(); if (bid < first) return;
    const int gw = (bid - first) * 8 + wave, NGW = ((int)gridDim.x - first) * 8;
    bf16* Ks = (bf16*)(p.ws + WS_KS); bf16* Vs = (bf16*)(p.ws + WS_VS);
    { const int NR = 2 * NSB * (PAST + 32), per = (NR + NGW - 1) / NGW, r0 = gw * per, r1 = (r0 + per < NR) ? r0 + per : NR;
      float mx = 0.f; int curb = -1;
      for (int r = r0; r < r1; ++r) { const int which = r / (NSB * (PAST + 32)), rr = r - which * (NSB * (PAST + 32)), b = rr / (PAST + 32), t = rr - b * (PAST + 32);
          if (b != curb) { if (curb >= 0 && (lane & 7) == 0) atomicMax((unsigned*)(p.ws + WS_KMAX) + jl * 128 + curb * 8 + (lane >> 3), __float_as_uint(mx)); mx = 0.f; curb = b; }
          bf16* dst = (which ? Vs : Ks) + ((size_t)b * SKS + (t < PAST ? t : t + 32)) * DM + 16 * lane;
          if (t < PAST) { const float* src = p.in[which ? I_CV : I_CK] + (((size_t)jl * NSB + b) * PAST + t) * DM + 16 * lane; float f[16];
#pragma unroll
              for (int e = 0; e < 16; e += 4) { const f32x4 v = *(const f32x4*)(src + e); f[e] = v.x; f[e + 1] = v.y; f[e + 2] = v.z; f[e + 3] = v.w; }
              if (which == 0) { float ss = 0.f;
#pragma unroll
                  for (int e = 0; e < 16; ++e) ss += f[e] * f[e];
                  ss += __shfl_xor(ss, 1); ss += __shfl_xor(ss, 2); ss += __shfl_xor(ss, 4); mx = fmaxf(mx, ss); }
              *(u32x4*)dst = pack8f(f); *(u32x4*)(dst + 8) = pack8f(f + 8); }
          else { *(u32x4*)dst = (u32x4){0u, 0u, 0u, 0u}; *(u32x4*)(dst + 8) = (u32x4){0u, 0u, 0u, 0u}; } }
      if (curb >= 0 && (lane & 7) == 0) atomicMax((unsigned*)(p.ws + WS_KMAX) + jl * 128 + curb * 8 + (lane >> 3), __float_as_uint(mx)); }
}
__device__ __forceinline__ void phase_qk_cumsum(int wv, PR p, int jl, char* lds) {
    const int tid = tid_of(wv), lane = tid & 63, wave = __builtin_amdgcn_readfirstlane(tid >> 6), gw = bid_here() * 8 + wave, NGW = gridDim.x * 8;
    const float* flog = (const float*)(p.ws + WS_FLOG); const float* bfg = p.in[I_BF] + jl * 8;
    { float* wsum = (float*)lds;
      for (int it = bid_here(); it < NB * 8; it += gridDim.x) cumsum_item<16, false>(p, jl, it, tid, lane, wave, wsum, flog, bfg);
      for (int it = (int)gridDim.x - 1 - bid_here(); it < NSB * 8; it += gridDim.x) cumsum_item<5, true>(p, jl, it, tid, lane, wave, wsum, flog, bfg); }
}

template <class PRT> __device__ __forceinline__ fa::BlockRef attn_ref(PRT p, int id, int jl, float traw_p, float qkb, float knew) {
    const bf16* proj = (const bf16*)(p.ws + WS_PROJ); bf16* yc = (bf16*)(p.ws + WS_CAT);
    fa::BlockRef r;
    if (id < 1024) { const int bh = id >> 5, qb = id & 31, b = bh >> 3, h = bh & 7; const size_t rq = (size_t)b * SEQ + qb * 256;
        r.Q = proj + rq * ODD_N + h * 128; r.K = proj + (size_t)b * SEQ * ODD_N + 1024 + h * 128; r.V = r.K + 1024; r.Bias = (const float*)(p.ws + WS_NFP) + (size_t)bh * SEQ;
        r.O = yc + rq * DM + h * 128; r.Z = proj + rq * ODD_N + 3072 + h * 128; r.P0 = qb * 256; r.qpitch = ODD_N; r.kvpitch = ODD_N; r.nvalid = 256; r.skv = SEQ; r.canskip = 1; r.traw = traw_p; }
    else { const int bh = id - 1024, b = bh >> 3, h = bh & 7; const size_t rq = (size_t)TP + b * SSEQ;
        r.Q = proj + rq * ODD_N + h * 128; r.K = (const bf16*)(p.ws + WS_KS) + (size_t)b * SKS * DM + h * 128; r.V = (const bf16*)(p.ws + WS_VS) + (size_t)b * SKS * DM + h * 128;
        r.Bias = (const float*)(p.ws + WS_NFS) + (size_t)bh * SKS; r.O = yc + rq * DM + h * 128; r.Z = proj + rq * ODD_N + 3072 + h * 128; r.P0 = PAST; r.qpitch = ODD_N; r.kvpitch = DM; r.nvalid = SSEQ; r.skv = SKS; r.canskip = 1;
        { const float kc = sqrtf(__uint_as_float(((const unsigned*)(p.ws + WS_KMAX))[jl * 128 + bh])) * 1.01f; const float kb = fmaxf(kc, knew);
          r.traw = (2.f * (qkb * kb) + 30.f) * 11.313708f; } }
    return r;
}
__device__ __forceinline__ int attn_item(int w, int G, int i) {
    if (G == 256) { if (w < 128) { if (i == 0) return 1024 + w; return i < 5 ? 4 * w + (i - 1) : -1; } return i < 4 ? 512 + 4 * (w - 128) + i : -1; }
    const int id = w + i * G; return id < 1152 ? id : -1;
}
__device__ __forceinline__ void phase_attn(int wv, PR p, int jl, char* lds) {
    const int w = vcu_here(), G = gridDim.x;
    int i = 0, id = attn_item(w, G, 0); if (id < 0) return;
    float traw, qkb, knew;
    { const int lane = tid_of(wv) & 63; const float* gq = p.in[I_GQ] + jl * 128; const float* gk = p.in[I_GK] + jl * 128;
      float mq = fmaxf(fabsf(gq[lane]), fabsf(gq[lane + 64])), mk = fmaxf(fabsf(gk[lane]), fabsf(gk[lane + 64]));
#pragma unroll
      for (int o = 1; o < 64; o <<= 1) { mq = fmaxf(mq, __shfl_xor(mq, o)); mk = fmaxf(mk, __shfl_xor(mk, o)); }
      const float B = 11.313708f * 1.02f * mq * mk; traw = __int_as_float(__builtin_amdgcn_readfirstlane(__float_as_int((2.f * B + 30.f) * 11.313708f)));
      qkb = __int_as_float(__builtin_amdgcn_readfirstlane(__float_as_int(11.313708f * 1.01f * mq * 0.08838834764831845f)));
      knew = __int_as_float(__builtin_amdgcn_readfirstlane(__float_as_int(11.313708f * 1.01f * mk))); }
    fa::Seam S; int jlo;
    { const fa::BlockRef cur = attn_ref<PR>(p, id, jl, traw, qkb, knew); jlo = fa::fox_jlo(cur, tid_of(wv) & 63); fa::fox_prime(cur, lds, S, wv, jlo); }
    for (;;) {
        int idn = attn_item(w, G, i + 1); const bool last = idn < 0; if (last) idn = id;
        int jlon = 0;
        fa::fox_block<PR>(p, id, jl, idn, jl, lds, S, wv, jlo, jlon, traw, qkb, knew);
        if (last) break;
        id = idn; jlo = jlon; ++i;
    }
}
#define LAS __attribute__((address_space(3)))
#define XB_TMO      128
#define XB_XCNT(j)  (256  + 64 * (j))
#define XB_XSUB(j)  (1280 + 64 * (j))
#define XB_XGEN(j)  (2304 + 64 * (j))
#define XB_TOP      3328
#define XB_TOPGEN   3392
#define XCD_BAR_WORDS 3456
#define XB_SPIN_CAP (1u << 18)

__device__ __forceinline__ unsigned xb_ld(unsigned* p)              { return __hip_atomic_load(p, __ATOMIC_RELAXED, __HIP_MEMORY_SCOPE_AGENT); }
__device__ __forceinline__ unsigned xb_add(unsigned* p, unsigned v) { return __hip_atomic_fetch_add(p, v, __ATOMIC_RELAXED, __HIP_MEMORY_SCOPE_AGENT); }
__device__ __forceinline__ unsigned xb_xcc_id() { return (unsigned)__builtin_amdgcn_s_getreg((3 << 11) | 20) & 0xFu; }
#define XB_SPIN(cond, bar) do { unsigned _sp = 0; while (cond) { __builtin_amdgcn_s_sleep(1); \
    if ((++_sp & 255u) == 0u) { if (xb_ld(&(bar)[XB_TMO])) break; if (_sp > XB_SPIN_CAP) { atomicAdd(&(bar)[XB_TMO], 1u); break; } } } } while (0)

struct XcdBarrier {
    unsigned* bar; unsigned x;
    volatile LAS unsigned* st;
};

__device__ __forceinline__ XcdBarrier xcd_barrier_post(unsigned* bar, volatile LAS unsigned* st, int xb_tid) {
    XcdBarrier b; b.bar = bar; b.x = xb_xcc_id(); b.st = st;
    if (xb_tid == 0) (void)xb_add(&bar[XB_XCNT(b.x)], 1u);
    return b;
}
__device__ __forceinline__ void xcd_barrier_complete(unsigned* bar, unsigned x, unsigned& nloc, unsigned& nx) {
    const unsigned G = gridDim.x * gridDim.y * gridDim.z;
    unsigned sum, cnt, mine, sp = 0u;
    for (;;) {
        sum = 0u; cnt = 0u; mine = 0u;
#pragma unroll
        for (unsigned j = 0; j < 16; ++j) { const unsigned c = xb_ld(&bar[XB_XCNT(j)]); sum += c; cnt += (c > 0u) ? 1u : 0u; mine = (j == x) ? c : mine; }
        if (sum == G) break;
        __builtin_amdgcn_s_sleep(1);
        if ((++sp & 255u) == 0u) { if (xb_ld(&bar[XB_TMO])) break; if (sp > XB_SPIN_CAP) { atomicAdd(&bar[XB_TMO], 1u); break; } }
    }
    nloc = mine > 0u ? mine : 1u; nx = cnt > 0u ? cnt : 1u;
}

__device__ __forceinline__ void xcd_barrier(const XcdBarrier& b, int wv_) {
    const int xb_tid = tid_of(wv_);
    asm volatile("s_waitcnt vmcnt(0)" ::: "memory");
    __syncthreads();
    if (xb_tid == 0) {
        unsigned* bar = b.bar;
        __builtin_amdgcn_s_waitcnt(0);
        unsigned nloc = b.st[0], nx = b.st[1];
        if (nloc == 0u) { xcd_barrier_complete(bar, b.x, nloc, nx); b.st[0] = nloc; b.st[1] = nx; }
        const unsigned old = xb_add(&bar[XB_XSUB(b.x)], 1u);
        const unsigned gen = old / nloc;
        if (old + 1u == (gen + 1u) * nloc) {
            __builtin_amdgcn_fence(__ATOMIC_RELEASE, "agent");
            asm volatile("s_waitcnt vmcnt(0)" ::: "memory");
            const unsigned og = xb_add(&bar[XB_TOP], 1u);
            const unsigned tg = og / nx;
            if (og + 1u == (tg + 1u) * nx) xb_add(&bar[XB_TOPGEN], 1u);
            else XB_SPIN(xb_ld(&bar[XB_TOPGEN]) == tg, bar);
            __builtin_amdgcn_fence(__ATOMIC_ACQUIRE, "agent");
            xb_add(&bar[XB_XGEN(b.x)], 1u);
            asm volatile("s_waitcnt vmcnt(0)" ::: "memory");
        } else {
            XB_SPIN(xb_ld(&bar[XB_XGEN(b.x)]) == gen, bar);
            __builtin_amdgcn_fence(__ATOMIC_ACQUIRE, "agent");
            asm volatile("s_waitcnt vmcnt(0)" ::: "memory");
        }
    }
    __syncthreads();
}
#ifndef PH_MASK
#define PH_MASK 0xFFFF
#endif
#ifndef DUP_MASK
#define DUP_MASK 0
#endif
#define PH(b) for (int rep_ = 0; rep_ < ((DUP_MASK >> (b)) & 1) + 1; ++rep_) if (PH_MASK & (1 << (b)))
#define PHX(b) PH(b)
template <int MODE> __device__ __forceinline__ void run_gemm(int wv, char* lds, PR p, const bf16* A, const bf16* Bt, int N, int K, int jl) {
    pg8::Gemm g{A, Bt, TT, N, K}; pg8::StaticOrder S; S.init(TT, N, (int)gridDim.x, bid_here());
    EpiProj<MODE> E{p.ws, p.out, MODE == 2 ? p.in[I_GQ] + jl * 128 : nullptr, MODE == 2 ? p.in[I_GK] + jl * 128 : nullptr, (float*)(lds + 131072 + 1024), jl};
    pg8::gemm_phase<EpiProj<MODE>, pg8::StaticOrder, true, true>((PG8_LAS unsigned char*)lds, g, S, E, wv);
}

template <int jl> __device__ __forceinline__ void layer_pair(int wv, char* lds, const XcdBarrier& xb) {
        PHX(2) { PR p = *params_here(); run_gemm<1>(wv, lds, p, (const bf16*)(p.ws + WS_H), (const bf16*)(p.ws + WS_WINE) + (size_t)jl * EVEN_NP * 1024, EVEN_NP, 1024, jl); }
        xcd_barrier(xb, wv);
        PHX(3) { PR p = *params_here(); phase_conv(wv, p, jl); }
        PHX(4) { PR p = *params_here(); phase_gmlp(wv, p, jl, lds); }
        xcd_barrier(xb, wv);
        PHX(5) { PR p = *params_here(); phase_scan(wv, p, jl, lds); }
        xcd_barrier(xb, wv);
        PHX(6) { PR p = *params_here(); phase_gate(wv, p, jl); }
        xcd_barrier(xb, wv);
        PHX(7) { PR p = *params_here(); run_gemm<0>(wv, lds, p, (const bf16*)(p.ws + WS_CAT), (const bf16*)(p.ws + WS_WOUTE) + (size_t)jl * 1024 * 2048, 1024, 2048, jl); }
        PHX(14) { PR p = *params_here(); const int G_ = (int)gridDim.x, nu_ = (TT / 256) * 4; phase_qk_cache(wv, p, jl, (nu_ > 2 * G_ && nu_ < 3 * G_) ? nu_ - 2 * G_ : 0); }
        xcd_barrier(xb, wv);
        PHX(8) { PR p = *params_here(); phase_norm(wv, p, 2 * jl + 1); }
        xcd_barrier(xb, wv);
        PHX(9) { PR p = *params_here(); run_gemm<2>(wv, lds, p, (const bf16*)(p.ws + WS_H), (const bf16*)(p.ws + WS_WINO) + (size_t)jl * ODD_NP * 1024, ODD_NP, 1024, jl); }
        xcd_barrier(xb, wv);
        PHX(10) { { PR p = *params_here(); phase_qk_cumsum(wv, p, jl, lds); } }
        xcd_barrier(xb, wv);
        PHX(11) { PR p = *params_here(); phase_attn(wv, p, jl, lds); }
        xcd_barrier(xb, wv);
        PHX(12) { PR p = *params_here(); run_gemm<0>(wv, lds, p, (const bf16*)(p.ws + WS_CAT), (const bf16*)(p.ws + WS_WOUTO) + (size_t)jl * 1024 * 1024, 1024, 1024, jl); }
        xcd_barrier(xb, wv);
        PHX(13) { PR p = *params_here(); phase_norm(wv, p, 2 * jl + 2); }
        xcd_barrier(xb, wv);
}

__global__ void __launch_bounds__(512, 2) hybrid_fwd(Params p_unused) {
    extern __shared__ __attribute__((aligned(16))) unsigned char lds_raw[];
    char* lds = (char*)lds_raw;
    cg::grid_group grid = cg::this_grid();
    const int wv = __builtin_amdgcn_readfirstlane((int)threadIdx.x >> 6);
    volatile LAS unsigned* xst = (volatile LAS unsigned*)((LAS unsigned char*)lds_raw + 131072 + 64);
    if (threadIdx.x < 2) xst[threadIdx.x] = 0u;
    __syncthreads();
    const XcdBarrier xb = xcd_barrier_post((unsigned*)(p_unused.ws + WS_BAR), xst, (int)threadIdx.x);

    PH(0) { PR p = *params_here(); phase_prologue(wv, p, lds); }
    PH(1) { PR p = *params_here(); phase_norm(wv, p, 0); }
    grid.sync();
    layer_pair<0>(wv, lds, xb);
    layer_pair<1>(wv, lds, xb);
}

extern "C" void kernel_launch(void* const* d_in, const int* in_sizes, int n_in, void* d_out, int out_size, void* d_ws, size_t ws_size, hipStream_t stream) {
    static int grid = 0;
    if (grid == 0) {
        if (n_in != 25 || (size_t)out_size != O_END || ws_size < WS_END) {
            fprintf(stderr, "kernel_launch: unexpected shapes: n_in %d out %d (want %zu) ws %zu (need %zu)\n", n_in, out_size, (size_t)O_END, ws_size, (size_t)WS_END);
            grid = -1; return; }
        int dev = 0, cus = 0, per_cu = 0;
        (void)hipGetDevice(&dev);
        (void)hipDeviceGetAttribute(&cus, hipDeviceAttributeMultiprocessorCount, dev);
        if (hipFuncSetAttribute((const void*)hybrid_fwd, hipFuncAttributeMaxDynamicSharedMemorySize, LDS_BYTES) != hipSuccess) fprintf(stderr, "kernel_launch: hipFuncSetAttribute failed\n");
        if (hipOccupancyMaxActiveBlocksPerMultiprocessor(&per_cu, (const void*)hybrid_fwd, 512, LDS_BYTES) != hipSuccess || per_cu < 1) { fprintf(stderr, "kernel_launch: occupancy query gave %d\n", per_cu); per_cu = 1; }
        (void)hipGetLastError();
        if (cus <= 0) cus = 256;
        grid = cus;
    }
    if (grid < 0) return;
    (void)hipMemsetAsync((char*)d_ws + WS_BAR, 0, 65536, stream);
    Params p{};
    for (int i = 0; i < 25; ++i) p.in[i] = (const float*)d_in[i];
    p.out = (float*)d_out; p.ws = (unsigned char*)d_ws;
    void* args[] = {&p};
    hipError_t e = hipLaunchCooperativeKernel((const void*)hybrid_fwd, dim3(grid), dim3(512), args, LDS_BYTES, stream);
    if (e != hipSuccess) fprintf(stderr, "kernel_launch: cooperative launch failed: %s (grid %d)\n", hipGetErrorString(e), grid);
}
```

```cpp
#include <hip/hip_runtime.h>
#include <hip/hip_cooperative_groups.h>
#include <hip/hip_bf16.h>
#include <cstdio>
#include <cstdint>
namespace cg = cooperative_groups;

constexpr int DM = 1024, NB = 4, SEQ = 8192, NSB = 16, SSEQ = 32, PAST = 2048;
constexpr int TP = NB * SEQ, TS = NSB * SSEQ, TT = TP + TS;
constexpr int EVEN_IN = 5648, EVEN_N = 5632, EVEN_NP = 5888;
constexpr int ODD_IN = 4104, ODD_N = 4096, ODD_NP = 4352;
constexpr int CONV_DIM = 1536, SKS = PAST + 64;
constexpr float EPS = 1e-6f;

constexpr size_t O_YP = 0;
constexpr size_t O_YS = O_YP + (size_t)TP * DM;
constexpr size_t O_KP = O_YS + (size_t)TS * DM;
constexpr size_t O_VP = O_KP + (size_t)2 * TP * DM;
constexpr size_t O_LP = O_VP + (size_t)2 * TP * DM;
constexpr size_t O_SP = O_LP + (size_t)2 * TP * 8;
constexpr size_t O_CP = O_SP + (size_t)2 * NB * 16 * 64 * 128;
constexpr size_t O_KS = O_CP + (size_t)2 * NB * 3 * CONV_DIM;
constexpr size_t O_VS = O_KS + (size_t)2 * TS * DM;
constexpr size_t O_LS = O_VS + (size_t)2 * TS * DM;
constexpr size_t O_SS = O_LS + (size_t)2 * TS * 8;
constexpr size_t O_CS = O_SS + (size_t)2 * NSB * 16 * 64 * 128;
constexpr size_t O_GV = O_CS + (size_t)2 * NSB * 3 * CONV_DIM;
constexpr size_t O_END = O_GV + (size_t)2 * TS * DM;

constexpr size_t MiB = 1u << 20;
constexpr size_t WS_WINE = 0, WS_WOUTE = 24 * MiB, WS_WINO = 32 * MiB, WS_WOUTO = 50 * MiB;
constexpr size_t WS_DTRAW = 54 * MiB, WS_FLOG = 57 * MiB, WS_NFP = 59 * MiB, WS_NFS = 60 * MiB;
constexpr size_t WS_BAR = 61 * MiB + 512 * 1024;
constexpr size_t WS_KMAX = WS_BAR + 32768;
constexpr size_t WS_H = 62 * MiB, WS_O = 127 * MiB, WS_CAT = 192 * MiB, WS_ACT = 322 * MiB, WS_Y = 420 * MiB;
constexpr size_t WS_KS = 322 * MiB, WS_VS = 388 * MiB;
constexpr size_t WS_PROJ = 485 * MiB, WS_RES = 843 * MiB, WS_END = 908 * MiB;
static_assert((size_t)2 * EVEN_NP * 1024 * 2 <= 24 * MiB && (size_t)2 * ODD_NP * 1024 * 2 <= 18 * MiB, "weights");
static_assert((size_t)TT * 16 * 4 <= 3 * MiB && (size_t)TT * 8 * 4 <= 2 * MiB && (size_t)128 * SKS * 4 <= 2 * MiB, "small");
static_assert((size_t)TT * 1024 * 2 <= 65 * MiB && (size_t)TT * 1536 * 2 <= 98 * MiB && (size_t)NSB * SKS * 1024 * 2 <= 66 * MiB, "act");
static_assert((size_t)TT * EVEN_N * 2 <= 358 * MiB, "proj");

constexpr int LDS_BYTES = 131072 + 1024 + 8192 + 1024;

typedef unsigned short bf16;
typedef float f32x4 __attribute__((ext_vector_type(4)));
typedef float f32x2 __attribute__((ext_vector_type(2)));
typedef float f32x16 __attribute__((ext_vector_type(16)));
typedef unsigned u32x4 __attribute__((ext_vector_type(4)));
typedef unsigned u32x2 __attribute__((ext_vector_type(2)));
typedef short bf16x8 __attribute__((ext_vector_type(8)));
typedef short s16x4 __attribute__((ext_vector_type(4)));

__device__ __forceinline__ float bf2f(unsigned b) { return __uint_as_float(b << 16); }
__device__ __forceinline__ float bflo(unsigned w) { return __uint_as_float(w << 16); }
__device__ __forceinline__ float bfhi(unsigned w) { return __uint_as_float(w & 0xffff0000u); }
typedef __bf16 bf16x2_t __attribute__((ext_vector_type(2)));
__device__ __forceinline__ unsigned cvtpk(float lo, float hi) { const f32x2 v = {lo, hi}; const bf16x2_t b = __builtin_convertvector(v, bf16x2_t); return __builtin_bit_cast(unsigned, b); }
__device__ __forceinline__ float wave_sum(float v) {
#pragma unroll
    for (int o = 1; o < 64; o <<= 1) v += __shfl_xor(v, o);
    return v;
}
__device__ __forceinline__ float silu_f(float x) { return x * __builtin_amdgcn_rcpf(1.f + __expf(-x)); }
__device__ __forceinline__ float softplus_f(float x) { return x > 20.f ? x : log1pf(__expf(x)); }
__device__ __forceinline__ float logsigmoid_f(float x) { return fminf(x, 0.f) - log1pf(__expf(-fabsf(x))); }
__device__ __forceinline__ void unpack8(u32x4 w, float* f) {
    f[0] = bflo(w.x); f[1] = bfhi(w.x); f[2] = bflo(w.y); f[3] = bfhi(w.y); f[4] = bflo(w.z); f[5] = bfhi(w.z); f[6] = bflo(w.w); f[7] = bfhi(w.w);
}
__device__ __forceinline__ u32x4 pack8f(const float* f) { u32x4 w; w.x = cvtpk(f[0], f[1]); w.y = cvtpk(f[2], f[3]); w.z = cvtpk(f[4], f[5]); w.w = cvtpk(f[6], f[7]); return w; }

__device__ __forceinline__ int tid_of(int wv) { asm volatile("" : "+s"(wv)); int l; asm volatile("v_mbcnt_lo_u32_b32 %0, -1, 0\n\tv_mbcnt_hi_u32_b32 %0, -1, %0" : "=v"(l)); int t = (wv << 6) | l; asm volatile("" : "+v"(t)); return t; }
__device__ __forceinline__ int bid_here() { int b = blockIdx.x; asm volatile("" : "+s"(b)); return b; }
__device__ __forceinline__ int vcu_here() { const int b = bid_here(), G = (int)gridDim.x; return (G % 8 == 0) ? (b % 8) * (G / 8) + b / 8 : b; }
namespace pg8 {
#define PG8_LAS __attribute__((address_space(3)))
typedef unsigned short bf16_t;
typedef short bf16x8 __attribute__((ext_vector_type(8)));
typedef float f32x4 __attribute__((ext_vector_type(4)));
typedef unsigned u32x4 __attribute__((ext_vector_type(4)));
constexpr int BM = 256, BK = 64, HALF = 128, HTB = HALF * BK * 2  , STAGE_BYTES = 8 * HTB, NXCD = 8, WGM = 8;

__host__ __device__ __forceinline__ int lds_byte(int r, int c) { const int st = (r >> 4) * 2 + (c >> 5), rr = r & 15, cc = c & 31, ob = rr * 64 + cc * 2; return st * 1024 + (ob ^ (((ob >> 9) & 1) << 5)); }
__host__ __device__ __forceinline__ void stage_rc(int b, int& R, int& C) { const int st = b / 1024, sb = b % 1024, swz = sb ^ (((sb >> 9) & 1) << 5); R = (st >> 1) * 16 + swz / 64; C = (st & 1) * 32 + (swz % 64) / 2; }
__host__ __device__ __forceinline__ int perm32(int rho) { const int n = rho >> 4, i = rho & 15; return 8 * (i >> 2) + 4 * n + (i & 3); }

struct Unit { int pm, pn; };
struct Gemm { const bf16_t* A; const bf16_t* Bt; int M, N, K; };

struct StaticOrder {
    int nM, nN, nwg, G, c;
    __host__ __device__ void init(int M, int N, int G_, int c_) { nM = M / BM; nN = N / BM; nwg = nM * nN; G = G_; c = c_; }
    __host__ __device__ bool next(int i, Unit& u) const {
        const long L = (long)i * G + c; if (L >= nwg) return false;
        int wgid = (int)L; { const int q = nwg / NXCD, r = nwg % NXCD, xcd = wgid % NXCD, off = wgid / NXCD; wgid = (xcd < r ? xcd * (q + 1) : r * (q + 1) + (xcd - r) * q) + off; }
        const int nig = WGM * nN, gid = wgid / nig, fm = gid * WGM, gsz = (nM - fm) < WGM ? (nM - fm) : WGM;
        u.pm = fm + ((wgid % nig) % gsz); u.pn = (wgid % nig) / gsz; return true;
    }
    __device__ __forceinline__ void a_ready(const Unit&) const {}
    __device__ __forceinline__ void done(const Unit&) const {}
};

__device__ __forceinline__ unsigned cvt_pk_bf16(float lo, float hi) { unsigned r; asm volatile("v_cvt_pk_bf16_f32 %0, %1, %2" : "=v"(r) : "v"(lo), "v"(hi)); return r; }
typedef float f32x2 __attribute__((ext_vector_type(2)));
__device__ __forceinline__ f32x2 gelu_pk(f32x2 v) {
    const f32x2 av = __builtin_elementwise_abs(v), d = av * 0.2316418882f + 1.0f;
    f32x2 t; t.x = __builtin_amdgcn_rcpf(d.x); t.y = __builtin_amdgcn_rcpf(d.y);
    f32x2 q = t * 0.5307027145f + (-0.7265760135f); q = q * t + 0.7107068705f; q = q * t + (-0.142248368f); q = q * t + 0.127414796f; q = q * t;
    const f32x2 s = (v * v) * (-0.72134752044f);
    f32x2 e; e.x = __builtin_amdgcn_exp2f(s.x); e.y = __builtin_amdgcn_exp2f(s.y);
    const f32x2 m = v * (q * e), r = v - m;
    f32x2 o; o.x = v.x < 0.f ? m.x : r.x; o.y = v.y < 0.f ? m.y : r.y; return o;
}
template <class Epi, class Sched, bool ALIGN_EPI = false, bool SP2 = false>
__device__ __forceinline__ void gemm_phase(PG8_LAS unsigned char* lds, const Gemm g, const Sched& S, const Epi& E, const int wv_in) {
    const int tid = tid_of(wv_in), wid = __builtin_amdgcn_readfirstlane(tid >> 6), lane = tid & 63, wr = wid >> 2, wc = wid & 3, fr = lane & 15, fq = lane >> 4;
    const int K = g.K, nt = K / BK;
    unsigned voffA[2], voffB[2];
#pragma unroll
    for (int i = 0; i < 2; ++i) { int R, C; stage_rc(tid * 16 + i * 8192, R, C); const int Rb = Epi::PERM ? ((R & ~31) + perm32(R & 31)) : R;
        voffA[i] = (unsigned)(R * K + C) * 2u; voffB[i] = (unsigned)(Rb * K + C) * 2u; }
    const size_t kstep = (size_t)(BK * 2);
    const size_t hstep = (size_t)HALF * K * 2;
    const size_t tstep = 2 * hstep;
    const unsigned ldsw = (unsigned)wid * 1024u;
    const int aoff = lds_byte(wr * 64 + fr, fq * 8), boff = lds_byte(wc * 32 + fr, fq * 8);
#define PG8_SA(b, h) (((b) * 2 + (h)) * HTB)
#define PG8_SB(b, h) ((4 + (b) * 2 + (h)) * HTB)
#define PG8_STAGE(bufoff, gbase, voff) do { _Pragma("unroll") for (int _i = 0; _i < 2; ++_i) \
        __builtin_amdgcn_global_load_lds((const unsigned*)((const char*)(gbase) + (voff)[_i]), (PG8_LAS unsigned*)(lds + (bufoff) + ldsw + _i * 8192), 16, 0, 0); } while (0)
#define PG8_LDA(dst, b, h) do { _Pragma("unroll") for (int m = 0; m < 4; ++m) _Pragma("unroll") for (int k = 0; k < 2; ++k) dst[m][k] = *(const PG8_LAS bf16x8*)(lds + PG8_SA(b, h) + aoff + m * 2048 + k * 1024); } while (0)
#define PG8_LDB(dst, b, h) do { _Pragma("unroll") for (int n = 0; n < 2; ++n) _Pragma("unroll") for (int k = 0; k < 2; ++k) dst[n][k] = *(const PG8_LAS bf16x8*)(lds + PG8_SB(b, h) + boff + n * 2048 + k * 1024); } while (0)
#define PG8_MMA(ai, bj, At, Bt) do { __builtin_amdgcn_s_setprio(1); _Pragma("unroll") for (int m = 0; m < 4; ++m) _Pragma("unroll") for (int n = 0; n < 2; ++n) _Pragma("unroll") for (int k = 0; k < 2; ++k) \
        acc[ai][bj][m][n] = __builtin_amdgcn_mfma_f32_16x16x32_bf16(Bt[n][k], At[m][k], acc[ai][bj][m][n], 0, 0, 0); __builtin_amdgcn_s_setprio(0); } while (0)
#define PG8_WAIT_V(n) asm volatile("s_waitcnt vmcnt(" #n ")" ::: "memory")
#define PG8_WAIT_L(n) asm volatile("s_waitcnt lgkmcnt(" #n ")" ::: "memory")
#define PG8_BAR __builtin_amdgcn_s_barrier()
#define PG8_SCHED __builtin_amdgcn_sched_barrier(0)
    Unit cur, nxt; int ui = 0;
    if (!S.next(0, cur)) return;
    f32x4 acc[2][2][4][2];
#pragma unroll
    for (int a = 0; a < 2; ++a)
#pragma unroll
        for (int b = 0; b < 2; ++b)
#pragma unroll
            for (int m = 0; m < 4; ++m)
#pragma unroll
                for (int n = 0; n < 2; ++n) acc[a][b][m][n] = (f32x4){0.f, 0.f, 0.f, 0.f};
    bf16x8 At[4][2], B0[2][2], B1[2][2];
    const char* cA = (const char*)g.A + (size_t)cur.pm * tstep; const char* cB = (const char*)g.Bt + (size_t)cur.pn * tstep;
    S.a_ready(cur);
    if constexpr (SP2) {
        PG8_STAGE(PG8_SB(0, 0), cB, voffB); PG8_STAGE(PG8_SB(0, 1), cB + hstep, voffB); PG8_STAGE(PG8_SA(0, 0), cA, voffA); PG8_STAGE(PG8_SA(0, 1), cA + hstep, voffA);
        if (wr == 1) PG8_BAR;
        PG8_WAIT_V(2); PG8_BAR;
        PG8_STAGE(PG8_SB(1, 0), cB + kstep, voffB); PG8_STAGE(PG8_SA(1, 0), cA + kstep, voffA); PG8_STAGE(PG8_SB(1, 1), cB + hstep + kstep, voffB);
        PG8_WAIT_V(6); PG8_BAR;
    } else {
        PG8_STAGE(PG8_SB(0, 0), cB, voffB); PG8_STAGE(PG8_SA(0, 0), cA, voffA); PG8_STAGE(PG8_SB(0, 1), cB + hstep, voffB); PG8_STAGE(PG8_SA(0, 1), cA + hstep, voffA);
        if (wr == 1) PG8_BAR;
        PG8_WAIT_V(4); PG8_BAR;
        PG8_STAGE(PG8_SB(1, 0), cB + kstep, voffB); PG8_STAGE(PG8_SA(1, 0), cA + kstep, voffA); PG8_STAGE(PG8_SB(1, 1), cB + hstep + kstep, voffB);
        PG8_WAIT_V(6); PG8_BAR;
    }
    for (;;) {
        const bool has_next = S.next(ui + 1, nxt);
        const char* nA = has_next ? (const char*)g.A + (size_t)nxt.pm * tstep : cA; const char* nB = has_next ? (const char*)g.Bt + (size_t)nxt.pn * tstep : cB;
        for (int t = 0; t < nt; t += 2) {
            const bool last = (t == nt - 2);
            const char* a1 = cA + (size_t)(t + 1) * kstep;
            const char* a2 = last ? nA : cA + (size_t)(t + 2) * kstep; const char* b2 = last ? nB : cB + (size_t)(t + 2) * kstep;
            const char* a3 = a2 + kstep; const char* b3 = b2 + kstep;
            if (last && has_next) S.a_ready(nxt);
            if constexpr (SP2) {
            PG8_LDB(B0, 0, 0); PG8_LDB(B1, 0, 1); PG8_SCHED; PG8_LDA(At, 0, 0); PG8_STAGE(PG8_SA(1, 1), a1 + hstep, voffA);
            PG8_WAIT_V(8); PG8_WAIT_L(0); PG8_BAR; PG8_MMA(0, 0, At, B0); PG8_MMA(0, 1, At, B1); PG8_BAR; PG8_SCHED;
            PG8_LDA(At, 0, 1); PG8_STAGE(PG8_SB(0, 0), b2, voffB); PG8_STAGE(PG8_SB(0, 1), b2 + hstep, voffB); PG8_STAGE(PG8_SA(0, 0), a2, voffA);
            PG8_WAIT_V(8); PG8_WAIT_L(0); PG8_BAR; PG8_MMA(1, 0, At, B0); PG8_MMA(1, 1, At, B1); PG8_BAR; PG8_SCHED;
            PG8_LDB(B0, 1, 0); PG8_LDB(B1, 1, 1); PG8_SCHED; PG8_LDA(At, 1, 0); PG8_STAGE(PG8_SA(0, 1), a2 + hstep, voffA);
            PG8_WAIT_V(8); PG8_WAIT_L(0); PG8_BAR; PG8_MMA(0, 0, At, B0); PG8_MMA(0, 1, At, B1); PG8_BAR; PG8_SCHED;
            PG8_LDA(At, 1, 1); PG8_STAGE(PG8_SB(1, 0), b3, voffB); PG8_STAGE(PG8_SB(1, 1), b3 + hstep, voffB); PG8_STAGE(PG8_SA(1, 0), a3, voffA);
            PG8_WAIT_V(8); PG8_WAIT_L(0); PG8_BAR; PG8_MMA(1, 0, At, B0); PG8_MMA(1, 1, At, B1); PG8_BAR; PG8_SCHED;
            } else {
            PG8_LDB(B0, 0, 0); PG8_SCHED; PG8_LDA(At, 0, 0); PG8_STAGE(PG8_SA(1, 1), a1 + hstep, voffA);
            PG8_WAIT_L(8); PG8_BAR; PG8_WAIT_L(0); PG8_MMA(0, 0, At, B0); PG8_BAR; PG8_SCHED;
            PG8_LDB(B1, 0, 1); PG8_STAGE(PG8_SB(0, 0), b2, voffB);
            PG8_BAR; PG8_WAIT_L(0); PG8_MMA(0, 1, At, B1); PG8_BAR;
            PG8_LDA(At, 0, 1); PG8_STAGE(PG8_SA(0, 0), a2, voffA);
            PG8_BAR; PG8_WAIT_L(0); PG8_MMA(1, 0, At, B0); PG8_BAR; PG8_SCHED;
            PG8_STAGE(PG8_SB(0, 1), b2 + hstep, voffB);
            PG8_WAIT_V(6); PG8_BAR; PG8_MMA(1, 1, At, B1); PG8_BAR;
            PG8_LDB(B0, 1, 0); PG8_SCHED; PG8_LDA(At, 1, 0); PG8_STAGE(PG8_SA(0, 1), a2 + hstep, voffA);
            PG8_WAIT_L(8); PG8_BAR; PG8_WAIT_L(0); PG8_MMA(0, 0, At, B0); PG8_BAR; PG8_SCHED;
            PG8_LDB(B1, 1, 1); PG8_STAGE(PG8_SB(1, 0), b3, voffB);
            PG8_BAR; PG8_WAIT_L(0); PG8_MMA(0, 1, At, B1); PG8_BAR;
            PG8_LDA(At, 1, 1); PG8_STAGE(PG8_SA(1, 0), a3, voffA);
            PG8_BAR; PG8_WAIT_L(0); PG8_MMA(1, 0, At, B0); PG8_BAR; PG8_SCHED;
            PG8_STAGE(PG8_SB(1, 1), b3 + hstep, voffB);
            PG8_WAIT_V(6); PG8_BAR; PG8_MMA(1, 1, At, B1); PG8_BAR;
            }
        }
        if constexpr (ALIGN_EPI) { if (wr == 0) PG8_BAR; }
        if constexpr (!Epi::AFTER_DRAIN) { E(acc, cur, wr, wc, fr, fq); S.done(cur); }
        if (!has_next) break;
#pragma unroll
        for (int a = 0; a < 2; ++a)
#pragma unroll
            for (int b = 0; b < 2; ++b)
#pragma unroll
                for (int m = 0; m < 4; ++m)
#pragma unroll
                    for (int n = 0; n < 2; ++n) acc[a][b][m][n] = (f32x4){0.f, 0.f, 0.f, 0.f};
        cur = nxt; cA = nA; cB = nB; ++ui;
        if constexpr (ALIGN_EPI) { if (wr == 1) PG8_BAR; }
    }
    PG8_WAIT_V(0);
    if constexpr (!ALIGN_EPI) { if (wr == 0) PG8_BAR; }
    PG8_BAR;
    if constexpr (Epi::AFTER_DRAIN) { E.fused(acc, cur, wr, wc, fr, fq, lds, wid, lane); S.done(cur); }
#undef PG8_SA
#undef PG8_SB
#undef PG8_STAGE
#undef PG8_LDA
#undef PG8_LDB
#undef PG8_MMA
#undef PG8_WAIT_V
#undef PG8_WAIT_L
#undef PG8_BAR
#undef PG8_SCHED
}
}
namespace fa {
constexpr float SCALE = 0.08838834764831845f;
constexpr float THR = 40.f;
constexpr int D = 128, NW = 8, QBLK = 32, KVBLK = 64, QB = NW * QBLK;
constexpr int SHM_V = KVBLK * D * 2, SHM_K = KVBLK * D * 2;
constexpr int OFF_WS = 2 * SHM_V + 2 * SHM_K, OFF_BIAS = OFF_WS + NW * 64 * 4, FA_LDS = OFF_BIAS + 2 * 64 * 4;
#define KSWZ(row, colB) ((row) * 256 + ((colB) ^ (((row) & 7) << 4)))
#define SBAR() __builtin_amdgcn_sched_barrier(0)
__device__ __forceinline__ int v_st(int k, int c) { const int kk = (k & ~0xC) | ((k & 4) << 1) | ((k & 8) >> 1); return ((kk >> 3) * 4 + (c >> 5)) * 512 + ((kk & 7) * 32 + (c & 31)) * 2; }
__device__ __forceinline__ int v_rd_base(int lane) { return ((lane & 3) << 3) | (((lane >> 2) & 3) << 6) | (((lane >> 4) & 1) << 5) | (((lane >> 5) & 1) << 8); }
constexpr int v_rd_off(int d0, int ks, int half) { return d0 * 512 + ks * 4096 + half * 2048; }
__device__ __forceinline__ int crow(int r, int hi) { return (r & 3) + 8 * (r >> 2) + 4 * hi; }
__device__ __forceinline__ bf16x8 load8(const bf16* p) { return *reinterpret_cast<const bf16x8*>(p); }
__device__ __forceinline__ void mask_tile(f32x16& p0, f32x16& p1, int dq) {
    const float NEG = -__builtin_inff();
#pragma unroll
    for (int r = 0; r < 16; ++r) {
        const int c = (r & 3) + 8 * (r >> 2);
        if (dq - c < 0) p0[r] = NEG;
        if (dq - c - 32 < 0) p1[r] = NEG;
    }
}
__device__ __forceinline__ void partialSM(f32x16& p0, f32x16& p1, float& m_reg, float& mn, float& alpha) {
    float pmax = p0[0];
#pragma unroll
    for (int r = 1; r < 16; ++r) pmax = fmaxf(pmax, p0[r]);
#pragma unroll
    for (int r = 0; r < 16; ++r) pmax = fmaxf(pmax, p1[r]);
    { auto rr = __builtin_amdgcn_permlane32_swap(__float_as_uint(pmax), __float_as_uint(pmax), false, false);
      pmax = fmaxf(__uint_as_float(rr[0]), __uint_as_float(rr[1])); }
    constexpr float C2 = 1.4426950408889634f * SCALE;
    if (__builtin_expect(__all((pmax - m_reg) * SCALE <= THR), 1)) { mn = m_reg; alpha = 1.f; }
    else { mn = fmaxf(m_reg, pmax); alpha = __builtin_amdgcn_exp2f((m_reg - mn) * C2); m_reg = mn; }
    const float mnL = -mn * C2;
#pragma unroll
    for (int r = 0; r < 16; ++r) p0[r] = fmaf(p0[r], C2, mnL);
#pragma unroll
    for (int r = 0; r < 16; ++r) p1[r] = fmaf(p1[r], C2, mnL);
#pragma unroll
    for (int r = 0; r < 16; ++r) p0[r] = __builtin_amdgcn_exp2f(p0[r]);
}
__device__ __forceinline__ void finishSM(f32x16& p0, f32x16& p1, float alpha, float& l_reg, bf16x8& pa0, bf16x8& pa1, bf16x8& pa2, bf16x8& pa3) {
#pragma unroll
    for (int r = 0; r < 16; ++r) p1[r] = __builtin_amdgcn_exp2f(p1[r]);
    float ps = 0;
#pragma unroll
    for (int r = 0; r < 16; ++r) ps += p0[r];
#pragma unroll
    for (int r = 0; r < 16; ++r) ps += p1[r];
    { auto rr = __builtin_amdgcn_permlane32_swap(__float_as_uint(ps), __float_as_uint(ps), false, false);
      ps = __uint_as_float(rr[0]) + __uint_as_float(rr[1]); }
    l_reg = l_reg * alpha + ps;
#define PK4(P, B_, OUT) do { unsigned a0 = cvtpk(P[B_+0], P[B_+1]), a1 = cvtpk(P[B_+2], P[B_+3]);                          \
        unsigned b0 = cvtpk(P[B_+4], P[B_+5]), b1 = cvtpk(P[B_+6], P[B_+7]);                                             \
        auto r0 = __builtin_amdgcn_permlane32_swap(a0, b0, false, false); auto r1 = __builtin_amdgcn_permlane32_swap(a1, b1, false, false); \
        u32x4 w = {r0[0], r1[0], r0[1], r1[1]}; OUT = *reinterpret_cast<bf16x8*>(&w); } while (0)
    PK4(p0, 0, pa0); PK4(p0, 8, pa1); PK4(p1, 0, pa2); PK4(p1, 8, pa3);
#undef PK4
}
template <int KB>
__device__ __forceinline__ void qkt(f32x16& p0, f32x16& p1, const char* K_lds, const float* B_lds, int r32, int hi, const bf16x8* qr) {
    { const float* bp = B_lds + KB * 64 + 4 * hi;
      const f32x4 a0 = *(const f32x4*)(bp), a1 = *(const f32x4*)(bp + 8), a2 = *(const f32x4*)(bp + 16), a3 = *(const f32x4*)(bp + 24);
      const f32x4 c0 = *(const f32x4*)(bp + 32), c1 = *(const f32x4*)(bp + 40), c2 = *(const f32x4*)(bp + 48), c3 = *(const f32x4*)(bp + 56);
      p0 = (f32x16){a0[0], a0[1], a0[2], a0[3], a1[0], a1[1], a1[2], a1[3], a2[0], a2[1], a2[2], a2[3], a3[0], a3[1], a3[2], a3[3]};
      p1 = (f32x16){c0[0], c0[1], c0[2], c0[3], c1[0], c1[1], c1[2], c1[3], c2[0], c2[1], c2[2], c2[3], c3[0], c3[1], c3[2], c3[3]}; }
    const char* kb[4];
#pragma unroll
    for (int dd = 0; dd < 4; ++dd) kb[dd] = K_lds + KB * SHM_K + KSWZ(r32, (dd * 16 + hi * 8) * 2);
#pragma unroll
    for (int d0 = 0; d0 < 8; ++d0) { const char* a = kb[d0 & 3] + (d0 >> 2) * 128;
        bf16x8 b0 = *reinterpret_cast<const bf16x8*>(a);
        bf16x8 b1 = *reinterpret_cast<const bf16x8*>(a + 32 * 256);
        p0 = __builtin_amdgcn_mfma_f32_32x32x16_bf16(b0, qr[d0], p0, 0, 0, 0);
        p1 = __builtin_amdgcn_mfma_f32_32x32x16_bf16(b1, qr[d0], p1, 0, 0, 0); }
}
template <int VB>
__device__ __forceinline__ void pv_tile(f32x16* o, int vb0, bf16x8 pa0, bf16x8 pa1, bf16x8 pa2, bf16x8 pa3) {
#define TRRD(dst, off) asm volatile("ds_read_b64_tr_b16 %0, %1 offset:%2" : "=&v"(dst) : "v"(vb0), "i"(off) : "memory")
#define PV_D0(d0) do { s16x4 l0, l1, l2, l3, h0, h1, h2, h3; constexpr int b_ = VB * SHM_V + v_rd_off(d0, 0, 0); \
        TRRD(l0, b_); TRRD(h0, b_ + 2048); TRRD(l1, b_ + 4096); TRRD(h1, b_ + 6144); TRRD(l2, b_ + 8192); TRRD(h2, b_ + 10240); TRRD(l3, b_ + 12288); TRRD(h3, b_ + 14336); \
        asm volatile("s_waitcnt lgkmcnt(0)" ::: "memory"); SBAR();   \
        o[d0] = __builtin_amdgcn_mfma_f32_32x32x16_bf16(pa0, (bf16x8){l0[0], l0[1], l0[2], l0[3], h0[0], h0[1], h0[2], h0[3]}, o[d0], 0, 0, 0);   \
        o[d0] = __builtin_amdgcn_mfma_f32_32x32x16_bf16(pa1, (bf16x8){l1[0], l1[1], l1[2], l1[3], h1[0], h1[1], h1[2], h1[3]}, o[d0], 0, 0, 0);   \
        o[d0] = __builtin_amdgcn_mfma_f32_32x32x16_bf16(pa2, (bf16x8){l2[0], l2[1], l2[2], l2[3], h2[0], h2[1], h2[2], h2[3]}, o[d0], 0, 0, 0);   \
        o[d0] = __builtin_amdgcn_mfma_f32_32x32x16_bf16(pa3, (bf16x8){l3[0], l3[1], l3[2], l3[3], h3[0], h3[1], h3[2], h3[3]}, o[d0], 0, 0, 0); } while (0)
    PV_D0(0); PV_D0(1); PV_D0(2); PV_D0(3);
#undef PV_D0
#undef TRRD
}
struct BlockRef { const bf16* Q; const bf16* K; const bf16* V; const float* Bias; bf16* O; const bf16* Z; int P0, qpitch, kvpitch, nvalid, skv, canskip; float traw; };
__device__ __forceinline__ int fox_jlo(const BlockRef& r, int lane) { const float traw = r.traw;
    if (!r.canskip) return 0;
    const float bi = r.Bias[r.P0]; const int nt = r.P0 / KVBLK; int cnt = 0;
    for (int t0 = 0; t0 < nt; t0 += 64) { const int t = t0 + lane; const bool c = (t < nt) && (bi - r.Bias[(t < nt ? t : 0) * KVBLK + KVBLK - 1] > traw); cnt += __popcll(__ballot(c)); }
    return __builtin_amdgcn_readfirstlane(cnt);
}
}
struct Params;
template <class PRT> __device__ __forceinline__ fa::BlockRef attn_ref(PRT p, int L, int pass, float traw_p, float qkb, float knew);
namespace fa {
struct Seam { bf16x8 qr[8]; bf16x8 st_v0, st_v1, st_k0, st_k1; float st_b; };
#define VMW() asm volatile("s_waitcnt vmcnt(0)" ::: "memory")
#define VMWN(n) asm volatile("s_waitcnt vmcnt(%0)" :: "i"(n) : "memory")
#define SLOAD_H(Kp, Vp, Bp, pitch, k0) do { const unsigned vo_ = (unsigned)(sr * (pitch) + sc) * 2u; \
        const char* kb_ = (const char*)(Kp) + (size_t)(k0) * (size_t)(pitch) * 2; const char* vb_ = (const char*)(Vp) + (size_t)(k0) * (size_t)(pitch) * 2; const size_t r32_ = (size_t)(pitch) * 64; \
        S.st_v0 = *(const bf16x8*)(vb_ + vo_); S.st_v1 = *(const bf16x8*)(vb_ + r32_ + vo_);              \
        S.st_k0 = *(const bf16x8*)(kb_ + vo_); S.st_k1 = *(const bf16x8*)(kb_ + r32_ + vo_); S.st_b = *(const float*)((const char*)((Bp) + (k0)) + (unsigned)((tid & 63) * 4)); } while (0)
#define SWRITE_HK(bf) do { *(bf16x8*)(K_lds + (bf) * SHM_K + kws) = S.st_k0; *(bf16x8*)(K_lds + (bf) * SHM_K + kws + 32 * 256) = S.st_k1; if (tid < 64) B_lds[(bf) * 64 + tid] = S.st_b; } while (0)
#define SWRITE_HV(bf) do { *(bf16x8*)(V_lds + (bf) * SHM_V + vst0) = S.st_v0; *(bf16x8*)(V_lds + (bf) * SHM_V + vst1) = S.st_v1; } while (0)
#define SWRITE_H(bf) do { SWRITE_HV(bf); SWRITE_HK(bf); } while (0)
#define QLOAD(ref) do { const int qrow_ = wid * QBLK + r32; \
        _Pragma("unroll") for (int d0 = 0; d0 < 8; ++d0) S.qr[d0] = load8((ref).Q + (size_t)qrow_ * (ref).qpitch + d0 * 16 + hi * 8); } while (0)
__device__ __forceinline__ void fox_prime(const BlockRef& cur, char* lds, Seam& S, int wv, int jlo) {
    const int tid = tid_of(wv), wid = __builtin_amdgcn_readfirstlane(tid >> 6), lane = tid & 63, r32 = lane & 31, hi = lane >> 5;
    const int sr = tid >> 4, sc = (tid & 15) * 8, kws = KSWZ(sr, sc * 2); char* K_lds = lds + 2 * SHM_V; float* B_lds = (float*)(lds + OFF_BIAS);
    QLOAD(cur);
    SLOAD_H(cur.K, cur.V, cur.Bias, cur.kvpitch, jlo * KVBLK); VMW(); SWRITE_HK(0);
    __syncthreads();
}
template <class PRT> __device__ __forceinline__ void fox_block(PRT p, int L, int pass, int Ln, int passn, char* lds, Seam& S, int wv, int j_lo, int jlo_next, float traw, float qkb, float knew) {
    const BlockRef cur = attn_ref<PRT>(p, L, pass, traw, qkb, knew);
    const int tid = tid_of(wv), wid = __builtin_amdgcn_readfirstlane(tid >> 6), lane = tid & 63, r32 = lane & 31, hi = lane >> 5;
    int j_hi = (cur.P0 + QB - 1) / KVBLK + 1; if (j_hi > cur.skv / KVBLK) j_hi = cur.skv / KVBLK;
    const int NT = j_hi - j_lo;
    const int qlo = cur.P0 + wid * QBLK, qm = qlo + r32 - 4 * hi;
    char* V_lds = lds; char* K_lds = lds + 2 * SHM_V;
    float* ws = (float*)(lds + OFF_WS) + wid * 64; float* li_l = ws, * al_l = ws + 32; float* B_lds = (float*)(lds + OFF_BIAS);
    float m_reg = -1e30f, l_reg = 0; f32x16 o[4] = {};
    const int sr = tid >> 4, sc = (tid & 15) * 8, vst0 = v_st(sr, sc), vst1 = v_st(32 + sr, sc), kws = KSWZ(sr, sc * 2);
    const int vb0 = (int)(uintptr_t)V_lds + v_rd_base(lane);
    const bf16* Kh = cur.K; const bf16* Vh = cur.V; const float* Bh = cur.Bias; const int kvp = cur.kvpitch;
#define RESC(a) do { if (__any((a) < 1.f)) { if (hi == 0) al_l[r32] = (a); asm volatile("s_waitcnt lgkmcnt(0)" ::: "memory");              \
                     _Pragma("unroll") for (int d_ = 0; d_ < 4; ++d_) _Pragma("unroll") for (int r = 0; r < 16; ++r) o[d_][r] *= al_l[crow(r, hi)]; } } while (0)
#define KBASE(t) ((j_lo + (t)) * KVBLK)
#define MASKT(P0_, P1_, t) do { const int kb_ = KBASE(t); if (kb_ + KVBLK - 1 > qlo) mask_tile(P0_, P1_, qm - kb_); } while (0)
    f32x16 pA0, pA1, pB0, pB1; float mnA, mnB, alA, alB; bf16x8 pa0, pa1, pa2, pa3;
    SWRITE_HV(0); SBAR();
    if (NT > 1) { SLOAD_H(Kh, Vh, Bh, kvp, KBASE(1)); }
    SBAR(); qkt<0>(pA0, pA1, K_lds, B_lds, r32, hi, S.qr);
    MASKT(pA0, pA1, 0); partialSM(pA0, pA1, m_reg, mnA, alA);
    if (NT > 1) { VMW(); SWRITE_H(1); }
    __syncthreads();
#define HALF_STEP(PX0, PX1, mnX, alX, PY0, PY1, alY, t, KB, VB, SB) do {                                                      \
        SBAR(); qkt<KB>(PX0, PX1, K_lds, B_lds, r32, hi, S.qr);                                             \
        finishSM(PY0, PY1, alY, l_reg, pa0, pa1, pa2, pa3); SBAR();                                                           \
        if ((t) + 1 < NT) { SLOAD_H(Kh, Vh, Bh, kvp, KBASE((t) + 1)); SBAR(); }                                               \
        pv_tile<VB>(o, vb0, pa0, pa1, pa2, pa3); MASKT(PX0, PX1, (t)); partialSM(PX0, PX1, m_reg, mnX, alX);                                        \
        __syncthreads();                                                                                                      \
        if ((t) + 1 < NT) { VMW(); SWRITE_H(SB); }                                                                          \
        RESC(alX); __syncthreads(); } while (0)
    for (int t = 1; t + 1 < NT; t += 2) {
        HALF_STEP(pB0, pB1, mnB, alB, pA0, pA1, alA, t, 1, 0, 0);
        HALF_STEP(pA0, pA1, mnA, alA, pB0, pB1, alB, t + 1, 0, 1, 1);
    }
    const bool even = (NT & 1) == 0;
    if (even) { SBAR(); qkt<1>(pB0, pB1, K_lds, B_lds, r32, hi, S.qr); SBAR(); }
    { int Ln_ = __builtin_amdgcn_readfirstlane(Ln), pn_ = __builtin_amdgcn_readfirstlane(passn); asm volatile("" : "+s"(Ln_), "+s"(pn_)); const BlockRef nxt = attn_ref<PRT>(p, Ln_, pn_, traw, qkb, knew);
      const int jn_ = jlo_next;
      SLOAD_H(nxt.K, nxt.V, nxt.Bias, nxt.kvpitch, jn_ * KVBLK); SBAR();
      QLOAD(nxt); }
    SBAR();
    finishSM(pA0, pA1, alA, l_reg, pa0, pa1, pa2, pa3); SBAR();
    pv_tile<0>(o, vb0, pa0, pa1, pa2, pa3);
    if (even) { MASKT(pB0, pB1, NT - 1); partialSM(pB0, pB1, m_reg, mnB, alB); __syncthreads(); RESC(alB);
        finishSM(pB0, pB1, alB, l_reg, pa0, pa1, pa2, pa3); SBAR(); pv_tile<1>(o, vb0, pa0, pa1, pa2, pa3); }
    SBAR(); VMWN(8); SWRITE_HK(0); SBAR();
    if (hi == 0) li_l[r32] = l_reg; asm volatile("s_waitcnt lgkmcnt(0)" ::: "memory");
    float rli[16];
#pragma unroll
    for (int r = 0; r < 16; ++r) rli[r] = __builtin_amdgcn_rcpf(li_l[crow(r, hi)]);
    int Le_ = __builtin_amdgcn_readfirstlane(L), pe_ = __builtin_amdgcn_readfirstlane(pass); asm volatile("" : "+s"(Le_), "+s"(pe_)); const BlockRef ce = attn_ref<PRT>(p, Le_, pe_, traw, qkb, knew);
#pragma unroll
    for (int r = 0; r < 16; ++r) { const int orow = wid * QBLK + crow(r, hi);
#pragma unroll
        for (int d0 = 0; d0 < 4; ++d0) { const float v = o[d0][r] * rli[r];
            const float vn = __shfl_xor(v, 1);
            if ((r32 & 1) == 0 && orow < ce.nvalid) {
                const unsigned zz = *(const unsigned*)(ce.Z + (size_t)orow * ODD_N + d0 * 32 + r32);
                *(unsigned*)(ce.O + (size_t)orow * DM + d0 * 32 + r32) = cvtpk(v * silu_f(bflo(zz)), vn * silu_f(bfhi(zz))); } } }
    __syncthreads();
#undef RESC
#undef KBASE
#undef MASKT
#undef HALF_STEP
}
#undef ROWP
#undef VMW
#undef VMWN
#undef SLOAD_H
#undef SWRITE_HK
#undef SWRITE_HV
#undef SWRITE_H
#undef QLOAD
#undef SBAR
}
struct Params { const float* in[25]; float* out; unsigned char* ws; };
typedef const __attribute__((address_space(4))) Params& PR;
__device__ __forceinline__ const __attribute__((address_space(4))) Params* params_here() { const __attribute__((address_space(4))) Params* q = (const __attribute__((address_space(4))) Params*)__builtin_amdgcn_kernarg_segment_ptr(); asm volatile("" : "+s"(q)); return q; }
enum { I_XP = 0, I_XS, I_CK, I_CV, I_CLF, I_SSD, I_SCONV, I_NPRE, I_NPOST, I_WINE, I_WOUTE, I_GWS, I_GBS, I_GGV, I_CW, I_CB, I_DTB, I_ALOG, I_DSK, I_GSSD, I_WINO, I_BF, I_WOUTO, I_GQ, I_GK };

template <int MODE> struct EpiProj {
    static constexpr bool PERM = true, AFTER_DRAIN = false;
    unsigned char* ws; float* out; const float* gq; const float* gk; float* xl; int jl;
    __device__ __forceinline__ void operator()(const pg8::f32x4 (&acc)[2][2][4][2], const pg8::Unit& u, int wr, int wc, int fr, int fq) const {
        constexpr int ldc = MODE == 0 ? 1024 : (MODE == 1 ? EVEN_N : ODD_N), n_main = ldc / 256, thin_cols = MODE == 1 ? 16 : 8;
        bf16* O = (bf16*)(ws + (MODE == 0 ? WS_O : WS_PROJ));
        const int row0 = u.pm * 256 + wr * 64 + fr;
        if (MODE == 0 || u.pn < n_main) {
            const int col0 = u.pn * 256 + wc * 32 + 8 * fq;
            const bool isv = MODE == 2 && u.pn >= 8 && u.pn < 12, isqk = MODE == 2 && u.pn < 8, isk = isqk && u.pn >= 4;
            float rs[2][2][4];
            pg8::f32x4 g0 = {1.f, 1.f, 1.f, 1.f}, g1 = {1.f, 1.f, 1.f, 1.f};
            if (MODE == 2 && isqk) {
#pragma unroll
                for (int ai = 0; ai < 2; ++ai)
#pragma unroll
                    for (int bj = 0; bj < 2; ++bj)
#pragma unroll
                        for (int m = 0; m < 4; ++m) { const pg8::f32x4 a = acc[ai][bj][m][0], b = acc[ai][bj][m][1];
                            float s = (a[0] * a[0] + a[1] * a[1]) + (a[2] * a[2] + a[3] * a[3]) + (b[0] * b[0] + b[1] * b[1]) + (b[2] * b[2] + b[3] * b[3]);
                            s += __shfl_xor(s, 16); s += __shfl_xor(s, 32);
                            if (fq == 0) xl[((((wr * 4 + wc) * 2 + ai) * 2 + bj) * 4 + m) * 16 + fr] = s; }
                asm volatile("s_waitcnt lgkmcnt(0)" ::: "memory"); __builtin_amdgcn_s_barrier(); asm volatile("" ::: "memory");
#pragma unroll
                for (int ai = 0; ai < 2; ++ai)
#pragma unroll
                    for (int bj = 0; bj < 2; ++bj)
#pragma unroll
                        for (int m = 0; m < 4; ++m) { float t = 0.f;
#pragma unroll
                            for (int w4 = 0; w4 < 4; ++w4) t += xl[((((wr * 4 + w4) * 2 + ai) * 2 + bj) * 4 + m) * 16 + fr];
                            rs[ai][bj][m] = rsqrtf(t * (1.f / 128.f) + EPS); }
                const float* gp = (isk ? gk : gq) + wc * 32 + 8 * fq; g0 = *(const pg8::f32x4*)gp; g1 = *(const pg8::f32x4*)(gp + 4);
            }
#pragma unroll
            for (int ai = 0; ai < 2; ++ai)
#pragma unroll
                for (int m = 0; m < 4; ++m) { const int row = row0 + ai * 128 + m * 16; bf16* rowp = O + (size_t)row * ldc + col0;
#pragma unroll
                    for (int bj = 0; bj < 2; ++bj) { pg8::f32x4 v0 = acc[ai][bj][m][0], v1 = acc[ai][bj][m][1];
                        if (MODE == 2 && isqk) { v0 = v0 * rs[ai][bj][m] * g0; v1 = v1 * rs[ai][bj][m] * g1; }
                        u32x4 w; w.x = cvtpk(v0[0], v0[1]); w.y = cvtpk(v0[2], v0[3]); w.z = cvtpk(v1[0], v1[1]); w.w = cvtpk(v1[2], v1[3]);
                        *(u32x4*)(rowp + bj * 128) = w;
                        if (MODE == 2 && (isv || isk)) { const int vc = col0 - (isv ? 2048 : 1024) + bj * 128; const bool samp = row >= TP;
                            float* vo = out + (isv ? (samp ? O_VS + ((size_t)jl * TS + (row - TP)) * DM : O_VP + ((size_t)jl * TP + row) * DM)
                                                   : (samp ? O_KS + ((size_t)jl * TS + (row - TP)) * DM : O_KP + ((size_t)jl * TP + row) * DM)) + vc;
                            *(pg8::f32x4*)vo = v0; *(pg8::f32x4*)(vo + 4) = v1;
                            if (samp) { const int sr = row - TP; *(u32x4*)((bf16*)(ws + (isv ? WS_VS : WS_KS)) + ((size_t)(sr / SSEQ) * SKS + PAST + (sr % SSEQ)) * DM + vc) = w; } } } }
        } else if (MODE != 0) {
            if (wc == 0 && 8 * fq < thin_cols) { float* thin = (float*)(ws + (MODE == 1 ? WS_DTRAW : WS_FLOG));
#pragma unroll
                for (int ai = 0; ai < 2; ++ai)
#pragma unroll
                    for (int m = 0; m < 4; ++m) { float* tp = thin + (size_t)(row0 + ai * 128 + m * 16) * thin_cols + 8 * fq;
                        *(pg8::f32x4*)tp = acc[ai][0][m][0]; *(pg8::f32x4*)(tp + 4) = acc[ai][0][m][1]; }
            }
        }
    }
};

__device__ __forceinline__ void transpose_item(const float* W, int K, int N, bf16* WT, float* scr, int item, int nblk, int lane) {
    const int kb = item / nblk, nb = item % nblk, k0 = 64 * kb, n0 = 32 * nb;
    const int ncol = n0 + (lane & 31);
#pragma unroll 8
    for (int i = 0; i < 32; ++i) { const int kk = 2 * i + (lane >> 5); scr[kk * 33 + (lane & 31)] = (ncol < N) ? W[(size_t)(k0 + kk) * N + ncol] : 0.f; }
    asm volatile("s_waitcnt lgkmcnt(0)" ::: "memory");
    const int c = lane & 7;
#pragma unroll
    for (int j = 0; j < 4; ++j) { const int n = (lane >> 3) + 8 * j; const float* s = scr + (8 * c) * 33 + n;
        u32x4 o; o.x = cvtpk(s[0 * 33], s[1 * 33]); o.y = cvtpk(s[2 * 33], s[3 * 33]); o.z = cvtpk(s[4 * 33], s[5 * 33]); o.w = cvtpk(s[6 * 33], s[7 * 33]);
        *(u32x4*)(WT + (size_t)(n0 + n) * K + k0 + 8 * c) = o; }
    asm volatile("s_waitcnt lgkmcnt(0)" ::: "memory");
}
__device__ __forceinline__ void phase_prologue(int wv, PR p, char* lds) {
    const int tid = tid_of(wv), lane = tid & 63, wave = __builtin_amdgcn_readfirstlane(tid >> 6), gw = bid_here() * 8 + wave, NGW = gridDim.x * 8;
    float* scr = (float*)(lds + wave * 8704);
    constexpr int I0 = 16 * (EVEN_NP / 32), I1 = 32 * 32, I2 = 16 * (ODD_NP / 32), I3 = 16 * 32;
    constexpr int NIT = 2 * (I0 + I1 + I2 + I3);
    for (int it = gw; it < NIT; it += NGW) {
        int r = it; const int j = r & 1; r >>= 1;
        if (r < I0) { transpose_item(p.in[I_WINE] + (size_t)j * 1024 * EVEN_IN, 1024, EVEN_IN, (bf16*)(p.ws + WS_WINE) + (size_t)j * EVEN_NP * 1024, scr, r, EVEN_NP / 32, lane); continue; } r -= I0;
        if (r < I1) { transpose_item(p.in[I_WOUTE] + (size_t)j * 2048 * 1024, 2048, 1024, (bf16*)(p.ws + WS_WOUTE) + (size_t)j * 1024 * 2048, scr, r, 32, lane); continue; } r -= I1;
        if (r < I2) { transpose_item(p.in[I_WINO] + (size_t)j * 1024 * ODD_IN, 1024, ODD_IN, (bf16*)(p.ws + WS_WINO) + (size_t)j * ODD_NP * 1024, scr, r, ODD_NP / 32, lane); continue; } r -= I2;
        transpose_item(p.in[I_WOUTO] + (size_t)j * 1024 * 1024, 1024, 1024, (bf16*)(p.ws + WS_WOUTO) + (size_t)j * 1024 * 1024, scr, r, 32, lane);
    }
}

__device__ __forceinline__ void phase_norm(int wv, PR p, int li) {
    const int tid = tid_of(wv), lane = tid & 63, wave = __builtin_amdgcn_readfirstlane(tid >> 6), gw = bid_here() * 8 + wave, NGW = gridDim.x * 8;
    bf16* resb = (bf16*)(p.ws + WS_RES); const bf16* ob = (const bf16*)(p.ws + WS_O); bf16* hb = (bf16*)(p.ws + WS_H);
    const float* gpost = p.in[I_NPOST] + (li > 0 ? (li - 1) * DM : 0); const float* gpre = p.in[I_NPRE] + (li < 4 ? li * DM : 0);
    f32x4 gpo[4], gpr[4];
#pragma unroll
    for (int j = 0; j < 4; ++j) { gpo[j] = *(const f32x4*)(gpost + 4 * lane + 256 * j); gpr[j] = *(const f32x4*)(gpre + 4 * lane + 256 * j); }
    for (int row0 = gw; row0 < TT; row0 += 2 * NGW) {
        int rows[2] = {row0, row0 + NGW}; const bool v1 = rows[1] < TT; if (!v1) rows[1] = row0;
        f32x4 x[2][4]; u32x2 ow[2][4];
#pragma unroll
        for (int k = 0; k < 2; ++k) { const int row = rows[k];
            if (li <= 1) { const float* xin = row < TP ? p.in[I_XP] + (size_t)row * DM : p.in[I_XS] + (size_t)(row - TP) * DM;
#pragma unroll
                for (int j = 0; j < 4; ++j) x[k][j] = *(const f32x4*)(xin + 4 * lane + 256 * j); }
            else {
#pragma unroll
                for (int j = 0; j < 4; ++j) { const u32x2 w = *(const u32x2*)(resb + (size_t)row * DM + 4 * lane + 256 * j); x[k][j] = (f32x4){bflo(w.x), bfhi(w.x), bflo(w.y), bfhi(w.y)}; } }
            if (li > 0) {
#pragma unroll
                for (int j = 0; j < 4; ++j) ow[k][j] = *(const u32x2*)(ob + (size_t)row * DM + 4 * lane + 256 * j); } }
#pragma unroll
        for (int k = 0; k < 2; ++k) { const int row = rows[k]; if (k == 1 && !v1) break;
            if (li > 0) {
                f32x4 o[4]; float s = 0.f;
#pragma unroll
                for (int j = 0; j < 4; ++j) { const u32x2 w = ow[k][j];
                    o[j] = (f32x4){bflo(w.x), bfhi(w.x), bflo(w.y), bfhi(w.y)}; s += (o[j].x * o[j].x + o[j].y * o[j].y) + (o[j].z * o[j].z + o[j].w * o[j].w); }
                const float r = rsqrtf(wave_sum(s) * (1.f / DM) + EPS);
#pragma unroll
                for (int j = 0; j < 4; ++j) { x[k][j] = x[k][j] + o[j] * r * gpo[j];
                    if (li == 4) *(f32x4*)(p.out + (size_t)row * DM + 4 * lane + 256 * j) = x[k][j];
                    else { u32x2 w; w.x = cvtpk(x[k][j].x, x[k][j].y); w.y = cvtpk(x[k][j].z, x[k][j].w); *(u32x2*)(resb + (size_t)row * DM + 4 * lane + 256 * j) = w;
                           x[k][j] = (f32x4){bflo(w.x), bfhi(w.x), bflo(w.y), bfhi(w.y)}; } }
            }
            if (li < 4) {
                float s = 0.f;
#pragma unroll
                for (int j = 0; j < 4; ++j) s += (x[k][j].x * x[k][j].x + x[k][j].y * x[k][j].y) + (x[k][j].z * x[k][j].z + x[k][j].w * x[k][j].w);
                const float r = rsqrtf(wave_sum(s) * (1.f / DM) + EPS);
#pragma unroll
                for (int j = 0; j < 4; ++j) { const f32x4 h = x[k][j] * r * gpr[j];
                    u32x2 w; w.x = cvtpk(h.x, h.y); w.y = cvtpk(h.z, h.w); *(u32x2*)(hb + (size_t)row * DM + 4 * lane + 256 * j) = w; }
            }
        }
    }
}

constexpr int NCHP = TP / 64, NCH = NCHP + NSB;
constexpr size_t A_XT = 0, A_B = A_XT + (size_t)NCH * 16 * 64 * 64 * 2, A_C = A_B + (size_t)NCH * 64 * 256 * 2, A_BT = A_C + (size_t)NCH * 64 * 256 * 2;
constexpr size_t A_DT = A_BT + (size_t)NCH * 2 * 128 * 64 * 2, A_ACS = A_DT + (size_t)NCH * 16 * 64 * 4, A_W = A_ACS + (size_t)NCH * 16 * 64 * 4, A_END = A_W + (size_t)NCH * 16 * 64 * 4;
static_assert(A_END <= 163 * MiB, "act layouts");
__device__ __forceinline__ void phase_conv(int wv, PR p, int jl) {
    const int tid = tid_of(wv), lane = tid & 63, wave = __builtin_amdgcn_readfirstlane(tid >> 6);
    const int gtid = bid_here() * 512 + tid, gthreads = gridDim.x * 512;
    const bf16* proj = (const bf16*)(p.ws + WS_PROJ);
    bf16* XT = (bf16*)(p.ws + WS_ACT + A_XT); bf16* Bact = (bf16*)(p.ws + WS_ACT + A_B); bf16* Cact = (bf16*)(p.ws + WS_ACT + A_C); bf16* BT = (bf16*)(p.ws + WS_ACT + A_BT);
    const float* cw = p.in[I_CW] + (size_t)jl * CONV_DIM * 4; const float* cb = p.in[I_CB] + (size_t)jl * CONV_DIM;
    constexpr int NCG = CONV_DIM / 8;
    for (int idx = gtid; idx < NCH * NCG; idx += gthreads) {
        const int ch = idx / NCG, cgp = idx - ch * NCG, c0 = cgp * 8;
        int row0, Lv, b; bool samp, first, lastc;
        if (ch < NCHP) { b = ch >> 7; const int t0 = (ch & 127) * 64; row0 = b * SEQ + t0; Lv = 64; samp = false; first = (t0 == 0); lastc = (t0 + 64 == SEQ); }
        else { b = ch - NCHP; row0 = TP + b * SSEQ; Lv = SSEQ; samp = true; first = true; lastc = true; }
        float w[8][4], bias[8], xm3[8], xm2[8], xm1[8];
#pragma unroll
        for (int e = 0; e < 8; ++e) { const f32x4 t = *(const f32x4*)(cw + (size_t)(c0 + e) * 4); w[e][0] = t.x; w[e][1] = t.y; w[e][2] = t.z; w[e][3] = t.w; bias[e] = cb[c0 + e]; }
        if (first) {
            if (samp) { const float* sc = p.in[I_SCONV] + ((size_t)(jl * NSB + b) * 3) * CONV_DIM + c0;
#pragma unroll
                for (int e = 0; e < 8; ++e) { xm3[e] = sc[e]; xm2[e] = sc[CONV_DIM + e]; xm1[e] = sc[2 * CONV_DIM + e]; } }
            else {
#pragma unroll
                for (int e = 0; e < 8; ++e) { xm3[e] = 0.f; xm2[e] = 0.f; xm1[e] = 0.f; } }
        } else {
            unpack8(*(const u32x4*)(proj + (size_t)(row0 - 3) * EVEN_N + 4096 + c0), xm3);
            unpack8(*(const u32x4*)(proj + (size_t)(row0 - 2) * EVEN_N + 4096 + c0), xm2);
            unpack8(*(const u32x4*)(proj + (size_t)(row0 - 1) * EVEN_N + 4096 + c0), xm1);
        }
        u32x4 nx[8];
#pragma unroll
        for (int t = 0; t < 8; ++t) nx[t] = *(const u32x4*)(proj + (size_t)(row0 + t) * EVEN_N + 4096 + c0);
#pragma unroll 1
        for (int tb = 0; tb < 8; ++tb) {
            float v[8][8];
            if (8 * tb < Lv) {
                u32x4 cur[8];
#pragma unroll
                for (int t = 0; t < 8; ++t) cur[t] = nx[t];
                if (8 * (tb + 1) < Lv) {
#pragma unroll
                    for (int t = 0; t < 8; ++t) nx[t] = *(const u32x4*)(proj + (size_t)(row0 + 8 * (tb + 1) + t) * EVEN_N + 4096 + c0); }
#pragma unroll
                for (int t = 0; t < 8; ++t) { float x[8]; unpack8(cur[t], x);
#pragma unroll
                    for (int e = 0; e < 8; ++e) { const float y = bias[e] + xm3[e] * w[e][0] + xm2[e] * w[e][1] + xm1[e] * w[e][2] + x[e] * w[e][3]; v[t][e] = silu_f(y); xm3[e] = xm2[e]; xm2[e] = xm1[e]; xm1[e] = x[e]; } }
            } else {
#pragma unroll
                for (int t = 0; t < 8; ++t)
#pragma unroll
                    for (int e = 0; e < 8; ++e) v[t][e] = 0.f;
            }
            if (c0 < 1024 || (c0 >= 1024 && c0 < 1280)) {
                bf16* dst = (c0 < 1024) ? XT + ((((size_t)ch * 16 + (c0 >> 6)) * 8 + tb) * 64 + (c0 & 63)) * 8 : BT + ((((size_t)ch * 2 + ((c0 - 1024) >> 7)) * 8 + tb) * 128 + ((c0 - 1024) & 127)) * 8;
#pragma unroll
                for (int e = 0; e < 8; ++e) { u32x4 o; o.x = cvtpk(v[0][e], v[1][e]); o.y = cvtpk(v[2][e], v[3][e]); o.z = cvtpk(v[4][e], v[5][e]); o.w = cvtpk(v[6][e], v[7][e]); *(u32x4*)(dst + (size_t)e * 8) = o; }
            }
            if (c0 >= 1024) {
                bf16* dst = (c0 < 1280 ? Bact + (c0 - 1024) : Cact + (c0 - 1280)) + ((size_t)ch * 64 + 8 * tb) * 256;
#pragma unroll
                for (int t = 0; t < 8; ++t) *(u32x4*)(dst + (size_t)t * 256) = pack8f(v[t]);
            }
        }
        if (lastc) {
            float* co = p.out + (samp ? O_CS + ((size_t)(jl * NSB + b) * 3) * CONV_DIM : O_CP + ((size_t)(jl * NB + b) * 3) * CONV_DIM) + c0;
#pragma unroll
            for (int e = 0; e < 8; ++e) { co[e] = xm3[e]; co[CONV_DIM + e] = xm2[e]; co[2 * CONV_DIM + e] = xm1[e]; }
        }
    }
    { const float* dtraw = (const float*)(p.ws + WS_DTRAW); float* DT = (float*)(p.ws + WS_ACT + A_DT); float* ACS = (float*)(p.ws + WS_ACT + A_ACS); float* WW = (float*)(p.ws + WS_ACT + A_W);
      const int gw = bid_here() * 8 + wave, NGW = gridDim.x * 8;
      for (int it = gw; it < NCH * 16; it += NGW) { const int ch = it >> 4, h = it & 15;
          const int row = (ch < NCHP) ? ch * 64 + lane : TP + (ch - NCHP) * SSEQ + lane; const bool valid = (ch < NCHP) || lane < SSEQ;
          float dt = 0.f; if (valid) dt = softplus_f(dtraw[(size_t)row * 16 + h] + p.in[I_DTB][jl * 16 + h]);
          const float a_h = -__expf(p.in[I_ALOG][jl * 16 + h]);
          float acs = dt * a_h;
#pragma unroll
          for (int o = 1; o < 64; o <<= 1) { const float t = __shfl_up(acs, o); if (lane >= o) acs += t; }
          const float alast = __shfl(acs, 63);
          DT[(size_t)it * 64 + lane] = dt; ACS[(size_t)it * 64 + lane] = acs; WW[(size_t)it * 64 + lane] = dt * __expf(alast - acs); } }
}

constexpr int GM_WSTR = 136;
__device__ __forceinline__ void phase_gmlp(int wv, PR p, int jl, char* lds) {
    const int tid = tid_of(wv), lane = tid & 63, wave = tid >> 6;
    const bf16* proj = (const bf16*)(p.ws + WS_PROJ); bf16* cat = (bf16*)(p.ws + WS_CAT);
    bf16* Wl = (bf16*)lds; bf16* vT = (bf16*)(lds + 128 * GM_WSTR * 2);
    constexpr int NU = (TP / 128 + NSB) * 4;
    for (int u = bid_here(); u < NU; u += gridDim.x) {
        const int g = u & 3, cu = u >> 2;
        int row0, n; bool samp; int sb = 0;
        if (cu < TP / 128) { row0 = cu * 128; n = 128; samp = false; } else { sb = cu - TP / 128; row0 = TP + sb * SSEQ; n = SSEQ; samp = true; }
        __syncthreads();
        { const int j = tid >> 2, q = tid & 3; const bool valid = j < n;
          float v[64]; float ss = 0.f;
          const float* gv = p.in[I_GGV] + (size_t)(jl * 4 + g) * 256;
#pragma unroll
          for (int i = 0; i < 8; ++i) { const int cc = (q + 4 * i) * 8;
              u32x4 w = {0u, 0u, 0u, 0u}; if (valid) w = *(const u32x4*)(proj + (size_t)(row0 + j) * EVEN_N + 1024 + g * 256 + cc);
              float f[8]; unpack8(w, f);
#pragma unroll
              for (int e = 0; e < 8; e += 2) { const f32x2 gg = pg8::gelu_pk((f32x2){f[e], f[e + 1]}); v[i * 8 + e] = gg.x; v[i * 8 + e + 1] = gg.y; ss += gg.x * gg.x + gg.y * gg.y; } }
          ss += __shfl_xor(ss, 1); ss += __shfl_xor(ss, 2);
          const float r = rsqrtf(ss * (1.f / 256.f) + EPS);
#pragma unroll
          for (int i = 0; i < 8; ++i) { const int cc = (q + 4 * i) * 8;
#pragma unroll
              for (int e = 0; e < 8; ++e) v[i * 8 + e] = v[i * 8 + e] * r * gv[cc + e];
              if (samp && valid) { float* go = p.out + O_GV + ((size_t)(jl * NSB + sb) * SSEQ + j) * DM + g * 256 + cc;
                  *(f32x4*)go = (f32x4){v[i * 8], v[i * 8 + 1], v[i * 8 + 2], v[i * 8 + 3]}; *(f32x4*)(go + 4) = (f32x4){v[i * 8 + 4], v[i * 8 + 5], v[i * 8 + 6], v[i * 8 + 7]}; }
#pragma unroll
              for (int e = 0; e < 8; e += 2) { const unsigned pk = cvtpk(v[i * 8 + e], v[i * 8 + e + 1]); vT[(cc + e) * GM_WSTR + j] = (bf16)(pk & 0xffffu); vT[(cc + e + 1) * GM_WSTR + j] = (bf16)(pk >> 16); } }
        }
        { const int i = tid >> 2, jq = tid & 3; const float* wsrc = p.in[I_GWS] + ((size_t)(jl * 4 + g) * 128 + i) * 128 + jq * 32;
#pragma unroll
          for (int c = 0; c < 4; ++c) { float f[8];
              const f32x4 a = *(const f32x4*)(wsrc + c * 8), b = *(const f32x4*)(wsrc + c * 8 + 4);
              f[0] = a.x; f[1] = a.y; f[2] = a.z; f[3] = a.w; f[4] = b.x; f[5] = b.y; f[6] = b.z; f[7] = b.w;
              const int j0 = jq * 32 + c * 8;
              const bool keep = (i < n) && (j0 < n) && ((j0 >> 6) <= (i >> 6));
              if (!keep) {
#pragma unroll
                  for (int e = 0; e < 8; ++e) f[e] = 0.f; }
              *(u32x4*)(Wl + i * GM_WSTR + j0) = pack8f(f); } }
        __syncthreads();
        const int wi = wave >> 2, wj = wave & 3, fr = lane & 15, fq = lane >> 4;
        f32x4 acc[4][4];
#pragma unroll
        for (int a = 0; a < 4; ++a)
#pragma unroll
            for (int b = 0; b < 4; ++b) acc[a][b] = (f32x4){0.f, 0.f, 0.f, 0.f};
        const int nks = (wi == 0) ? 2 : 4;
        for (int ks = 0; ks < nks; ++ks) {
            bf16x8 af[4], bfr[4];
#pragma unroll
            for (int mi = 0; mi < 4; ++mi) af[mi] = *(const bf16x8*)(Wl + (64 * wi + 16 * mi + fr) * GM_WSTR + ks * 32 + fq * 8);
#pragma unroll
            for (int ni = 0; ni < 4; ++ni) bfr[ni] = *(const bf16x8*)(vT + (64 * wj + 16 * ni + fr) * GM_WSTR + ks * 32 + fq * 8);
#pragma unroll
            for (int ni = 0; ni < 4; ++ni)
#pragma unroll
                for (int mi = 0; mi < 4; ++mi) acc[ni][mi] = __builtin_amdgcn_mfma_f32_16x16x32_bf16(bfr[ni], af[mi], acc[ni][mi], 0, 0, 0);
        }
        const float* bs = p.in[I_GBS] + (size_t)(jl * 4 + g) * 128;
#pragma unroll
        for (int mi = 0; mi < 4; ++mi) { const int i = 64 * wi + 16 * mi + fr;
            if (i < n) { const float bsi = bs[i]; const size_t rb = (size_t)(row0 + i) * EVEN_N;
#pragma unroll
                for (int ni = 0; ni < 4; ++ni) { const int col = g * 256 + 64 * wj + 16 * ni + 4 * fq;
                    const u32x2 uu = *(const u32x2*)(proj + rb + col), zz = *(const u32x2*)(proj + rb + 2048 + col);
                    const f32x2 g0 = pg8::gelu_pk((f32x2){bflo(uu.x), bfhi(uu.x)}), g1 = pg8::gelu_pk((f32x2){bflo(uu.y), bfhi(uu.y)});
                    const f32x4 s = acc[ni][mi] + bsi;
                    u32x2 o; o.x = cvtpk(silu_f(bflo(zz.x)) * g0.x * s.x, silu_f(bfhi(zz.x)) * g0.y * s.y); o.y = cvtpk(silu_f(bflo(zz.y)) * g1.x * s.z, silu_f(bfhi(zz.y)) * g1.y * s.w);
                    *(u32x2*)(cat + (size_t)(row0 + i) * 2048 + col) = o; } } }
    }
}

__device__ __forceinline__ void phase_scan(int wv, PR p, int jl, char* lds) {
    const int tid = tid_of(wv), lane = tid & 63, wave = __builtin_amdgcn_readfirstlane(tid >> 6), fr = lane & 15, fq = lane >> 4;
    const bf16* XT = (const bf16*)(p.ws + WS_ACT + A_XT); const bf16* Bact = (const bf16*)(p.ws + WS_ACT + A_B); const bf16* Cact = (const bf16*)(p.ws + WS_ACT + A_C); const bf16* BT = (const bf16*)(p.ws + WS_ACT + A_BT);
    const float* DT = (const float*)(p.ws + WS_ACT + A_DT); const float* ACS = (const float*)(p.ws + WS_ACT + A_ACS); const float* WW = (const float*)(p.ws + WS_ACT + A_W);
    bf16* yb = (bf16*)(p.ws + WS_O);
    bf16* Cs = (bf16*)lds; bf16* Bs = Cs + 64 * 136; bf16* BTs = Bs + 64 * 136; bf16* XTs = BTs + 128 * 72; bf16* Ms = XTs + 16 * 72; bf16* Sb = Ms + 64 * 72;
    float* DTs = (float*)(Sb + 2 * 16 * 136); float* ACSs = DTs + 64; float* Ws = ACSs + 64;
    constexpr int NITEM = NB * 64 + NSB * 64;
    for (int it = vcu_here(); it < NITEM; it += gridDim.x) {
        int seq, h, pq, ch0, nch; bool samp;
        if (it < NB * 64) { seq = it >> 6; h = (it >> 2) & 15; pq = it & 3; ch0 = seq * 128; nch = 128; samp = false; }
        else { const int r = it - NB * 64; seq = r >> 6; h = (r >> 2) & 15; pq = r & 3; ch0 = NCHP + seq; nch = 1; samp = true; }
        const int g = h >> 3; const float dsk = p.in[I_DSK][jl * 16 + h];
        f32x4 accS = {0.f, 0.f, 0.f, 0.f};
        __syncthreads();
        { float* st = nullptr; if (samp) st = (float*)p.in[I_SSD] + (((size_t)(jl * NSB + seq) * 16 + h) * 64 + 16 * pq) * 128;
#pragma unroll
          for (int e = 0; e < 4; ++e) { if (samp) accS[e] = st[(size_t)(4 * fq + e) * 128 + 16 * wave + fr]; Sb[(4 * fq + e) * 136 + 16 * wave + fr] = (bf16)(cvtpk(accS[e], 0.f) & 0xffffu); } }
        u32x4 rC0, rC1, rB0, rB1, rT0, rT1, rX; float rS = 0.f;
#define SSD_LOAD(ch) do { const size_t cb_ = (size_t)(ch) * 64 * 256 + g * 128; \
        rC0 = *(const u32x4*)(Cact + cb_ + (size_t)(tid >> 4) * 256 + (tid & 15) * 8); rC1 = *(const u32x4*)(Cact + cb_ + (size_t)(32 + (tid >> 4)) * 256 + (tid & 15) * 8); \
        rB0 = *(const u32x4*)(Bact + cb_ + (size_t)(tid >> 4) * 256 + (tid & 15) * 8); rB1 = *(const u32x4*)(Bact + cb_ + (size_t)(32 + (tid >> 4)) * 256 + (tid & 15) * 8); \
        const bf16* bt_ = BT + ((size_t)(ch) * 2 + g) * 128 * 64; rT0 = *(const u32x4*)(bt_ + ((size_t)(tid & 7) * 128 + (tid >> 3)) * 8); rT1 = *(const u32x4*)(bt_ + ((size_t)(tid & 7) * 128 + 64 + (tid >> 3)) * 8); \
        if (tid < 128) rX = *(const u32x4*)(XT + ((((size_t)(ch) * 16 + h) * 8 + (tid & 7)) * 64 + 16 * pq + (tid >> 3)) * 8); \
        else if (tid < 320) { const int k_ = (tid - 128) >> 6; const float* src_ = k_ == 0 ? DT : (k_ == 1 ? ACS : WW); rS = src_[((size_t)(ch) * 16 + h) * 64 + (tid & 63)]; } } while (0)
        SSD_LOAD(ch0);
        for (int c = 0; c < nch; ++c) {
            const int ch = ch0 + c;
            __syncthreads();
            *(u32x4*)(Cs + (tid >> 4) * 136 + (tid & 15) * 8) = rC0; *(u32x4*)(Cs + (32 + (tid >> 4)) * 136 + (tid & 15) * 8) = rC1;
            *(u32x4*)(Bs + (tid >> 4) * 136 + (tid & 15) * 8) = rB0; *(u32x4*)(Bs + (32 + (tid >> 4)) * 136 + (tid & 15) * 8) = rB1;
            *(u32x4*)(BTs + (tid >> 3) * 72 + (tid & 7) * 8) = rT0; *(u32x4*)(BTs + (64 + (tid >> 3)) * 72 + (tid & 7) * 8) = rT1;
            if (tid < 128) *(u32x4*)(XTs + (tid >> 3) * 72 + (tid & 7) * 8) = rX;
            else if (tid < 320) DTs[tid - 128] = rS;
            __syncthreads();
            if (c + 1 < nch) SSD_LOAD(ch + 1);
            { const int lt = wave >> 1, sth = wave & 1;
              f32x4 a0 = {0.f, 0.f, 0.f, 0.f}, a1 = {0.f, 0.f, 0.f, 0.f};
              if (2 * sth <= lt) {
#pragma unroll
                  for (int kk = 0; kk < 4; ++kk) { const bf16x8 yf = *(const bf16x8*)(Cs + (16 * lt + fr) * 136 + 32 * kk + 8 * fq);
                      const bf16x8 x0 = *(const bf16x8*)(Bs + (32 * sth + fr) * 136 + 32 * kk + 8 * fq), x1 = *(const bf16x8*)(Bs + (32 * sth + 16 + fr) * 136 + 32 * kk + 8 * fq);
                      a0 = __builtin_amdgcn_mfma_f32_16x16x32_bf16(x0, yf, a0, 0, 0, 0); a1 = __builtin_amdgcn_mfma_f32_16x16x32_bf16(x1, yf, a1, 0, 0, 0); } }
              const int l = 16 * lt + fr; const float al = ACSs[l];
#pragma unroll
              for (int j = 0; j < 2; ++j) { const int s0 = 32 * sth + 16 * j + 4 * fq; const f32x4 as = *(const f32x4*)(ACSs + s0), ds = *(const f32x4*)(DTs + s0); const f32x4 ga = j ? a1 : a0; float m[4];
#pragma unroll
                  for (int e = 0; e < 4; ++e) m[e] = (s0 + e <= l) ? ga[e] * __expf(al - as[e]) * ds[e] : 0.f;
                  u32x2 o; o.x = cvtpk(m[0], m[1]); o.y = cvtpk(m[2], m[3]); *(u32x2*)(Ms + l * 72 + s0) = o; } }
            { const float dec = __expf(ACSs[63]);
#pragma unroll
              for (int e = 0; e < 4; ++e) accS[e] *= dec;
#pragma unroll
              for (int kk = 0; kk < 2; ++kk) { float xf[8]; unpack8(*(const u32x4*)(XTs + fr * 72 + 32 * kk + 8 * fq), xf);
                  const f32x4 w0 = *(const f32x4*)(Ws + 32 * kk + 8 * fq), w1 = *(const f32x4*)(Ws + 32 * kk + 8 * fq + 4);
                  xf[0] *= w0.x; xf[1] *= w0.y; xf[2] *= w0.z; xf[3] *= w0.w; xf[4] *= w1.x; xf[5] *= w1.y; xf[6] *= w1.z; xf[7] *= w1.w;
                  const u32x4 xw = pack8f(xf); const bf16x8 bfrag = *(const bf16x8*)(BTs + (16 * wave + fr) * 72 + 32 * kk + 8 * fq);
                  accS = __builtin_amdgcn_mfma_f32_16x16x32_bf16(*(const bf16x8*)&xw, bfrag, accS, 0, 0, 0); }
              bf16* sbn = Sb + ((c + 1) & 1) * 16 * 136;
#pragma unroll
              for (int e = 0; e < 4; ++e) sbn[(4 * fq + e) * 136 + 16 * wave + fr] = (bf16)(cvtpk(accS[e], 0.f) & 0xffffu); }
            __syncthreads();
            if (wave < 4) { const bf16* sbc = Sb + (c & 1) * 16 * 136; f32x4 ay = {0.f, 0.f, 0.f, 0.f};
#pragma unroll
                for (int kk = 0; kk < 4; ++kk) ay = __builtin_amdgcn_mfma_f32_16x16x32_bf16(*(const bf16x8*)(sbc + fr * 136 + 32 * kk + 8 * fq), *(const bf16x8*)(Cs + (16 * wave + fr) * 136 + 32 * kk + 8 * fq), ay, 0, 0, 0);
                const float el = __expf(ACSs[16 * wave + fr]);
#pragma unroll
                for (int e = 0; e < 4; ++e) ay[e] *= el;
                ay = __builtin_amdgcn_mfma_f32_16x16x32_bf16(*(const bf16x8*)(XTs + fr * 72 + 8 * fq), *(const bf16x8*)(Ms + (16 * wave + fr) * 72 + 8 * fq), ay, 0, 0, 0);
                if (wave >= 2) ay = __builtin_amdgcn_mfma_f32_16x16x32_bf16(*(const bf16x8*)(XTs + fr * 72 + 32 + 8 * fq), *(const bf16x8*)(Ms + (16 * wave + fr) * 72 + 32 + 8 * fq), ay, 0, 0, 0);
                const int l = 16 * wave + fr;
#pragma unroll
                for (int e = 0; e < 4; ++e) ay[e] += dsk * bf2f(XTs[(4 * fq + e) * 72 + l]);
                if (!samp || l < SSEQ) { const size_t row = samp ? (size_t)TP + seq * SSEQ + l : (size_t)ch * 64 + l;
                    u32x2 o; o.x = cvtpk(ay[0], ay[1]); o.y = cvtpk(ay[2], ay[3]); *(u32x2*)(yb + row * DM + h * 64 + 16 * pq + 4 * fq) = o; } }
        }
#undef SSD_LOAD
        { float* so = p.out + (samp ? O_SS + (((size_t)(jl * NSB + seq) * 16 + h) * 64 + 16 * pq) * 128 : O_SP + (((size_t)(jl * NB + seq) * 16 + h) * 64 + 16 * pq) * 128);
#pragma unroll
          for (int e = 0; e < 4; ++e) so[(size_t)(4 * fq + e) * 128 + 16 * wave + fr] = accS[e]; }
    }
}

__device__ __forceinline__ void phase_gate(int wv, PR p, int jl) {
    const int tid = tid_of(wv), lane = tid & 63, wave = __builtin_amdgcn_readfirstlane(tid >> 6), gw = bid_here() * 8 + wave, NGW = gridDim.x * 8;
    const bf16* proj = (const bf16*)(p.ws + WS_PROJ); const bf16* yb = (const bf16*)(p.ws + WS_O); bf16* cat = (bf16*)(p.ws + WS_CAT);
    const float* gs = p.in[I_GSSD] + (size_t)jl * 1024;
    float gsv[2][8];
#pragma unroll
    for (int gg = 0; gg < 2; ++gg)
#pragma unroll
        for (int e = 0; e < 8; ++e) gsv[gg][e] = gs[gg * 512 + 8 * lane + e];
    for (int row0 = gw; row0 < TT; row0 += 2 * NGW) {
        int rows[2] = {row0, row0 + NGW}; const bool v1 = rows[1] < TT; if (!v1) rows[1] = row0;
        u32x4 yw[2][2], zw[2][2];
#pragma unroll
        for (int k = 0; k < 2; ++k)
#pragma unroll
            for (int gg = 0; gg < 2; ++gg) { const int c = gg * 512 + 8 * lane; yw[k][gg] = *(const u32x4*)(yb + (size_t)rows[k] * DM + c); zw[k][gg] = *(const u32x4*)(proj + (size_t)rows[k] * EVEN_N + 3072 + c); }
#pragma unroll
        for (int k = 0; k < 2; ++k) { if (k == 1 && !v1) break;
#pragma unroll
            for (int gg = 0; gg < 2; ++gg) { const int c = gg * 512 + 8 * lane; float y[8], z[8]; unpack8(yw[k][gg], y); unpack8(zw[k][gg], z);
                float ss = 0.f;
#pragma unroll
                for (int e = 0; e < 8; ++e) { y[e] *= silu_f(z[e]); ss += y[e] * y[e]; }
                const float r = rsqrtf(wave_sum(ss) * (1.f / 512.f) + EPS);
#pragma unroll
                for (int e = 0; e < 8; ++e) y[e] = y[e] * r * gsv[gg][e];
                *(u32x4*)(cat + (size_t)rows[k] * 2048 + 1024 + c) = pack8f(y); } }
    }
}

template <int PER, bool SAMP> __device__ __forceinline__ void cumsum_item(PR p, int jl, int bh, int tid, int lane, int wave, float* wsum, const float* flog, const float* bfg) {
    constexpr float INV_SCALE = 11.313708498984761f; constexpr int n = SAMP ? PAST + SSEQ : SEQ, tot = SAMP ? SKS : SEQ;
    const int b = bh >> 3, h = bh & 7, e0 = tid * PER; const float bfh = bfg[h];
    float lf[PER]; float sum = 0.f;
#pragma unroll
    for (int i = 0; i < PER; ++i) { const int e = e0 + i; float v = 0.f;
        if (e < n) { if (SAMP) v = (e < PAST) ? p.in[I_CLF][(((size_t)jl * NSB + b) * PAST + e) * 8 + h] : logsigmoid_f(flog[(size_t)(TP + b * SSEQ + e - PAST) * 8 + h] + bfh);
                     else v = logsigmoid_f(flog[(size_t)(b * SEQ + e) * 8 + h] + bfh); }
        if (e < n && (!SAMP || e >= PAST)) p.out[SAMP ? O_LS + ((size_t)jl * TS + b * SSEQ + (e - PAST)) * 8 + h : O_LP + ((size_t)jl * TP + b * SEQ + e) * 8 + h] = v;
        sum += v; lf[i] = sum; }
    float incl = sum;
#pragma unroll
    for (int o = 1; o < 64; o <<= 1) { const float t = __shfl_up(incl, o); if (lane >= o) incl += t; }
    __syncthreads();
    if (lane == 63) wsum[wave] = incl;
    __syncthreads();
    float off = incl - sum;
#pragma unroll
    for (int w8 = 0; w8 < 8; ++w8) off += (w8 < wave) ? wsum[w8] : 0.f;
    float* dst = (float*)(p.ws + (SAMP ? WS_NFS : WS_NFP)) + (size_t)bh * tot;
#pragma unroll
    for (int i = 0; i < PER; ++i) { const int e = e0 + i; if (e < tot) dst[e] = (e < n) ? -(off + lf[i]) * INV_SCALE : 0.f; }
}
__device__ __forceinline__ void phase_qk_cache(int wv, PR p, int jl, int first) {
    const int tid = tid_of(wv), lane = tid & 63, wave = __builtin_amdgcn_readfirstlane(tid >> 6); const int bid = bid_here(); if (bid < first) return;
    const int gw = (bid - first) * 8 + wave, NGW = ((int)gridDim.x - first) * 8;
    bf16* Ks = (bf16*)(p.ws + WS_KS); bf16* Vs = (bf16*)(p.ws + WS_VS);
    { const int NR = 2 * NSB * (PAST + 32), per = (NR + NGW - 1) / NGW, r0 = gw * per, r1 = (r0 + per < NR) ? r0 + per : NR;
      float mx = 0.f; int curb = -1;
      for (int r = r0; r < r1; ++r) { const int which = r / (NSB * (PAST + 32)), rr = r - which * (NSB * (PAST + 32)), b = rr / (PAST + 32), t = rr - b * (PAST + 32);
          if (b != curb) { if (curb >= 0 && (lane & 7) == 0) atomicMax((unsigned*)(p.ws + WS_KMAX) + jl * 128 + curb * 8 + (lane >> 3), __float_as_uint(mx)); mx = 0.f; curb = b; }
          bf16* dst = (which ? Vs : Ks) + ((size_t)b * SKS + (t < PAST ? t : t + 32)) * DM + 16 * lane;
          if (t < PAST) { const float* src = p.in[which ? I_CV : I_CK] + (((size_t)jl * NSB + b) * PAST + t) * DM + 16 * lane; float f[16];
#pragma unroll
              for (int e = 0; e < 16; e += 4) { const f32x4 v = *(const f32x4*)(src + e); f[e] = v.x; f[e + 1] = v.y; f[e + 2] = v.z; f[e + 3] = v.w; }
              if (which == 0) { float ss = 0.f;
#pragma unroll
                  for (int e = 0; e < 16; ++e) ss += f[e] * f[e];
                  ss += __shfl_xor(ss, 1); ss += __shfl_xor(ss, 2); ss += __shfl_xor(ss, 4); mx = fmaxf(mx, ss); }
              *(u32x4*)dst = pack8f(f); *(u32x4*)(dst + 8) = pack8f(f + 8); }
          else { *(u32x4*)dst = (u32x4){0u, 0u, 0u, 0u}; *(u32x4*)(dst + 8) = (u32x4){0u, 0u, 0u, 0u}; } }
      if (curb >= 0 && (lane & 7) == 0) atomicMax((unsigned*)(p.ws + WS_KMAX) + jl * 128 + curb * 8 + (lane >> 3), __float_as_uint(mx)); }
}
__device__ __forceinline__ void phase_qk_cumsum(int wv, PR p, int jl, char* lds) {
    const int tid = tid_of(wv), lane = tid & 63, wave = __builtin_amdgcn_readfirstlane(tid >> 6), gw = bid_here() * 8 + wave, NGW = gridDim.x * 8;
    const float* flog = (const float*)(p.ws + WS_FLOG); const float* bfg = p.in[I_BF] + jl * 8;
    { float* wsum = (float*)lds;
      for (int it = bid_here(); it < NB * 8; it += gridDim.x) cumsum_item<16, false>(p, jl, it, tid, lane, wave, wsum, flog, bfg);
      for (int it = (int)gridDim.x - 1 - bid_here(); it < NSB * 8; it += gridDim.x) cumsum_item<5, true>(p, jl, it, tid, lane, wave, wsum, flog, bfg); }
}

template <class PRT> __device__ __forceinline__ fa::BlockRef attn_ref(PRT p, int id, int jl, float traw_p, float qkb, float knew) {
    const bf16* proj = (const bf16*)(p.ws + WS_PROJ); bf16* yc = (bf16*)(p.ws + WS_CAT);
    fa::BlockRef r;
    if (id < 1024) { const int bh = id >> 5, qb = id & 31, b = bh >> 3, h = bh & 7; const size_t rq = (size_t)b * SEQ + qb * 256;
        r.Q = proj + rq * ODD_N + h * 128; r.K = proj + (size_t)b * SEQ * ODD_N + 1024 + h * 128; r.V = r.K + 1024; r.Bias = (const float*)(p.ws + WS_NFP) + (size_t)bh * SEQ;
        r.O = yc + rq * DM + h * 128; r.Z = proj + rq * ODD_N + 3072 + h * 128; r.P0 = qb * 256; r.qpitch = ODD_N; r.kvpitch = ODD_N; r.nvalid = 256; r.skv = SEQ; r.canskip = 1; r.traw = traw_p; }
    else { const int bh = id - 1024, b = bh >> 3, h = bh & 7; const size_t rq = (size_t)TP + b * SSEQ;
        r.Q = proj + rq * ODD_N + h * 128; r.K = (const bf16*)(p.ws + WS_KS) + (size_t)b * SKS * DM + h * 128; r.V = (const bf16*)(p.ws + WS_VS) + (size_t)b * SKS * DM + h * 128;
        r.Bias = (const float*)(p.ws + WS_NFS) + (size_t)bh * SKS; r.O = yc + rq * DM + h * 128; r.Z = proj + rq * ODD_N + 3072 + h * 128; r.P0 = PAST; r.qpitch = ODD_N; r.kvpitch = DM; r.nvalid = SSEQ; r.skv = SKS; r.canskip = 1;
        { const float kc = sqrtf(__uint_as_float(((const unsigned*)(p.ws + WS_KMAX))[jl * 128 + bh])) * 1.01f; const float kb = fmaxf(kc, knew);
          r.traw = (2.f * (qkb * kb) + 30.f) * 11.313708f; } }
    return r;
}
__device__ __forceinline__ int attn_item(int w, int G, int i) {
    if (G == 256) { if (w < 128) { if (i == 0) return 1024 + w; return i < 5 ? 4 * w + (i - 1) : -1; } return i < 4 ? 512 + 4 * (w - 128) + i : -1; }
    const int id = w + i * G; return id < 1152 ? id : -1;
}
__device__ __forceinline__ void phase_attn(int wv, PR p, int jl, char* lds) {
    const int w = vcu_here(), G = gridDim.x;
    int i = 0, id = attn_item(w, G, 0); if (id < 0) return;
    float traw, qkb, knew;
    { const int lane = tid_of(wv) & 63; const float* gq = p.in[I_GQ] + jl * 128; const float* gk = p.in[I_GK] + jl * 128;
      float mq = fmaxf(fabsf(gq[lane]), fabsf(gq[lane + 64])), mk = fmaxf(fabsf(gk[lane]), fabsf(gk[lane + 64]));
#pragma unroll
      for (int o = 1; o < 64; o <<= 1) { mq = fmaxf(mq, __shfl_xor(mq, o)); mk = fmaxf(mk, __shfl_xor(mk, o)); }
      const float B = 11.313708f * 1.02f * mq * mk; traw = __int_as_float(__builtin_amdgcn_readfirstlane(__float_as_int((2.f * B + 30.f) * 11.313708f)));
      qkb = __int_as_float(__builtin_amdgcn_readfirstlane(__float_as_int(11.313708f * 1.01f * mq * 0.08838834764831845f)));
      knew = __int_as_float(__builtin_amdgcn_readfirstlane(__float_as_int(11.313708f * 1.01f * mk))); }
    fa::Seam S; int jlo;
    { const fa::BlockRef cur = attn_ref<PR>(p, id, jl, traw, qkb, knew); jlo = fa::fox_jlo(cur, tid_of(wv) & 63); fa::fox_prime(cur, lds, S, wv, jlo); }
    for (;;) {
        int idn = attn_item(w, G, i + 1); const bool last = idn < 0; if (last) idn = id;
        int jlon = jlo;
        if (!last) { const fa::BlockRef nx = attn_ref<PR>(p, idn, jl, traw, qkb, knew); jlon = fa::fox_jlo(nx, tid_of(wv) & 63); }
        fa::fox_block<PR>(p, id, jl, idn, jl, lds, S, wv, jlo, jlon, traw, qkb, knew);
        if (last) break;
        id = idn; jlo = jlon; ++i;
    }
}
#define LAS __attribute__((address_space(3)))
#define XB_TMO      128
#define XB_XCNT(j)  (256  + 64 * (j))
#define XB_XSUB(j)  (1280 + 64 * (j))
#define XB_XGEN(j)  (2304 + 64 * (j))
#define XB_TOP      3328
#define XB_TOPGEN   3392
#define XCD_BAR_WORDS 3456
#define XB_SPIN_CAP (1u << 18)

__device__ __forceinline__ unsigned xb_ld(unsigned* p)              { return __hip_atomic_load(p, __ATOMIC_RELAXED, __HIP_MEMORY_SCOPE_AGENT); }
__device__ __forceinline__ unsigned xb_add(unsigned* p, unsigned v) { return __hip_atomic_fetch_add(p, v, __ATOMIC_RELAXED, __HIP_MEMORY_SCOPE_AGENT); }
__device__ __forceinline__ unsigned xb_xcc_id() { return (unsigned)__builtin_amdgcn_s_getreg((3 << 11) | 20) & 0xFu; }
#define XB_SPIN(cond, bar) do { unsigned _sp = 0; while (cond) { __builtin_amdgcn_s_sleep(1); \
    if ((++_sp & 255u) == 0u) { if (xb_ld(&(bar)[XB_TMO])) break; if (_sp > XB_SPIN_CAP) { atomicAdd(&(bar)[XB_TMO], 1u); break; } } } } while (0)

struct XcdBarrier {
    unsigned* bar; unsigned x;
    volatile LAS unsigned* st;
};

__device__ __forceinline__ XcdBarrier xcd_barrier_post(unsigned* bar, volatile LAS unsigned* st, int xb_tid) {
    XcdBarrier b; b.bar = bar; b.x = xb_xcc_id(); b.st = st;
    if (xb_tid == 0) (void)xb_add(&bar[XB_XCNT(b.x)], 1u);
    return b;
}
__device__ __forceinline__ void xcd_barrier_complete(unsigned* bar, unsigned x, unsigned& nloc, unsigned& nx) {
    const unsigned G = gridDim.x * gridDim.y * gridDim.z;
    unsigned sum, cnt, mine, sp = 0u;
    for (;;) {
        sum = 0u; cnt = 0u; mine = 0u;
#pragma unroll
        for (unsigned j = 0; j < 16; ++j) { const unsigned c = xb_ld(&bar[XB_XCNT(j)]); sum += c; cnt += (c > 0u) ? 1u : 0u; mine = (j == x) ? c : mine; }
        if (sum == G) break;
        __builtin_amdgcn_s_sleep(1);
        if ((++sp & 255u) == 0u) { if (xb_ld(&bar[XB_TMO])) break; if (sp > XB_SPIN_CAP) { atomicAdd(&bar[XB_TMO], 1u); break; } }
    }
    nloc = mine > 0u ? mine : 1u; nx = cnt > 0u ? cnt : 1u;
}

__device__ __forceinline__ void xcd_barrier(const XcdBarrier& b, int wv_) {
    const int xb_tid = tid_of(wv_);
    asm volatile("s_waitcnt vmcnt(0)" ::: "memory");
    __syncthreads();
    if (xb_tid == 0) {
        unsigned* bar = b.bar;
        __builtin_amdgcn_s_waitcnt(0);
        unsigned nloc = b.st[0], nx = b.st[1];
        if (nloc == 0u) { xcd_barrier_complete(bar, b.x, nloc, nx); b.st[0] = nloc; b.st[1] = nx; }
        const unsigned old = xb_add(&bar[XB_XSUB(b.x)], 1u);
        const unsigned gen = old / nloc;
        if (old + 1u == (gen + 1u) * nloc) {
            __builtin_amdgcn_fence(__ATOMIC_RELEASE, "agent");
            asm volatile("s_waitcnt vmcnt(0)" ::: "memory");
            const unsigned og = xb_add(&bar[XB_TOP], 1u);
            const unsigned tg = og / nx;
            if (og + 1u == (tg + 1u) * nx) xb_add(&bar[XB_TOPGEN], 1u);
            else XB_SPIN(xb_ld(&bar[XB_TOPGEN]) == tg, bar);
            __builtin_amdgcn_fence(__ATOMIC_ACQUIRE, "agent");
            xb_add(&bar[XB_XGEN(b.x)], 1u);
            asm volatile("s_waitcnt vmcnt(0)" ::: "memory");
        } else {
            XB_SPIN(xb_ld(&bar[XB_XGEN(b.x)]) == gen, bar);
            __builtin_amdgcn_fence(__ATOMIC_ACQUIRE, "agent");
            asm volatile("s_waitcnt vmcnt(0)" ::: "memory");
        }
    }
    __syncthreads();
}
#ifndef PH_MASK
#define PH_MASK 0xFFFF
#endif
#ifndef DUP_MASK
#define DUP_MASK 0
#endif
#define PH(b) for (int rep_ = 0; rep_ < ((DUP_MASK >> (b)) & 1) + 1; ++rep_) if (PH_MASK & (1 << (b)))
#define PHX(b) PH(b)
template <int MODE> __device__ __forceinline__ void run_gemm(int wv, char* lds, PR p, const bf16* A, const bf16* Bt, int N, int K, int jl) {
    pg8::Gemm g{A, Bt, TT, N, K}; pg8::StaticOrder S; S.init(TT, N, (int)gridDim.x, bid_here());
    EpiProj<MODE> E{p.ws, p.out, MODE == 2 ? p.in[I_GQ] + jl * 128 : nullptr, MODE == 2 ? p.in[I_GK] + jl * 128 : nullptr, (float*)(lds + 131072 + 1024), jl};
    pg8::gemm_phase<EpiProj<MODE>, pg8::StaticOrder, true, true>((PG8_LAS unsigned char*)lds, g, S, E, wv);
}

template <int jl> __device__ __forceinline__ void layer_pair(int wv, char* lds, const XcdBarrier& xb) {
        PHX(2) { PR p = *params_here(); run_gemm<1>(wv, lds, p, (const bf16*)(p.ws + WS_H), (const bf16*)(p.ws + WS_WINE) + (size_t)jl * EVEN_NP * 1024, EVEN_NP, 1024, jl); }
        xcd_barrier(xb, wv);
        PHX(3) { PR p = *params_here(); phase_conv(wv, p, jl); }
        PHX(4) { PR p = *params_here(); phase_gmlp(wv, p, jl, lds); }
        xcd_barrier(xb, wv);
        PHX(5) { PR p = *params_here(); phase_scan(wv, p, jl, lds); }
        xcd_barrier(xb, wv);
        PHX(6) { PR p = *params_here(); phase_gate(wv, p, jl); }
        xcd_barrier(xb, wv);
        PHX(7) { PR p = *params_here(); run_gemm<0>(wv, lds, p, (const bf16*)(p.ws + WS_CAT), (const bf16*)(p.ws + WS_WOUTE) + (size_t)jl * 1024 * 2048, 1024, 2048, jl); }
        PHX(14) { PR p = *params_here(); const int G_ = (int)gridDim.x, nu_ = (TT / 256) * 4; phase_qk_cache(wv, p, jl, (nu_ > 2 * G_ && nu_ < 3 * G_) ? nu_ - 2 * G_ : 0); }
        xcd_barrier(xb, wv);
        PHX(8) { PR p = *params_here(); phase_norm(wv, p, 2 * jl + 1); }
        xcd_barrier(xb, wv);
        PHX(9) { PR p = *params_here(); run_gemm<2>(wv, lds, p, (const bf16*)(p.ws + WS_H), (const bf16*)(p.ws + WS_WINO) + (size_t)jl * ODD_NP * 1024, ODD_NP, 1024, jl); }
        xcd_barrier(xb, wv);
        PHX(10) { { PR p = *params_here(); phase_qk_cumsum(wv, p, jl, lds); } }
        xcd_barrier(xb, wv);
        PHX(11) { PR p = *params_here(); phase_attn(wv, p, jl, lds); }
        xcd_barrier(xb, wv);
        PHX(12) { PR p = *params_here(); run_gemm<0>(wv, lds, p, (const bf16*)(p.ws + WS_CAT), (const bf16*)(p.ws + WS_WOUTO) + (size_t)jl * 1024 * 1024, 1024, 1024, jl); }
        xcd_barrier(xb, wv);
        PHX(13) { PR p = *params_here(); phase_norm(wv, p, 2 * jl + 2); }
        xcd_barrier(xb, wv);
}

__global__ void __launch_bounds__(512, 2) hybrid_fwd(Params p_unused) {
    extern __shared__ __attribute__((aligned(16))) unsigned char lds_raw[];
    char* lds = (char*)lds_raw;
    cg::grid_group grid = cg::this_grid();
    const int wv = __builtin_amdgcn_readfirstlane((int)threadIdx.x >> 6);
    volatile LAS unsigned* xst = (volatile LAS unsigned*)((LAS unsigned char*)lds_raw + 131072 + 64);
    if (threadIdx.x < 2) xst[threadIdx.x] = 0u;
    __syncthreads();
    const XcdBarrier xb = xcd_barrier_post((unsigned*)(p_unused.ws + WS_BAR), xst, (int)threadIdx.x);

    PH(0) { PR p = *params_here(); phase_prologue(wv, p, lds); }
    PH(1) { PR p = *params_here(); phase_norm(wv, p, 0); }
    grid.sync();
    layer_pair<0>(wv, lds, xb);
    layer_pair<1>(wv, lds, xb);
}

extern "C" void kernel_launch(void* const* d_in, const int* in_sizes, int n_in, void* d_out, int out_size, void* d_ws, size_t ws_size, hipStream_t stream) {
    static int grid = 0;
    if (grid == 0) {
        if (n_in != 25 || (size_t)out_size != O_END || ws_size < WS_END) {
            fprintf(stderr, "kernel_launch: unexpected shapes: n_in %d out %d (want %zu) ws %zu (need %zu)\n", n_in, out_size, (size_t)O_END, ws_size, (size_t)WS_END);
            grid = -1; return; }
        int dev = 0, cus = 0, per_cu = 0;
        (void)hipGetDevice(&dev);
        (void)hipDeviceGetAttribute(&cus, hipDeviceAttributeMultiprocessorCount, dev);
        if (hipFuncSetAttribute((const void*)hybrid_fwd, hipFuncAttributeMaxDynamicSharedMemorySize, LDS_BYTES) != hipSuccess) fprintf(stderr, "kernel_launch: hipFuncSetAttribute failed\n");
        if (hipOccupancyMaxActiveBlocksPerMultiprocessor(&per_cu, (const void*)hybrid_fwd, 512, LDS_BYTES) != hipSuccess || per_cu < 1) { fprintf(stderr, "kernel_launch: occupancy query gave %d\n", per_cu); per_cu = 1; }
        (void)hipGetLastError();
        if (cus <= 0) cus = 256;
        grid = cus;
    }
    if (grid < 0) return;
    (void)hipMemsetAsync((char*)d_ws + WS_BAR, 0, 65536, stream);
    Params p{};
    for (int i = 0; i < 25; ++i) p.in[i] = (const float*)d_in[i];
    p.out = (float*)d_out; p.ws = (unsigned char*)d_ws;
    void* args[] = {&p};
    hipError_t e = hipLaunchCooperativeKernel((const void*)hybrid_fwd, dim3(grid), dim3(512), args, LDS_BYTES, stream);
    if (e != hipSuccess) fprintf(stderr, "kernel_launch: cooperative launch failed: %s (grid %d)\n", hipGetErrorString(e), grid);
}
```

```cpp
#include <hip/hip_runtime.h>
#include <hip/hip_cooperative_groups.h>
#include <hip/hip_bf16.h>
#include <cstdio>
#include <cstdint>
namespace cg = cooperative_groups;

constexpr int DM = 1024, NB = 4, SEQ = 8192, NSB = 16, SSEQ = 32, PAST = 2048;
constexpr int TP = NB * SEQ, TS = NSB * SSEQ, TT = TP + TS;
constexpr int EVEN_IN = 5648, EVEN_N = 5632, EVEN_NP = 5888;
constexpr int ODD_IN = 4104, ODD_N = 4096, ODD_NP = 4352;
constexpr int CONV_DIM = 1536, SKS = PAST + 64;
constexpr float EPS = 1e-6f;

constexpr size_t O_YP = 0;
constexpr size_t O_YS = O_YP + (size_t)TP * DM;
constexpr size_t O_KP = O_YS + (size_t)TS * DM;
constexpr size_t O_VP = O_KP + (size_t)2 * TP * DM;
constexpr size_t O_LP = O_VP + (size_t)2 * TP * DM;
constexpr size_t O_SP = O_LP + (size_t)2 * TP * 8;
constexpr size_t O_CP = O_SP + (size_t)2 * NB * 16 * 64 * 128;
constexpr size_t O_KS = O_CP + (size_t)2 * NB * 3 * CONV_DIM;
constexpr size_t O_VS = O_KS + (size_t)2 * TS * DM;
constexpr size_t O_LS = O_VS + (size_t)2 * TS * DM;
constexpr size_t O_SS = O_LS + (size_t)2 * TS * 8;
constexpr size_t O_CS = O_SS + (size_t)2 * NSB * 16 * 64 * 128;
constexpr size_t O_GV = O_CS + (size_t)2 * NSB * 3 * CONV_DIM;
constexpr size_t O_END = O_GV + (size_t)2 * TS * DM;

constexpr size_t MiB = 1u << 20;
constexpr size_t WS_WINE = 0, WS_WOUTE = 24 * MiB, WS_WINO = 32 * MiB, WS_WOUTO = 50 * MiB;
constexpr size_t WS_DTRAW = 54 * MiB, WS_FLOG = 57 * MiB, WS_NFP = 59 * MiB, WS_NFS = 60 * MiB;
constexpr size_t WS_BAR = 61 * MiB + 512 * 1024;
constexpr size_t WS_KMAX = WS_BAR + 32768;
constexpr size_t WS_H = 62 * MiB, WS_O = 127 * MiB, WS_CAT = 192 * MiB, WS_ACT = 322 * MiB, WS_Y = 420 * MiB;
constexpr size_t WS_KS = 322 * MiB, WS_VS = 388 * MiB;
constexpr size_t WS_PROJ = 485 * MiB, WS_RES = 843 * MiB, WS_END = 908 * MiB;
static_assert((size_t)2 * EVEN_NP * 1024 * 2 <= 24 * MiB && (size_t)2 * ODD_NP * 1024 * 2 <= 18 * MiB, "weights");
static_assert((size_t)TT * 16 * 4 <= 3 * MiB && (size_t)TT * 8 * 4 <= 2 * MiB && (size_t)128 * SKS * 4 <= 2 * MiB, "small");
static_assert((size_t)TT * 1024 * 2 <= 65 * MiB && (size_t)TT * 1536 * 2 <= 98 * MiB && (size_t)NSB * SKS * 1024 * 2 <= 66 * MiB, "act");
static_assert((size_t)TT * EVEN_N * 2 <= 358 * MiB, "proj");

constexpr int LDS_BYTES = 131072 + 1024 + 8192 + 1024;

typedef unsigned short bf16;
typedef float f32x4 __attribute__((ext_vector_type(4)));
typedef float f32x2 __attribute__((ext_vector_type(2)));
typedef float f32x16 __attribute__((ext_vector_type(16)));
typedef unsigned u32x4 __attribute__((ext_vector_type(4)));
typedef unsigned u32x2 __attribute__((ext_vector_type(2)));
typedef short bf16x8 __attribute__((ext_vector_type(8)));
typedef short s16x4 __attribute__((ext_vector_type(4)));

__device__ __forceinline__ float bf2f(unsigned b) { return __uint_as_float(b << 16); }
__device__ __forceinline__ float bflo(unsigned w) { return __uint_as_float(w << 16); }
__device__ __forceinline__ float bfhi(unsigned w) { return __uint_as_float(w & 0xffff0000u); }
typedef __bf16 bf16x2_t __attribute__((ext_vector_type(2)));
__device__ __forceinline__ unsigned cvtpk(float lo, float hi) { const f32x2 v = {lo, hi}; const bf16x2_t b = __builtin_convertvector(v, bf16x2_t); return __builtin_bit_cast(unsigned, b); }
__device__ __forceinline__ float wave_sum(float v) {
#pragma unroll
    for (int o = 1; o < 64; o <<= 1) v += __shfl_xor(v, o);
    return v;
}
__device__ __forceinline__ float silu_f(float x) { return x * __builtin_amdgcn_rcpf(1.f + __expf(-x)); }
__device__ __forceinline__ float softplus_f(float x) { return x > 20.f ? x : log1pf(__expf(x)); }
__device__ __forceinline__ float logsigmoid_f(float x) { return fminf(x, 0.f) - log1pf(__expf(-fabsf(x))); }
__device__ __forceinline__ void unpack8(u32x4 w, float* f) {
    f[0] = bflo(w.x); f[1] = bfhi(w.x); f[2] = bflo(w.y); f[3] = bfhi(w.y); f[4] = bflo(w.z); f[5] = bfhi(w.z); f[6] = bflo(w.w); f[7] = bfhi(w.w);
}
__device__ __forceinline__ u32x4 pack8f(const float* f) { u32x4 w; w.x = cvtpk(f[0], f[1]); w.y = cvtpk(f[2], f[3]); w.z = cvtpk(f[4], f[5]); w.w = cvtpk(f[6], f[7]); return w; }

__device__ __forceinline__ int tid_of(int wv) { asm volatile("" : "+s"(wv)); int l; asm volatile("v_mbcnt_lo_u32_b32 %0, -1, 0\n\tv_mbcnt_hi_u32_b32 %0, -1, %0" : "=v"(l)); int t = (wv << 6) | l; asm volatile("" : "+v"(t)); return t; }
__device__ __forceinline__ int bid_here() { int b = blockIdx.x; asm volatile("" : "+s"(b)); return b; }
__device__ __forceinline__ int vcu_here() { const int b = bid_here(), G = (int)gridDim.x; return (G % 8 == 0) ? (b % 8) * (G / 8) + b / 8 : b; }
namespace pg8 {
#define PG8_LAS __attribute__((address_space(3)))
typedef unsigned short bf16_t;
typedef short bf16x8 __attribute__((ext_vector_type(8)));
typedef float f32x4 __attribute__((ext_vector_type(4)));
typedef unsigned u32x4 __attribute__((ext_vector_type(4)));
constexpr int BM = 256, BK = 64, HALF = 128, HTB = HALF * BK * 2  , STAGE_BYTES = 8 * HTB, NXCD = 8, WGM = 8;

__host__ __device__ __forceinline__ int lds_byte(int r, int c) { const int st = (r >> 4) * 2 + (c >> 5), rr = r & 15, cc = c & 31, ob = rr * 64 + cc * 2; return st * 1024 + (ob ^ (((ob >> 9) & 1) << 5)); }
__host__ __device__ __forceinline__ void stage_rc(int b, int& R, int& C) { const int st = b / 1024, sb = b % 1024, swz = sb ^ (((sb >> 9) & 1) << 5); R = (st >> 1) * 16 + swz / 64; C = (st & 1) * 32 + (swz % 64) / 2; }
__host__ __device__ __forceinline__ int perm32(int rho) { const int n = rho >> 4, i = rho & 15; return 8 * (i >> 2) + 4 * n + (i & 3); }

struct Unit { int pm, pn; };
struct Gemm { const bf16_t* A; const bf16_t* Bt; int M, N, K; };

struct StaticOrder {
    int nM, nN, nwg, G, c;
    __host__ __device__ void init(int M, int N, int G_, int c_) { nM = M / BM; nN = N / BM; nwg = nM * nN; G = G_; c = c_; }
    __host__ __device__ bool next(int i, Unit& u) const {
        const long L = (long)i * G + c; if (L >= nwg) return false;
        int wgid = (int)L; { const int q = nwg / NXCD, r = nwg % NXCD, xcd = wgid % NXCD, off = wgid / NXCD; wgid = (xcd < r ? xcd * (q + 1) : r * (q + 1) + (xcd - r) * q) + off; }
        const int nig = WGM * nN, gid = wgid / nig, fm = gid * WGM, gsz = (nM - fm) < WGM ? (nM - fm) : WGM;
        u.pm = fm + ((wgid % nig) % gsz); u.pn = (wgid % nig) / gsz; return true;
    }
    __device__ __forceinline__ void a_ready(const Unit&) const {}
    __device__ __forceinline__ void done(const Unit&) const {}
};

__device__ __forceinline__ unsigned cvt_pk_bf16(float lo, float hi) { unsigned r; asm volatile("v_cvt_pk_bf16_f32 %0, %1, %2" : "=v"(r) : "v"(lo), "v"(hi)); return r; }
typedef float f32x2 __attribute__((ext_vector_type(2)));
__device__ __forceinline__ f32x2 gelu_pk(f32x2 v) {
    const f32x2 av = __builtin_elementwise_abs(v), d = av * 0.2316418882f + 1.0f;
    f32x2 t; t.x = __builtin_amdgcn_rcpf(d.x); t.y = __builtin_amdgcn_rcpf(d.y);
    f32x2 q = t * 0.5307027145f + (-0.7265760135f); q = q * t + 0.7107068705f; q = q * t + (-0.142248368f); q = q * t + 0.127414796f; q = q * t;
    const f32x2 s = (v * v) * (-0.72134752044f);
    f32x2 e; e.x = __builtin_amdgcn_exp2f(s.x); e.y = __builtin_amdgcn_exp2f(s.y);
    const f32x2 m = v * (q * e), r = v - m;
    f32x2 o; o.x = v.x < 0.f ? m.x : r.x; o.y = v.y < 0.f ? m.y : r.y; return o;
}
template <class Epi, class Sched, bool ALIGN_EPI = false, bool SP2 = false>
__device__ __forceinline__ void gemm_phase(PG8_LAS unsigned char* lds, const Gemm g, const Sched& S, const Epi& E, const int wv_in) {
    const int tid = tid_of(wv_in), wid = __builtin_amdgcn_readfirstlane(tid >> 6), lane = tid & 63, wr = wid >> 2, wc = wid & 3, fr = lane & 15, fq = lane >> 4;
    const int K = g.K, nt = K / BK;
    unsigned voffA[2], voffB[2];
#pragma unroll
    for (int i = 0; i < 2; ++i) { int R, C; stage_rc(tid * 16 + i * 8192, R, C); const int Rb = Epi::PERM ? ((R & ~31) + perm32(R & 31)) : R;
        voffA[i] = (unsigned)(R * K + C) * 2u; voffB[i] = (unsigned)(Rb * K + C) * 2u; }
    const size_t kstep = (size_t)(BK * 2);
    const size_t hstep = (size_t)HALF * K * 2;
    const size_t tstep = 2 * hstep;
    const unsigned ldsw = (unsigned)wid * 1024u;
    const int aoff = lds_byte(wr * 64 + fr, fq * 8), boff = lds_byte(wc * 32 + fr, fq * 8);
#define PG8_SA(b, h) (((b) * 2 + (h)) * HTB)
#define PG8_SB(b, h) ((4 + (b) * 2 + (h)) * HTB)
#define PG8_STAGE(bufoff, gbase, voff) do { _Pragma("unroll") for (int _i = 0; _i < 2; ++_i) \
        __builtin_amdgcn_global_load_lds((const unsigned*)((const char*)(gbase) + (voff)[_i]), (PG8_LAS unsigned*)(lds + (bufoff) + ldsw + _i * 8192), 16, 0, 0); } while (0)
#define PG8_LDA(dst, b, h) do { _Pragma("unroll") for (int m = 0; m < 4; ++m) _Pragma("unroll") for (int k = 0; k < 2; ++k) dst[m][k] = *(const PG8_LAS bf16x8*)(lds + PG8_SA(b, h) + aoff + m * 2048 + k * 1024); } while (0)
#define PG8_LDB(dst, b, h) do { _Pragma("unroll") for (int n = 0; n < 2; ++n) _Pragma("unroll") for (int k = 0; k < 2; ++k) dst[n][k] = *(const PG8_LAS bf16x8*)(lds + PG8_SB(b, h) + boff + n * 2048 + k * 1024); } while (0)
#define PG8_MMA(ai, bj, At, Bt) do { __builtin_amdgcn_s_setprio(1); _Pragma("unroll") for (int m = 0; m < 4; ++m) _Pragma("unroll") for (int n = 0; n < 2; ++n) _Pragma("unroll") for (int k = 0; k < 2; ++k) \
        acc[ai][bj][m][n] = __builtin_amdgcn_mfma_f32_16x16x32_bf16(Bt[n][k], At[m][k], acc[ai][bj][m][n], 0, 0, 0); __builtin_amdgcn_s_setprio(0); } while (0)
#define PG8_WAIT_V(n) asm volatile("s_waitcnt vmcnt(" #n ")" ::: "memory")
#define PG8_WAIT_L(n) asm volatile("s_waitcnt lgkmcnt(" #n ")" ::: "memory")
#define PG8_BAR __builtin_amdgcn_s_barrier()
#define PG8_SCHED __builtin_amdgcn_sched_barrier(0)
    Unit cur, nxt; int ui = 0;
    if (!S.next(0, cur)) return;
    f32x4 acc[2][2][4][2];
#pragma unroll
    for (int a = 0; a < 2; ++a)
#pragma unroll
        for (int b = 0; b < 2; ++b)
#pragma unroll
            for (int m = 0; m < 4; ++m)
#pragma unroll
                for (int n = 0; n < 2; ++n) acc[a][b][m][n] = (f32x4){0.f, 0.f, 0.f, 0.f};
    bf16x8 At[4][2], B0[2][2], B1[2][2];
    const char* cA = (const char*)g.A + (size_t)cur.pm * tstep; const char* cB = (const char*)g.Bt + (size_t)cur.pn * tstep;
    S.a_ready(cur);
    if constexpr (SP2) {
        PG8_STAGE(PG8_SB(0, 0), cB, voffB); PG8_STAGE(PG8_SB(0, 1), cB + hstep, voffB); PG8_STAGE(PG8_SA(0, 0), cA, voffA); PG8_STAGE(PG8_SA(0, 1), cA + hstep, voffA);
        if (wr == 1) PG8_BAR;
        PG8_WAIT_V(2); PG8_BAR;
        PG8_STAGE(PG8_SB(1, 0), cB + kstep, voffB); PG8_STAGE(PG8_SA(1, 0), cA + kstep, voffA); PG8_STAGE(PG8_SB(1, 1), cB + hstep + kstep, voffB);
        PG8_WAIT_V(6); PG8_BAR;
    } else {
        PG8_STAGE(PG8_SB(0, 0), cB, voffB); PG8_STAGE(PG8_SA(0, 0), cA, voffA); PG8_STAGE(PG8_SB(0, 1), cB + hstep, voffB); PG8_STAGE(PG8_SA(0, 1), cA + hstep, voffA);
        if (wr == 1) PG8_BAR;
        PG8_WAIT_V(4); PG8_BAR;
        PG8_STAGE(PG8_SB(1, 0), cB + kstep, voffB); PG8_STAGE(PG8_SA(1, 0), cA + kstep, voffA); PG8_STAGE(PG8_SB(1, 1), cB + hstep + kstep, voffB);
        PG8_WAIT_V(6); PG8_BAR;
    }
    for (;;) {
        const bool has_next = S.next(ui + 1, nxt);
        const char* nA = has_next ? (const char*)g.A + (size_t)nxt.pm * tstep : cA; const char* nB = has_next ? (const char*)g.Bt + (size_t)nxt.pn * tstep : cB;
        for (int t = 0; t < nt; t += 2) {
            const bool last = (t == nt - 2);
            const char* a1 = cA + (size_t)(t + 1) * kstep;
            const char* a2 = last ? nA : cA + (size_t)(t + 2) * kstep; const char* b2 = last ? nB : cB + (size_t)(t + 2) * kstep;
            const char* a3 = a2 + kstep; const char* b3 = b2 + kstep;
            if (last && has_next) S.a_ready(nxt);
            if constexpr (SP2) {
            PG8_LDB(B0, 0, 0); PG8_LDB(B1, 0, 1); PG8_SCHED; PG8_LDA(At, 0, 0); PG8_STAGE(PG8_SA(1, 1), a1 + hstep, voffA);
            PG8_WAIT_V(8); PG8_WAIT_L(0); PG8_BAR; PG8_MMA(0, 0, At, B0); PG8_MMA(0, 1, At, B1); PG8_BAR; PG8_SCHED;
            PG8_LDA(At, 0, 1); PG8_STAGE(PG8_SB(0, 0), b2, voffB); PG8_STAGE(PG8_SB(0, 1), b2 + hstep, voffB); PG8_STAGE(PG8_SA(0, 0), a2, voffA);
            PG8_WAIT_V(8); PG8_WAIT_L(0); PG8_BAR; PG8_MMA(1, 0, At, B0); PG8_MMA(1, 1, At, B1); PG8_BAR; PG8_SCHED;
            PG8_LDB(B0, 1, 0); PG8_LDB(B1, 1, 1); PG8_SCHED; PG8_LDA(At, 1, 0); PG8_STAGE(PG8_SA(0, 1), a2 + hstep, voffA);
            PG8_WAIT_V(8); PG8_WAIT_L(0); PG8_BAR; PG8_MMA(0, 0, At, B0); PG8_MMA(0, 1, At, B1); PG8_BAR; PG8_SCHED;
            PG8_LDA(At, 1, 1); PG8_STAGE(PG8_SB(1, 0), b3, voffB); PG8_STAGE(PG8_SB(1, 1), b3 + hstep, voffB); PG8_STAGE(PG8_SA(1, 0), a3, voffA);
            PG8_WAIT_V(8); PG8_WAIT_L(0); PG8_BAR; PG8_MMA(1, 0, At, B0); PG8_MMA(1, 1, At, B1); PG8_BAR; PG8_SCHED;
            } else {
            PG8_LDB(B0, 0, 0); PG8_SCHED; PG8_LDA(At, 0, 0); PG8_STAGE(PG8_SA(1, 1), a1 + hstep, voffA);
            PG8_WAIT_L(8); PG8_BAR; PG8_WAIT_L(0); PG8_MMA(0, 0, At, B0); PG8_BAR; PG8_SCHED;
            PG8_LDB(B1, 0, 1); PG8_STAGE(PG8_SB(0, 0), b2, voffB);
            PG8_BAR; PG8_WAIT_L(0); PG8_MMA(0, 1, At, B1); PG8_BAR;
            PG8_LDA(At, 0, 1); PG8_STAGE(PG8_SA(0, 0), a2, voffA);
            PG8_BAR; PG8_WAIT_L(0); PG8_MMA(1, 0, At, B0); PG8_BAR; PG8_SCHED;
            PG8_STAGE(PG8_SB(0, 1), b2 + hstep, voffB);
            PG8_WAIT_V(6); PG8_BAR; PG8_MMA(1, 1, At, B1); PG8_BAR;
            PG8_LDB(B0, 1, 0); PG8_SCHED; PG8_LDA(At, 1, 0); PG8_STAGE(PG8_SA(0, 1), a2 + hstep, voffA);
            PG8_WAIT_L(8); PG8_BAR; PG8_WAIT_L(0); PG8_MMA(0, 0, At, B0); PG8_BAR; PG8_SCHED;
            PG8_LDB(B1, 1, 1); PG8_STAGE(PG8_SB(1, 0), b3, voffB);
            PG8_BAR; PG8_WAIT_L(0); PG8_MMA(0, 1, At, B1); PG8_BAR;
            PG8_LDA(At, 1, 1); PG8_STAGE(PG8_SA(1, 0), a3, voffA);
            PG8_BAR; PG8_WAIT_L(0); PG8_MMA(1, 0, At, B0); PG8_BAR; PG8_SCHED;
            PG8_STAGE(PG8_SB(1, 1), b3 + hstep, voffB);
            PG8_WAIT_V(6); PG8_BAR; PG8_MMA(1, 1, At, B1); PG8_BAR;
            }
        }
        if constexpr (ALIGN_EPI) { if (wr == 0) PG8_BAR; }
        if constexpr (!Epi::AFTER_DRAIN) { E(acc, cur, wr, wc, fr, fq); S.done(cur); }
        if (!has_next) break;
#pragma unroll
        for (int a = 0; a < 2; ++a)
#pragma unroll
            for (int b = 0; b < 2; ++b)
#pragma unroll
                for (int m = 0; m < 4; ++m)
#pragma unroll
                    for (int n = 0; n < 2; ++n) acc[a][b][m][n] = (f32x4){0.f, 0.f, 0.f, 0.f};
        cur = nxt; cA = nA; cB = nB; ++ui;
        if constexpr (ALIGN_EPI) { if (wr == 1) PG8_BAR; }
    }
    PG8_WAIT_V(0);
    if constexpr (!ALIGN_EPI) { if (wr == 0) PG8_BAR; }
    PG8_BAR;
    if constexpr (Epi::AFTER_DRAIN) { E.fused(acc, cur, wr, wc, fr, fq, lds, wid, lane); S.done(cur); }
#undef PG8_SA
#undef PG8_SB
#undef PG8_STAGE
#undef PG8_LDA
#undef PG8_LDB
#undef PG8_MMA
#undef PG8_WAIT_V
#undef PG8_WAIT_L
#undef PG8_BAR
#undef PG8_SCHED
}
}
namespace fa {
constexpr float SCALE = 0.08838834764831845f;
constexpr float THR = 40.f;
constexpr int D = 128, NW = 8, QBLK = 32, KVBLK = 64, QB = NW * QBLK;
constexpr int SHM_V = KVBLK * D * 2, SHM_K = KVBLK * D * 2;
constexpr int OFF_WS = 2 * SHM_V + 2 * SHM_K, OFF_BIAS = OFF_WS + NW * 64 * 4, FA_LDS = OFF_BIAS + 2 * 64 * 4;
#define KSWZ(row, colB) ((row) * 256 + ((colB) ^ (((row) & 7) << 4)))
#define SBAR() __builtin_amdgcn_sched_barrier(0)
__device__ __forceinline__ int v_st(int k, int c) { const int kk = (k & ~0xC) | ((k & 4) << 1) | ((k & 8) >> 1); return ((kk >> 3) * 4 + (c >> 5)) * 512 + ((kk & 7) * 32 + (c & 31)) * 2; }
__device__ __forceinline__ int v_rd_base(int lane) { return ((lane & 3) << 3) | (((lane >> 2) & 3) << 6) | (((lane >> 4) & 1) << 5) | (((lane >> 5) & 1) << 8); }
constexpr int v_rd_off(int d0, int ks, int half) { return d0 * 512 + ks * 4096 + half * 2048; }
__device__ __forceinline__ int crow(int r, int hi) { return (r & 3) + 8 * (r >> 2) + 4 * hi; }
__device__ __forceinline__ bf16x8 load8(const bf16* p) { return *reinterpret_cast<const bf16x8*>(p); }
__device__ __forceinline__ void mask_tile(f32x16& p0, f32x16& p1, int dq) {
    const float NEG = -__builtin_inff();
#pragma unroll
    for (int r = 0; r < 16; ++r) {
        const int c = (r & 3) + 8 * (r >> 2);
        if (dq - c < 0) p0[r] = NEG;
        if (dq - c - 32 < 0) p1[r] = NEG;
    }
}
__device__ __forceinline__ void partialSM(f32x16& p0, f32x16& p1, float& m_reg, float& mn, float& alpha) {
    float pmax = p0[0];
#pragma unroll
    for (int r = 1; r < 16; ++r) pmax = fmaxf(pmax, p0[r]);
#pragma unroll
    for (int r = 0; r < 16; ++r) pmax = fmaxf(pmax, p1[r]);
    { auto rr = __builtin_amdgcn_permlane32_swap(__float_as_uint(pmax), __float_as_uint(pmax), false, false);
      pmax = fmaxf(__uint_as_float(rr[0]), __uint_as_float(rr[1])); }
    constexpr float C2 = 1.4426950408889634f * SCALE;
    if (__builtin_expect(__all((pmax - m_reg) * SCALE <= THR), 1)) { mn = m_reg; alpha = 1.f; }
    else { mn = fmaxf(m_reg, pmax); alpha = __builtin_amdgcn_exp2f((m_reg - mn) * C2); m_reg = mn; }
    const float mnL = -mn * C2;
#pragma unroll
    for (int r = 0; r < 16; ++r) p0[r] = fmaf(p0[r], C2, mnL);
#pragma unroll
    for (int r = 0; r < 16; ++r) p1[r] = fmaf(p1[r], C2, mnL);
#pragma unroll
    for (int r = 0; r < 16; ++r) p0[r] = __builtin_amdgcn_exp2f(p0[r]);
}
__device__ __forceinline__ void finishSM(f32x16& p0, f32x16& p1, float alpha, float& l_reg, bf16x8& pa0, bf16x8& pa1, bf16x8& pa2, bf16x8& pa3) {
#pragma unroll
    for (int r = 0; r < 16; ++r) p1[r] = __builtin_amdgcn_exp2f(p1[r]);
    float ps = 0;
#pragma unroll
    for (int r = 0; r < 16; ++r) ps += p0[r];
#pragma unroll
    for (int r = 0; r < 16; ++r) ps += p1[r];
    { auto rr = __builtin_amdgcn_permlane32_swap(__float_as_uint(ps), __float_as_uint(ps), false, false);
      ps = __uint_as_float(rr[0]) + __uint_as_float(rr[1]); }
    l_reg = l_reg * alpha + ps;
#define PK4(P, B_, OUT) do { unsigned a0 = cvtpk(P[B_+0], P[B_+1]), a1 = cvtpk(P[B_+2], P[B_+3]);                          \
        unsigned b0 = cvtpk(P[B_+4], P[B_+5]), b1 = cvtpk(P[B_+6], P[B_+7]);                                             \
        auto r0 = __builtin_amdgcn_permlane32_swap(a0, b0, false, false); auto r1 = __builtin_amdgcn_permlane32_swap(a1, b1, false, false); \
        u32x4 w = {r0[0], r1[0], r0[1], r1[1]}; OUT = *reinterpret_cast<bf16x8*>(&w); } while (0)
    PK4(p0, 0, pa0); PK4(p0, 8, pa1); PK4(p1, 0, pa2); PK4(p1, 8, pa3);
#undef PK4
}
template <int KB>
__device__ __forceinline__ void qkt(f32x16& p0, f32x16& p1, const char* K_lds, const float* B_lds, int r32, int hi, const bf16x8* qr) {
    { const float* bp = B_lds + KB * 64 + 4 * hi;
      const f32x4 a0 = *(const f32x4*)(bp), a1 = *(const f32x4*)(bp + 8), a2 = *(const f32x4*)(bp + 16), a3 = *(const f32x4*)(bp + 24);
      const f32x4 c0 = *(const f32x4*)(bp + 32), c1 = *(const f32x4*)(bp + 40), c2 = *(const f32x4*)(bp + 48), c3 = *(const f32x4*)(bp + 56);
      p0 = (f32x16){a0[0], a0[1], a0[2], a0[3], a1[0], a1[1], a1[2], a1[3], a2[0], a2[1], a2[2], a2[3], a3[0], a3[1], a3[2], a3[3]};
      p1 = (f32x16){c0[0], c0[1], c0[2], c0[3], c1[0], c1[1], c1[2], c1[3], c2[0], c2[1], c2[2], c2[3], c3[0], c3[1], c3[2], c3[3]}; }
    const char* kb[4];
#pragma unroll
    for (int dd = 0; dd < 4; ++dd) kb[dd] = K_lds + KB * SHM_K + KSWZ(r32, (dd * 16 + hi * 8) * 2);
#pragma unroll
    for (int d0 = 0; d0 < 8; ++d0) { const char* a = kb[d0 & 3] + (d0 >> 2) * 128;
        bf16x8 b0 = *reinterpret_cast<const bf16x8*>(a);
        bf16x8 b1 = *reinterpret_cast<const bf16x8*>(a + 32 * 256);
        p0 = __builtin_amdgcn_mfma_f32_32x32x16_bf16(b0, qr[d0], p0, 0, 0, 0);
        p1 = __builtin_amdgcn_mfma_f32_32x32x16_bf16(b1, qr[d0], p1, 0, 0, 0); }
}
template <int VB>
__device__ __forceinline__ void pv_tile(f32x16* o, int vb0, bf16x8 pa0, bf16x8 pa1, bf16x8 pa2, bf16x8 pa3) {
#define TRRD(dst, off) asm volatile("ds_read_b64_tr_b16 %0, %1 offset:%2" : "=&v"(dst) : "v"(vb0), "i"(off) : "memory")
#define PV_D0(d0) do { s16x4 l0, l1, l2, l3, h0, h1, h2, h3; constexpr int b_ = VB * SHM_V + v_rd_off(d0, 0, 0); \
        TRRD(l0, b_); TRRD(h0, b_ + 2048); TRRD(l1, b_ + 4096); TRRD(h1, b_ + 6144); TRRD(l2, b_ + 8192); TRRD(h2, b_ + 10240); TRRD(l3, b_ + 12288); TRRD(h3, b_ + 14336); \
        asm volatile("s_waitcnt lgkmcnt(0)" ::: "memory"); SBAR();   \
        o[d0] = __builtin_amdgcn_mfma_f32_32x32x16_bf16(pa0, (bf16x8){l0[0], l0[1], l0[2], l0[3], h0[0], h0[1], h0[2], h0[3]}, o[d0], 0, 0, 0);   \
        o[d0] = __builtin_amdgcn_mfma_f32_32x32x16_bf16(pa1, (bf16x8){l1[0], l1[1], l1[2], l1[3], h1[0], h1[1], h1[2], h1[3]}, o[d0], 0, 0, 0);   \
        o[d0] = __builtin_amdgcn_mfma_f32_32x32x16_bf16(pa2, (bf16x8){l2[0], l2[1], l2[2], l2[3], h2[0], h2[1], h2[2], h2[3]}, o[d0], 0, 0, 0);   \
        o[d0] = __builtin_amdgcn_mfma_f32_32x32x16_bf16(pa3, (bf16x8){l3[0], l3[1], l3[2], l3[3], h3[0], h3[1], h3[2], h3[3]}, o[d0], 0, 0, 0); } while (0)
    PV_D0(0); PV_D0(1); PV_D0(2); PV_D0(3);
#undef PV_D0
#undef TRRD
}
struct BlockRef { const bf16* Q; const bf16* K; const bf16* V; const float* Bias; bf16* O; const bf16* Z; int P0, qpitch, kvpitch, nvalid, skv, canskip; float traw; };
__device__ __forceinline__ int fox_jlo(const BlockRef& r, int lane) { const float traw = r.traw;
    if (!r.canskip) return 0;
    const float bi = r.Bias[r.P0]; const int nt = r.P0 / KVBLK; int cnt = 0;
    for (int t0 = 0; t0 < nt; t0 += 64) { const int t = t0 + lane; const bool c = (t < nt) && (bi - r.Bias[(t < nt ? t : 0) * KVBLK + KVBLK - 1] > traw); cnt += __popcll(__ballot(c)); }
    return __builtin_amdgcn_readfirstlane(cnt);
}
}
struct Params;
template <class PRT> __device__ __forceinline__ fa::BlockRef attn_ref(PRT p, int L, int pass, float traw_p, float qkb, float knew);
namespace fa {
struct Seam { bf16x8 qr[8]; bf16x8 st_v0, st_v1, st_k0, st_k1; float st_b; };
#define VMW() asm volatile("s_waitcnt vmcnt(0)" ::: "memory")
#define VMWN(n) asm volatile("s_waitcnt vmcnt(%0)" :: "i"(n) : "memory")
#define SLOAD_H(Kp, Vp, Bp, pitch, k0) do { const unsigned vo_ = (unsigned)(sr * (pitch) + sc) * 2u; \
        const char* kb_ = (const char*)(Kp) + (size_t)(k0) * (size_t)(pitch) * 2; const char* vb_ = (const char*)(Vp) + (size_t)(k0) * (size_t)(pitch) * 2; const size_t r32_ = (size_t)(pitch) * 64; \
        S.st_v0 = *(const bf16x8*)(vb_ + vo_); S.st_v1 = *(const bf16x8*)(vb_ + r32_ + vo_);              \
        S.st_k0 = *(const bf16x8*)(kb_ + vo_); S.st_k1 = *(const bf16x8*)(kb_ + r32_ + vo_); S.st_b = *(const float*)((const char*)((Bp) + (k0)) + (unsigned)((tid & 63) * 4)); } while (0)
#define SWRITE_HK(bf) do { *(bf16x8*)(K_lds + (bf) * SHM_K + kws) = S.st_k0; *(bf16x8*)(K_lds + (bf) * SHM_K + kws + 32 * 256) = S.st_k1; if (tid < 64) B_lds[(bf) * 64 + tid] = S.st_b; } while (0)
#define SWRITE_HV(bf) do { *(bf16x8*)(V_lds + (bf) * SHM_V + vst0) = S.st_v0; *(bf16x8*)(V_lds + (bf) * SHM_V + vst1) = S.st_v1; } while (0)
#define SWRITE_H(bf) do { SWRITE_HV(bf); SWRITE_HK(bf); } while (0)
#define QLOAD(ref) do { const int qrow_ = wid * QBLK + r32; \
        _Pragma("unroll") for (int d0 = 0; d0 < 8; ++d0) S.qr[d0] = load8((ref).Q + (size_t)qrow_ * (ref).qpitch + d0 * 16 + hi * 8); } while (0)
__device__ __forceinline__ void fox_prime(const BlockRef& cur, char* lds, Seam& S, int wv, int jlo) {
    const int tid = tid_of(wv), wid = __builtin_amdgcn_readfirstlane(tid >> 6), lane = tid & 63, r32 = lane & 31, hi = lane >> 5;
    const int sr = tid >> 4, sc = (tid & 15) * 8, kws = KSWZ(sr, sc * 2); char* K_lds = lds + 2 * SHM_V; float* B_lds = (float*)(lds + OFF_BIAS);
    QLOAD(cur);
    SLOAD_H(cur.K, cur.V, cur.Bias, cur.kvpitch, jlo * KVBLK); VMW(); SWRITE_HK(0);
    __syncthreads();
}
template <class PRT> __device__ __forceinline__ void fox_block(PRT p, int L, int pass, int Ln, int passn, char* lds, Seam& S, int wv, int j_lo, int& jlo_next, float traw, float qkb, float knew) {
    const BlockRef cur = attn_ref<PRT>(p, L, pass, traw, qkb, knew);
    const int tid = tid_of(wv), wid = __builtin_amdgcn_readfirstlane(tid >> 6), lane = tid & 63, r32 = lane & 31, hi = lane >> 5;
    int j_hi = (cur.P0 + QB - 1) / KVBLK + 1; if (j_hi > cur.skv / KVBLK) j_hi = cur.skv / KVBLK;
    const int NT = j_hi - j_lo;
    const int qlo = cur.P0 + wid * QBLK, qm = qlo + r32 - 4 * hi;
    char* V_lds = lds; char* K_lds = lds + 2 * SHM_V;
    float* ws = (float*)(lds + OFF_WS) + wid * 64; float* li_l = ws, * al_l = ws + 32; float* B_lds = (float*)(lds + OFF_BIAS);
    float m_reg = -1e30f, l_reg = 0; f32x16 o[4] = {};
    const int sr = tid >> 4, sc = (tid & 15) * 8, vst0 = v_st(sr, sc), vst1 = v_st(32 + sr, sc), kws = KSWZ(sr, sc * 2);
    const int vb0 = (int)(uintptr_t)V_lds + v_rd_base(lane);
    const bf16* Kh = cur.K; const bf16* Vh = cur.V; const float* Bh = cur.Bias; const int kvp = cur.kvpitch;
#define RESC(a) do { if (__any((a) < 1.f)) { if (hi == 0) al_l[r32] = (a); asm volatile("s_waitcnt lgkmcnt(0)" ::: "memory");              \
                     _Pragma("unroll") for (int d_ = 0; d_ < 4; ++d_) _Pragma("unroll") for (int r = 0; r < 16; ++r) o[d_][r] *= al_l[crow(r, hi)]; } } while (0)
#define KBASE(t) ((j_lo + (t)) * KVBLK)
#define MASKT(P0_, P1_, t) do { const int kb_ = KBASE(t); if (kb_ + KVBLK - 1 > qlo) mask_tile(P0_, P1_, qm - kb_); } while (0)
    f32x16 pA0, pA1, pB0, pB1; float mnA, mnB, alA, alB; bf16x8 pa0, pa1, pa2, pa3;
    SWRITE_HV(0); SBAR();
    if (NT > 1) { SLOAD_H(Kh, Vh, Bh, kvp, KBASE(1)); }
    SBAR(); qkt<0>(pA0, pA1, K_lds, B_lds, r32, hi, S.qr);
    MASKT(pA0, pA1, 0); partialSM(pA0, pA1, m_reg, mnA, alA);
    if (NT > 1) { VMW(); SWRITE_H(1); }
    __syncthreads();
#define HALF_STEP(PX0, PX1, mnX, alX, PY0, PY1, alY, t, KB, VB, SB) do {                                                      \
        SBAR(); qkt<KB>(PX0, PX1, K_lds, B_lds, r32, hi, S.qr);                                             \
        finishSM(PY0, PY1, alY, l_reg, pa0, pa1, pa2, pa3); SBAR();                                                           \
        if ((t) + 1 < NT) { SLOAD_H(Kh, Vh, Bh, kvp, KBASE((t) + 1)); SBAR(); }                                               \
        pv_tile<VB>(o, vb0, pa0, pa1, pa2, pa3); MASKT(PX0, PX1, (t)); partialSM(PX0, PX1, m_reg, mnX, alX);                                        \
        __syncthreads();                                                                                                      \
        if ((t) + 1 < NT) { VMW(); SWRITE_H(SB); }                                                                          \
        RESC(alX); __syncthreads(); } while (0)
    for (int t = 1; t + 1 < NT; t += 2) {
        HALF_STEP(pB0, pB1, mnB, alB, pA0, pA1, alA, t, 1, 0, 0);
        HALF_STEP(pA0, pA1, mnA, alA, pB0, pB1, alB, t + 1, 0, 1, 1);
    }
    const bool even = (NT & 1) == 0;
    if (even) { SBAR(); qkt<1>(pB0, pB1, K_lds, B_lds, r32, hi, S.qr); SBAR(); }
    { int Ln_ = __builtin_amdgcn_readfirstlane(Ln), pn_ = __builtin_amdgcn_readfirstlane(passn); asm volatile("" : "+s"(Ln_), "+s"(pn_)); const BlockRef nxt = attn_ref<PRT>(p, Ln_, pn_, traw, qkb, knew);
      const int jn_ = fox_jlo(nxt, lane); jlo_next = jn_;
      SLOAD_H(nxt.K, nxt.V, nxt.Bias, nxt.kvpitch, jn_ * KVBLK); SBAR();
      QLOAD(nxt); }
    SBAR();
    finishSM(pA0, pA1, alA, l_reg, pa0, pa1, pa2, pa3); SBAR();
    pv_tile<0>(o, vb0, pa0, pa1, pa2, pa3);
    if (even) { MASKT(pB0, pB1, NT - 1); partialSM(pB0, pB1, m_reg, mnB, alB); __syncthreads(); RESC(alB);
        finishSM(pB0, pB1, alB, l_reg, pa0, pa1, pa2, pa3); SBAR(); pv_tile<1>(o, vb0, pa0, pa1, pa2, pa3); }
    SBAR(); VMWN(8); SWRITE_HK(0); SBAR();
    if (hi == 0) li_l[r32] = l_reg; asm volatile("s_waitcnt lgkmcnt(0)" ::: "memory");
    float rli[16];
#pragma unroll
    for (int r = 0; r < 16; ++r) rli[r] = __builtin_amdgcn_rcpf(li_l[crow(r, hi)]);
    int Le_ = __builtin_amdgcn_readfirstlane(L), pe_ = __builtin_amdgcn_readfirstlane(pass); asm volatile("" : "+s"(Le_), "+s"(pe_)); const BlockRef ce = attn_ref<PRT>(p, Le_, pe_, traw, qkb, knew);
#pragma unroll
    for (int r = 0; r < 16; ++r) { const int orow = wid * QBLK + crow(r, hi);
#pragma unroll
        for (int d0 = 0; d0 < 4; ++d0) { const float v = o[d0][r] * rli[r];
            const float vn = __shfl_xor(v, 1);
            if ((r32 & 1) == 0 && orow < ce.nvalid) {
                const unsigned zz = *(const unsigned*)(ce.Z + (size_t)orow * ODD_N + d0 * 32 + r32);
                *(unsigned*)(ce.O + (size_t)orow * DM + d0 * 32 + r32) = cvtpk(v * silu_f(bflo(zz)), vn * silu_f(bfhi(zz))); } } }
    __syncthreads();
#undef RESC
#undef KBASE
#undef MASKT
#undef HALF_STEP
}
#undef ROWP
#undef VMW
#undef VMWN
#undef SLOAD_H
#undef SWRITE_HK
#undef SWRITE_HV
#undef SWRITE_H
#undef QLOAD
#undef SBAR
}
struct Params { const float* in[25]; float* out; unsigned char* ws; };
typedef const __attribute__((address_space(4))) Params& PR;
__device__ __forceinline__ const __attribute__((address_space(4))) Params* params_here() { const __attribute__((address_space(4))) Params* q = (const __attribute__((address_space(4))) Params*)__builtin_amdgcn_kernarg_segment_ptr(); asm volatile("" : "+s"(q)); return q; }
enum { I_XP = 0, I_XS, I_CK, I_CV, I_CLF, I_SSD, I_SCONV, I_NPRE, I_NPOST, I_WINE, I_WOUTE, I_GWS, I_GBS, I_GGV, I_CW, I_CB, I_DTB, I_ALOG, I_DSK, I_GSSD, I_WINO, I_BF, I_WOUTO, I_GQ, I_GK };

template <int MODE> struct EpiProj {
    static constexpr bool PERM = true, AFTER_DRAIN = false;
    unsigned char* ws; float* out; const float* gq; const float* gk; float* xl; int jl;
    __device__ __forceinline__ void operator()(const pg8::f32x4 (&acc)[2][2][4][2], const pg8::Unit& u, int wr, int wc, int fr, int fq) const {
        constexpr int ldc = MODE == 0 ? 1024 : (MODE == 1 ? EVEN_N : ODD_N), n_main = ldc / 256, thin_cols = MODE == 1 ? 16 : 8;
        bf16* O = (bf16*)(ws + (MODE == 0 ? WS_O : WS_PROJ));
        const int row0 = u.pm * 256 + wr * 64 + fr;
        if (MODE == 0 || u.pn < n_main) {
            const int col0 = u.pn * 256 + wc * 32 + 8 * fq;
            const bool isv = MODE == 2 && u.pn >= 8 && u.pn < 12, isqk = MODE == 2 && u.pn < 8, isk = isqk && u.pn >= 4;
            float rs[2][2][4];
            pg8::f32x4 g0 = {1.f, 1.f, 1.f, 1.f}, g1 = {1.f, 1.f, 1.f, 1.f};
            if (MODE == 2 && isqk) {
#pragma unroll
                for (int ai = 0; ai < 2; ++ai)
#pragma unroll
                    for (int bj = 0; bj < 2; ++bj)
#pragma unroll
                        for (int m = 0; m < 4; ++m) { const pg8::f32x4 a = acc[ai][bj][m][0], b = acc[ai][bj][m][1];
                            float s = (a[0] * a[0] + a[1] * a[1]) + (a[2] * a[2] + a[3] * a[3]) + (b[0] * b[0] + b[1] * b[1]) + (b[2] * b[2] + b[3] * b[3]);
                            s += __shfl_xor(s, 16); s += __shfl_xor(s, 32);
                            if (fq == 0) xl[((((wr * 4 + wc) * 2 + ai) * 2 + bj) * 4 + m) * 16 + fr] = s; }
                asm volatile("s_waitcnt lgkmcnt(0)" ::: "memory"); __builtin_amdgcn_s_barrier(); asm volatile("" ::: "memory");
#pragma unroll
                for (int ai = 0; ai < 2; ++ai)
#pragma unroll
                    for (int bj = 0; bj < 2; ++bj)
#pragma unroll
                        for (int m = 0; m < 4; ++m) { float t = 0.f;
#pragma unroll
                            for (int w4 = 0; w4 < 4; ++w4) t += xl[((((wr * 4 + w4) * 2 + ai) * 2 + bj) * 4 + m) * 16 + fr];
                            rs[ai][bj][m] = rsqrtf(t * (1.f / 128.f) + EPS); }
                const float* gp = (isk ? gk : gq) + wc * 32 + 8 * fq; g0 = *(const pg8::f32x4*)gp; g1 = *(const pg8::f32x4*)(gp + 4);
            }
#pragma unroll
            for (int ai = 0; ai < 2; ++ai)
#pragma unroll
                for (int m = 0; m < 4; ++m) { const int row = row0 + ai * 128 + m * 16; bf16* rowp = O + (size_t)row * ldc + col0;
#pragma unroll
                    for (int bj = 0; bj < 2; ++bj) { pg8::f32x4 v0 = acc[ai][bj][m][0], v1 = acc[ai][bj][m][1];
                        if (MODE == 2 && isqk) { v0 = v0 * rs[ai][bj][m] * g0; v1 = v1 * rs[ai][bj][m] * g1; }
                        u32x4 w; w.x = cvtpk(v0[0], v0[1]); w.y = cvtpk(v0[2], v0[3]); w.z = cvtpk(v1[0], v1[1]); w.w = cvtpk(v1[2], v1[3]);
                        *(u32x4*)(rowp + bj * 128) = w;
                        if (MODE == 2 && (isv || isk)) { const int vc = col0 - (isv ? 2048 : 1024) + bj * 128; const bool samp = row >= TP;
                            float* vo = out + (isv ? (samp ? O_VS + ((size_t)jl * TS + (row - TP)) * DM : O_VP + ((size_t)jl * TP + row) * DM)
                                                   : (samp ? O_KS + ((size_t)jl * TS + (row - TP)) * DM : O_KP + ((size_t)jl * TP + row) * DM)) + vc;
                            *(pg8::f32x4*)vo = v0; *(pg8::f32x4*)(vo + 4) = v1;
                            if (samp) { const int sr = row - TP; *(u32x4*)((bf16*)(ws + (isv ? WS_VS : WS_KS)) + ((size_t)(sr / SSEQ) * SKS + PAST + (sr % SSEQ)) * DM + vc) = w; } } } }
        } else if (MODE != 0) {
            if (wc == 0 && 8 * fq < thin_cols) { float* thin = (float*)(ws + (MODE == 1 ? WS_DTRAW : WS_FLOG));
#pragma unroll
                for (int ai = 0; ai < 2; ++ai)
#pragma unroll
                    for (int m = 0; m < 4; ++m) { float* tp = thin + (size_t)(row0 + ai * 128 + m * 16) * thin_cols + 8 * fq;
                        *(pg8::f32x4*)tp = acc[ai][0][m][0]; *(pg8::f32x4*)(tp + 4) = acc[ai][0][m][1]; }
            }
        }
    }
};

__device__ __forceinline__ void transpose_item(const float* W, int K, int N, bf16* WT, float* scr, int item, int nblk, int lane) {
    const int kb = item / nblk, nb = item % nblk, k0 = 64 * kb, n0 = 32 * nb;
    const int ncol = n0 + (lane & 31);
#pragma unroll 8
    for (int i = 0; i < 32; ++i) { const int kk = 2 * i + (lane >> 5); scr[kk * 33 + (lane & 31)] = (ncol < N) ? W[(size_t)(k0 + kk) * N + ncol] : 0.f; }
    asm volatile("s_waitcnt lgkmcnt(0)" ::: "memory");
    const int c = lane & 7;
#pragma unroll
    for (int j = 0; j < 4; ++j) { const int n = (lane >> 3) + 8 * j; const float* s = scr + (8 * c) * 33 + n;
        u32x4 o; o.x = cvtpk(s[0 * 33], s[1 * 33]); o.y = cvtpk(s[2 * 33], s[3 * 33]); o.z = cvtpk(s[4 * 33], s[5 * 33]); o.w = cvtpk(s[6 * 33], s[7 * 33]);
        *(u32x4*)(WT + (size_t)(n0 + n) * K + k0 + 8 * c) = o; }
    asm volatile("s_waitcnt lgkmcnt(0)" ::: "memory");
}
__device__ __forceinline__ void phase_prologue(int wv, PR p, char* lds) {
    const int tid = tid_of(wv), lane = tid & 63, wave = __builtin_amdgcn_readfirstlane(tid >> 6), gw = bid_here() * 8 + wave, NGW = gridDim.x * 8;
    float* scr = (float*)(lds + wave * 8704);
    constexpr int I0 = 16 * (EVEN_NP / 32), I1 = 32 * 32, I2 = 16 * (ODD_NP / 32), I3 = 16 * 32;
    constexpr int NIT = 2 * (I0 + I1 + I2 + I3);
    for (int it = gw; it < NIT; it += NGW) {
        int r = it; const int j = r & 1; r >>= 1;
        if (r < I0) { transpose_item(p.in[I_WINE] + (size_t)j * 1024 * EVEN_IN, 1024, EVEN_IN, (bf16*)(p.ws + WS_WINE) + (size_t)j * EVEN_NP * 1024, scr, r, EVEN_NP / 32, lane); continue; } r -= I0;
        if (r < I1) { transpose_item(p.in[I_WOUTE] + (size_t)j * 2048 * 1024, 2048, 1024, (bf16*)(p.ws + WS_WOUTE) + (size_t)j * 1024 * 2048, scr, r, 32, lane); continue; } r -= I1;
        if (r < I2) { transpose_item(p.in[I_WINO] + (size_t)j * 1024 * ODD_IN, 1024, ODD_IN, (bf16*)(p.ws + WS_WINO) + (size_t)j * ODD_NP * 1024, scr, r, ODD_NP / 32, lane); continue; } r -= I2;
        transpose_item(p.in[I_WOUTO] + (size_t)j * 1024 * 1024, 1024, 1024, (bf16*)(p.ws + WS_WOUTO) + (size_t)j * 1024 * 1024, scr, r, 32, lane);
    }
}

__device__ __forceinline__ void phase_norm(int wv, PR p, int li) {
    const int tid = tid_of(wv), lane = tid & 63, wave = __builtin_amdgcn_readfirstlane(tid >> 6), gw = bid_here() * 8 + wave, NGW = gridDim.x * 8;
    bf16* resb = (bf16*)(p.ws + WS_RES); const bf16* ob = (const bf16*)(p.ws + WS_O); bf16* hb = (bf16*)(p.ws + WS_H);
    const float* gpost = p.in[I_NPOST] + (li > 0 ? (li - 1) * DM : 0); const float* gpre = p.in[I_NPRE] + (li < 4 ? li * DM : 0);
    f32x4 gpo[4], gpr[4];
#pragma unroll
    for (int j = 0; j < 4; ++j) { gpo[j] = *(const f32x4*)(gpost + 4 * lane + 256 * j); gpr[j] = *(const f32x4*)(gpre + 4 * lane + 256 * j); }
    for (int row0 = gw; row0 < TT; row0 += 2 * NGW) {
        int rows[2] = {row0, row0 + NGW}; const bool v1 = rows[1] < TT; if (!v1) rows[1] = row0;
        f32x4 x[2][4]; u32x2 ow[2][4];
#pragma unroll
        for (int k = 0; k < 2; ++k) { const int row = rows[k];
            if (li <= 1) { const float* xin = row < TP ? p.in[I_XP] + (size_t)row * DM : p.in[I_XS] + (size_t)(row - TP) * DM;
#pragma unroll
                for (int j = 0; j < 4; ++j) x[k][j] = *(const f32x4*)(xin + 4 * lane + 256 * j); }
            else {
#pragma unroll
                for (int j = 0; j < 4; ++j) { const u32x2 w = *(const u32x2*)(resb + (size_t)row * DM + 4 * lane + 256 * j); x[k][j] = (f32x4){bflo(w.x), bfhi(w.x), bflo(w.y), bfhi(w.y)}; } }
            if (li > 0) {
#pragma unroll
                for (int j = 0; j < 4; ++j) ow[k][j] = *(const u32x2*)(ob + (size_t)row * DM + 4 * lane + 256 * j); } }
#pragma unroll
        for (int k = 0; k < 2; ++k) { const int row = rows[k]; if (k == 1 && !v1) break;
            if (li > 0) {
                f32x4 o[4]; float s = 0.f;
#pragma unroll
                for (int j = 0; j < 4; ++j) { const u32x2 w = ow[k][j];
                    o[j] = (f32x4){bflo(w.x), bfhi(w.x), bflo(w.y), bfhi(w.y)}; s += (o[j].x * o[j].x + o[j].y * o[j].y) + (o[j].z * o[j].z + o[j].w * o[j].w); }
                const float r = rsqrtf(wave_sum(s) * (1.f / DM) + EPS);
#pragma unroll
                for (int j = 0; j < 4; ++j) { x[k][j] = x[k][j] + o[j] * r * gpo[j];
                    if (li == 4) *(f32x4*)(p.out + (size_t)row * DM + 4 * lane + 256 * j) = x[k][j];
                    else { u32x2 w; w.x = cvtpk(x[k][j].x, x[k][j].y); w.y = cvtpk(x[k][j].z, x[k][j].w); *(u32x2*)(resb + (size_t)row * DM + 4 * lane + 256 * j) = w;
                           x[k][j] = (f32x4){bflo(w.x), bfhi(w.x), bflo(w.y), bfhi(w.y)}; } }
            }
            if (li < 4) {
                float s = 0.f;
#pragma unroll
                for (int j = 0; j < 4; ++j) s += (x[k][j].x * x[k][j].x + x[k][j].y * x[k][j].y) + (x[k][j].z * x[k][j].z + x[k][j].w * x[k][j].w);
                const float r = rsqrtf(wave_sum(s) * (1.f / DM) + EPS);
#pragma unroll
                for (int j = 0; j < 4; ++j) { const f32x4 h = x[k][j] * r * gpr[j];
                    u32x2 w; w.x = cvtpk(h.x, h.y); w.y = cvtpk(h.z, h.w); *(u32x2*)(hb + (size_t)row * DM + 4 * lane + 256 * j) = w; }
            }
        }
    }
}

constexpr int NCHP = TP / 64, NCH = NCHP + NSB;
constexpr size_t A_XT = 0, A_B = A_XT + (size_t)NCH * 16 * 64 * 64 * 2, A_C = A_B + (size_t)NCH * 64 * 256 * 2, A_BT = A_C + (size_t)NCH * 64 * 256 * 2;
constexpr size_t A_DT = A_BT + (size_t)NCH * 2 * 128 * 64 * 2, A_ACS = A_DT + (size_t)NCH * 16 * 64 * 4, A_W = A_ACS + (size_t)NCH * 16 * 64 * 4, A_END = A_W + (size_t)NCH * 16 * 64 * 4;
static_assert(A_END <= 163 * MiB, "act layouts");
__device__ __forceinline__ void phase_conv(int wv, PR p, int jl) {
    const int tid = tid_of(wv), lane = tid & 63, wave = __builtin_amdgcn_readfirstlane(tid >> 6);
    const int gtid = bid_here() * 512 + tid, gthreads = gridDim.x * 512;
    const bf16* proj = (const bf16*)(p.ws + WS_PROJ);
    bf16* XT = (bf16*)(p.ws + WS_ACT + A_XT); bf16* Bact = (bf16*)(p.ws + WS_ACT + A_B); bf16* Cact = (bf16*)(p.ws + WS_ACT + A_C); bf16* BT = (bf16*)(p.ws + WS_ACT + A_BT);
    const float* cw = p.in[I_CW] + (size_t)jl * CONV_DIM * 4; const float* cb = p.in[I_CB] + (size_t)jl * CONV_DIM;
    constexpr int NCG = CONV_DIM / 8;
    for (int idx = gtid; idx < NCH * NCG; idx += gthreads) {
        const int ch = idx / NCG, cgp = idx - ch * NCG, c0 = cgp * 8;
        int row0, Lv, b; bool samp, first, lastc;
        if (ch < NCHP) { b = ch >> 7; const int t0 = (ch & 127) * 64; row0 = b * SEQ + t0; Lv = 64; samp = false; first = (t0 == 0); lastc = (t0 + 64 == SEQ); }
        else { b = ch - NCHP; row0 = TP + b * SSEQ; Lv = SSEQ; samp = true; first = true; lastc = true; }
        float w[8][4], bias[8], xm3[8], xm2[8], xm1[8];
#pragma unroll
        for (int e = 0; e < 8; ++e) { const f32x4 t = *(const f32x4*)(cw + (size_t)(c0 + e) * 4); w[e][0] = t.x; w[e][1] = t.y; w[e][2] = t.z; w[e][3] = t.w; bias[e] = cb[c0 + e]; }
        if (first) {
            if (samp) { const float* sc = p.in[I_SCONV] + ((size_t)(jl * NSB + b) * 3) * CONV_DIM + c0;
#pragma unroll
                for (int e = 0; e < 8; ++e) { xm3[e] = sc[e]; xm2[e] = sc[CONV_DIM + e]; xm1[e] = sc[2 * CONV_DIM + e]; } }
            else {
#pragma unroll
                for (int e = 0; e < 8; ++e) { xm3[e] = 0.f; xm2[e] = 0.f; xm1[e] = 0.f; } }
        } else {
            unpack8(*(const u32x4*)(proj + (size_t)(row0 - 3) * EVEN_N + 4096 + c0), xm3);
            unpack8(*(const u32x4*)(proj + (size_t)(row0 - 2) * EVEN_N + 4096 + c0), xm2);
            unpack8(*(const u32x4*)(proj + (size_t)(row0 - 1) * EVEN_N + 4096 + c0), xm1);
        }
        u32x4 nx[8];
#pragma unroll
        for (int t = 0; t < 8; ++t) nx[t] = *(const u32x4*)(proj + (size_t)(row0 + t) * EVEN_N + 4096 + c0);
#pragma unroll 1
        for (int tb = 0; tb < 8; ++tb) {
            float v[8][8];
            if (8 * tb < Lv) {
                u32x4 cur[8];
#pragma unroll
                for (int t = 0; t < 8; ++t) cur[t] = nx[t];
                if (8 * (tb + 1) < Lv) {
#pragma unroll
                    for (int t = 0; t < 8; ++t) nx[t] = *(const u32x4*)(proj + (size_t)(row0 + 8 * (tb + 1) + t) * EVEN_N + 4096 + c0); }
#pragma unroll
                for (int t = 0; t < 8; ++t) { float x[8]; unpack8(cur[t], x);
#pragma unroll
                    for (int e = 0; e < 8; ++e) { const float y = bias[e] + xm3[e] * w[e][0] + xm2[e] * w[e][1] + xm1[e] * w[e][2] + x[e] * w[e][3]; v[t][e] = silu_f(y); xm3[e] = xm2[e]; xm2[e] = xm1[e]; xm1[e] = x[e]; } }
            } else {
#pragma unroll
                for (int t = 0; t < 8; ++t)
#pragma unroll
                    for (int e = 0; e < 8; ++e) v[t][e] = 0.f;
            }
            if (c0 < 1024 || (c0 >= 1024 && c0 < 1280)) {
                bf16* dst = (c0 < 1024) ? XT + ((((size_t)ch * 16 + (c0 >> 6)) * 8 + tb) * 64 + (c0 & 63)) * 8 : BT + ((((size_t)ch * 2 + ((c0 - 1024) >> 7)) * 8 + tb) * 128 + ((c0 - 1024) & 127)) * 8;
#pragma unroll
                for (int e = 0; e < 8; ++e) { u32x4 o; o.x = cvtpk(v[0][e], v[1][e]); o.y = cvtpk(v[2][e], v[3][e]); o.z = cvtpk(v[4][e], v[5][e]); o.w = cvtpk(v[6][e], v[7][e]); *(u32x4*)(dst + (size_t)e * 8) = o; }
            }
            if (c0 >= 1024) {
                bf16* dst = (c0 < 1280 ? Bact + (c0 - 1024) : Cact + (c0 - 1280)) + ((size_t)ch * 64 + 8 * tb) * 256;
#pragma unroll
                for (int t = 0; t < 8; ++t) *(u32x4*)(dst + (size_t)t * 256) = pack8f(v[t]);
            }
        }
        if (lastc) {
            float* co = p.out + (samp ? O_CS + ((size_t)(jl * NSB + b) * 3) * CONV_DIM : O_CP + ((size_t)(jl * NB + b) * 3) * CONV_DIM) + c0;
#pragma unroll
            for (int e = 0; e < 8; ++e) { co[e] = xm3[e]; co[CONV_DIM + e] = xm2[e]; co[2 * CONV_DIM + e] = xm1[e]; }
        }
    }
    { const float* dtraw = (const float*)(p.ws + WS_DTRAW); float* DT = (float*)(p.ws + WS_ACT + A_DT); float* ACS = (float*)(p.ws + WS_ACT + A_ACS); float* WW = (float*)(p.ws + WS_ACT + A_W);
      const int gw = bid_here() * 8 + wave, NGW = gridDim.x * 8;
      for (int it = gw; it < NCH * 16; it += NGW) { const int ch = it >> 4, h = it & 15;
          const int row = (ch < NCHP) ? ch * 64 + lane : TP + (ch - NCHP) * SSEQ + lane; const bool valid = (ch < NCHP) || lane < SSEQ;
          float dt = 0.f; if (valid) dt = softplus_f(dtraw[(size_t)row * 16 + h] + p.in[I_DTB][jl * 16 + h]);
          const float a_h = -__expf(p.in[I_ALOG][jl * 16 + h]);
          float acs = dt * a_h;
#pragma unroll
          for (int o = 1; o < 64; o <<= 1) { const float t = __shfl_up(acs, o); if (lane >= o) acs += t; }
          const float alast = __shfl(acs, 63);
          DT[(size_t)it * 64 + lane] = dt; ACS[(size_t)it * 64 + lane] = acs; WW[(size_t)it * 64 + lane] = dt * __expf(alast - acs); } }
}

constexpr int GM_WSTR = 136;
__device__ __forceinline__ void phase_gmlp(int wv, PR p, int jl, char* lds) {
    const int tid = tid_of(wv), lane = tid & 63, wave = tid >> 6;
    const bf16* proj = (const bf16*)(p.ws + WS_PROJ); bf16* cat = (bf16*)(p.ws + WS_CAT);
    bf16* Wl = (bf16*)lds; bf16* vT = (bf16*)(lds + 128 * GM_WSTR * 2);
    constexpr int NU = (TP / 128 + NSB) * 4;
    for (int u = bid_here(); u < NU; u += gridDim.x) {
        const int g = u & 3, cu = u >> 2;
        int row0, n; bool samp; int sb = 0;
        if (cu < TP / 128) { row0 = cu * 128; n = 128; samp = false; } else { sb = cu - TP / 128; row0 = TP + sb * SSEQ; n = SSEQ; samp = true; }
        __syncthreads();
        { const int j = tid >> 2, q = tid & 3; const bool valid = j < n;
          float v[64]; float ss = 0.f;
          const float* gv = p.in[I_GGV] + (size_t)(jl * 4 + g) * 256;
#pragma unroll
          for (int i = 0; i < 8; ++i) { const int cc = (q + 4 * i) * 8;
              u32x4 w = {0u, 0u, 0u, 0u}; if (valid) w = *(const u32x4*)(proj + (size_t)(row0 + j) * EVEN_N + 1024 + g * 256 + cc);
              float f[8]; unpack8(w, f);
#pragma unroll
              for (int e = 0; e < 8; e += 2) { const f32x2 gg = pg8::gelu_pk((f32x2){f[e], f[e + 1]}); v[i * 8 + e] = gg.x; v[i * 8 + e + 1] = gg.y; ss += gg.x * gg.x + gg.y * gg.y; } }
          ss += __shfl_xor(ss, 1); ss += __shfl_xor(ss, 2);
          const float r = rsqrtf(ss * (1.f / 256.f) + EPS);
#pragma unroll
          for (int i = 0; i < 8; ++i) { const int cc = (q + 4 * i) * 8;
#pragma unroll
              for (int e = 0; e < 8; ++e) v[i * 8 + e] = v[i * 8 + e] * r * gv[cc + e];
              if (samp && valid) { float* go = p.out + O_GV + ((size_t)(jl * NSB + sb) * SSEQ + j) * DM + g * 256 + cc;
                  *(f32x4*)go = (f32x4){v[i * 8], v[i * 8 + 1], v[i * 8 + 2], v[i * 8 + 3]}; *(f32x4*)(go + 4) = (f32x4){v[i * 8 + 4], v[i * 8 + 5], v[i * 8 + 6], v[i * 8 + 7]}; }
#pragma unroll
              for (int e = 0; e < 8; e += 2) { const unsigned pk = cvtpk(v[i * 8 + e], v[i * 8 + e + 1]); vT[(cc + e) * GM_WSTR + j] = (bf16)(pk & 0xffffu); vT[(cc + e + 1) * GM_WSTR + j] = (bf16)(pk >> 16); } }
        }
        { const int i = tid >> 2, jq = tid & 3; const float* wsrc = p.in[I_GWS] + ((size_t)(jl * 4 + g) * 128 + i) * 128 + jq * 32;
#pragma unroll
          for (int c = 0; c < 4; ++c) { float f[8];
              const f32x4 a = *(const f32x4*)(wsrc + c * 8), b = *(const f32x4*)(wsrc + c * 8 + 4);
              f[0] = a.x; f[1] = a.y; f[2] = a.z; f[3] = a.w; f[4] = b.x; f[5] = b.y; f[6] = b.z; f[7] = b.w;
              const int j0 = jq * 32 + c * 8;
              const bool keep = (i < n) && (j0 < n) && ((j0 >> 6) <= (i >> 6));
              if (!keep) {
#pragma unroll
                  for (int e = 0; e < 8; ++e) f[e] = 0.f; }
              *(u32x4*)(Wl + i * GM_WSTR + j0) = pack8f(f); } }
        __syncthreads();
        const int wi = wave >> 2, wj = wave & 3, fr = lane & 15, fq = lane >> 4;
        f32x4 acc[4][4];
#pragma unroll
        for (int a = 0; a < 4; ++a)
#pragma unroll
            for (int b = 0; b < 4; ++b) acc[a][b] = (f32x4){0.f, 0.f, 0.f, 0.f};
        const int nks = (wi == 0) ? 2 : 4;
        for (int ks = 0; ks < nks; ++ks) {
            bf16x8 af[4], bfr[4];
#pragma unroll
            for (int mi = 0; mi < 4; ++mi) af[mi] = *(const bf16x8*)(Wl + (64 * wi + 16 * mi + fr) * GM_WSTR + ks * 32 + fq * 8);
#pragma unroll
            for (int ni = 0; ni < 4; ++ni) bfr[ni] = *(const bf16x8*)(vT + (64 * wj + 16 * ni + fr) * GM_WSTR + ks * 32 + fq * 8);
#pragma unroll
            for (int ni = 0; ni < 4; ++ni)
#pragma unroll
                for (int mi = 0; mi < 4; ++mi) acc[ni][mi] = __builtin_amdgcn_mfma_f32_16x16x32_bf16(bfr[ni], af[mi], acc[ni][mi], 0, 0, 0);
        }
        const float* bs = p.in[I_GBS] + (size_t)(jl * 4 + g) * 128;
#pragma unroll
        for (int mi = 0; mi < 4; ++mi) { const int i = 64 * wi + 16 * mi + fr;
            if (i < n) { const float bsi = bs[i]; const size_t rb = (size_t)(row0 + i) * EVEN_N;
#pragma unroll
                for (int ni = 0; ni < 4; ++ni) { const int col = g * 256 + 64 * wj + 16 * ni + 4 * fq;
                    const u32x2 uu = *(const u32x2*)(proj + rb + col), zz = *(const u32x2*)(proj + rb + 2048 + col);
                    const f32x2 g0 = pg8::gelu_pk((f32x2){bflo(uu.x), bfhi(uu.x)}), g1 = pg8::gelu_pk((f32x2){bflo(uu.y), bfhi(uu.y)});
                    const f32x4 s = acc[ni][mi] + bsi;
                    u32x2 o; o.x = cvtpk(silu_f(bflo(zz.x)) * g0.x * s.x, silu_f(bfhi(zz.x)) * g0.y * s.y); o.y = cvtpk(silu_f(bflo(zz.y)) * g1.x * s.z, silu_f(bfhi(zz.y)) * g1.y * s.w);
                    *(u32x2*)(cat + (size_t)(row0 + i) * 2048 + col) = o; } } }
    }
}

__device__ __forceinline__ void phase_scan(int wv, PR p, int jl, char* lds) {
    const int tid = tid_of(wv), lane = tid & 63, wave = __builtin_amdgcn_readfirstlane(tid >> 6), fr = lane & 15, fq = lane >> 4;
    const bf16* XT = (const bf16*)(p.ws + WS_ACT + A_XT); const bf16* Bact = (const bf16*)(p.ws + WS_ACT + A_B); const bf16* Cact = (const bf16*)(p.ws + WS_ACT + A_C); const bf16* BT = (const bf16*)(p.ws + WS_ACT + A_BT);
    const float* DT = (const float*)(p.ws + WS_ACT + A_DT); const float* ACS = (const float*)(p.ws + WS_ACT + A_ACS); const float* WW = (const float*)(p.ws + WS_ACT + A_W);
    bf16* yb = (bf16*)(p.ws + WS_O);
    bf16* Cs = (bf16*)lds; bf16* Bs = Cs + 64 * 136; bf16* BTs = Bs + 64 * 136; bf16* XTs = BTs + 128 * 72; bf16* Ms = XTs + 16 * 72; bf16* Sb = Ms + 64 * 72;
    float* DTs = (float*)(Sb + 2 * 16 * 136); float* ACSs = DTs + 64; float* Ws = ACSs + 64;
    constexpr int NITEM = NB * 64 + NSB * 64;
    for (int it = vcu_here(); it < NITEM; it += gridDim.x) {
        int seq, h, pq, ch0, nch; bool samp;
        if (it < NB * 64) { seq = it >> 6; h = (it >> 2) & 15; pq = it & 3; ch0 = seq * 128; nch = 128; samp = false; }
        else { const int r = it - NB * 64; seq = r >> 6; h = (r >> 2) & 15; pq = r & 3; ch0 = NCHP + seq; nch = 1; samp = true; }
        const int g = h >> 3; const float dsk = p.in[I_DSK][jl * 16 + h];
        f32x4 accS = {0.f, 0.f, 0.f, 0.f};
        __syncthreads();
        { float* st = nullptr; if (samp) st = (float*)p.in[I_SSD] + (((size_t)(jl * NSB + seq) * 16 + h) * 64 + 16 * pq) * 128;
#pragma unroll
          for (int e = 0; e < 4; ++e) { if (samp) accS[e] = st[(size_t)(4 * fq + e) * 128 + 16 * wave + fr]; Sb[(4 * fq + e) * 136 + 16 * wave + fr] = (bf16)(cvtpk(accS[e], 0.f) & 0xffffu); } }
        u32x4 rC0, rC1, rB0, rB1, rT0, rT1, rX; float rS = 0.f;
#define SSD_LOAD(ch) do { const size_t cb_ = (size_t)(ch) * 64 * 256 + g * 128; \
        rC0 = *(const u32x4*)(Cact + cb_ + (size_t)(tid >> 4) * 256 + (tid & 15) * 8); rC1 = *(const u32x4*)(Cact + cb_ + (size_t)(32 + (tid >> 4)) * 256 + (tid & 15) * 8); \
        rB0 = *(const u32x4*)(Bact + cb_ + (size_t)(tid >> 4) * 256 + (tid & 15) * 8); rB1 = *(const u32x4*)(Bact + cb_ + (size_t)(32 + (tid >> 4)) * 256 + (tid & 15) * 8); \
        const bf16* bt_ = BT + ((size_t)(ch) * 2 + g) * 128 * 64; rT0 = *(const u32x4*)(bt_ + ((size_t)(tid & 7) * 128 + (tid >> 3)) * 8); rT1 = *(const u32x4*)(bt_ + ((size_t)(tid & 7) * 128 + 64 + (tid >> 3)) * 8); \
        if (tid < 128) rX = *(const u32x4*)(XT + ((((size_t)(ch) * 16 + h) * 8 + (tid & 7)) * 64 + 16 * pq + (tid >> 3)) * 8); \
        else if (tid < 320) { const int k_ = (tid - 128) >> 6; const float* src_ = k_ == 0 ? DT : (k_ == 1 ? ACS : WW); rS = src_[((size_t)(ch) * 16 + h) * 64 + (tid & 63)]; } } while (0)
        SSD_LOAD(ch0);
        for (int c = 0; c < nch; ++c) {
            const int ch = ch0 + c;
            __syncthreads();
            *(u32x4*)(Cs + (tid >> 4) * 136 + (tid & 15) * 8) = rC0; *(u32x4*)(Cs + (32 + (tid >> 4)) * 136 + (tid & 15) * 8) = rC1;
            *(u32x4*)(Bs + (tid >> 4) * 136 + (tid & 15) * 8) = rB0; *(u32x4*)(Bs + (32 + (tid >> 4)) * 136 + (tid & 15) * 8) = rB1;
            *(u32x4*)(BTs + (tid >> 3) * 72 + (tid & 7) * 8) = rT0; *(u32x4*)(BTs + (64 + (tid >> 3)) * 72 + (tid & 7) * 8) = rT1;
            if (tid < 128) *(u32x4*)(XTs + (tid >> 3) * 72 + (tid & 7) * 8) = rX;
            else if (tid < 320) DTs[tid - 128] = rS;
            __syncthreads();
            if (c + 1 < nch) SSD_LOAD(ch + 1);
            { const int lt = wave >> 1, sth = wave & 1;
              f32x4 a0 = {0.f, 0.f, 0.f, 0.f}, a1 = {0.f, 0.f, 0.f, 0.f};
              if (2 * sth <= lt) {
#pragma unroll
                  for (int kk = 0; kk < 4; ++kk) { const bf16x8 yf = *(const bf16x8*)(Cs + (16 * lt + fr) * 136 + 32 * kk + 8 * fq);
                      const bf16x8 x0 = *(const bf16x8*)(Bs + (32 * sth + fr) * 136 + 32 * kk + 8 * fq), x1 = *(const bf16x8*)(Bs + (32 * sth + 16 + fr) * 136 + 32 * kk + 8 * fq);
                      a0 = __builtin_amdgcn_mfma_f32_16x16x32_bf16(x0, yf, a0, 0, 0, 0); a1 = __builtin_amdgcn_mfma_f32_16x16x32_bf16(x1, yf, a1, 0, 0, 0); } }
              const int l = 16 * lt + fr; const float al = ACSs[l];
#pragma unroll
              for (int j = 0; j < 2; ++j) { const int s0 = 32 * sth + 16 * j + 4 * fq; const f32x4 as = *(const f32x4*)(ACSs + s0), ds = *(const f32x4*)(DTs + s0); const f32x4 ga = j ? a1 : a0; float m[4];
#pragma unroll
                  for (int e = 0; e < 4; ++e) m[e] = (s0 + e <= l) ? ga[e] * __expf(al - as[e]) * ds[e] : 0.f;
                  u32x2 o; o.x = cvtpk(m[0], m[1]); o.y = cvtpk(m[2], m[3]); *(u32x2*)(Ms + l * 72 + s0) = o; } }
            { const float dec = __expf(ACSs[63]);
#pragma unroll
              for (int e = 0; e < 4; ++e) accS[e] *= dec;
#pragma unroll
              for (int kk = 0; kk < 2; ++kk) { float xf[8]; unpack8(*(const u32x4*)(XTs + fr * 72 + 32 * kk + 8 * fq), xf);
                  const f32x4 w0 = *(const f32x4*)(Ws + 32 * kk + 8 * fq), w1 = *(const f32x4*)(Ws + 32 * kk + 8 * fq + 4);
                  xf[0] *= w0.x; xf[1] *= w0.y; xf[2] *= w0.z; xf[3] *= w0.w; xf[4] *= w1.x; xf[5] *= w1.y; xf[6] *= w1.z; xf[7] *= w1.w;
                  const u32x4 xw = pack8f(xf); const bf16x8 bfrag = *(const bf16x8*)(BTs + (16 * wave + fr) * 72 + 32 * kk + 8 * fq);
                  accS = __builtin_amdgcn_mfma_f32_16x16x32_bf16(*(const bf16x8*)&xw, bfrag, accS, 0, 0, 0); }
              bf16* sbn = Sb + ((c + 1) & 1) * 16 * 136;
#pragma unroll
              for (int e = 0; e < 4; ++e) sbn[(4 * fq + e) * 136 + 16 * wave + fr] = (bf16)(cvtpk(accS[e], 0.f) & 0xffffu); }
            __syncthreads();
            if (wave < 4) { const bf16* sbc = Sb + (c & 1) * 16 * 136; f32x4 ay = {0.f, 0.f, 0.f, 0.f};
#pragma unroll
                for (int kk = 0; kk < 4; ++kk) ay = __builtin_amdgcn_mfma_f32_16x16x32_bf16(*(const bf16x8*)(sbc + fr * 136 + 32 * kk + 8 * fq), *(const bf16x8*)(Cs + (16 * wave + fr) * 136 + 32 * kk + 8 * fq), ay, 0, 0, 0);
                const float el = __expf(ACSs[16 * wave + fr]);
#pragma unroll
                for (int e = 0; e < 4; ++e) ay[e] *= el;
                ay = __builtin_amdgcn_mfma_f32_16x16x32_bf16(*(const bf16x8*)(XTs + fr * 72 + 8 * fq), *(const bf16x8*)(Ms + (16 * wave + fr) * 72 + 8 * fq), ay, 0, 0, 0);
                if (wave >= 2) ay = __builtin_amdgcn_mfma_f32_16x16x32_bf16(*(const bf16x8*)(XTs + fr * 72 + 32 + 8 * fq), *(const bf16x8*)(Ms + (16 * wave + fr) * 72 + 32 + 8 * fq), ay, 0, 0, 0);
                const int l = 16 * wave + fr;
#pragma unroll
                for (int e = 0; e < 4; ++e) ay[e] += dsk * bf2f(XTs[(4 * fq + e) * 72 + l]);
                if (!samp || l < SSEQ) { const size_t row = samp ? (size_t)TP + seq * SSEQ + l : (size_t)ch * 64 + l;
                    u32x2 o; o.x = cvtpk(ay[0], ay[1]); o.y = cvtpk(ay[2], ay[3]); *(u32x2*)(yb + row * DM + h * 64 + 16 * pq + 4 * fq) = o; } }
        }
#undef SSD_LOAD
        { float* so = p.out + (samp ? O_SS + (((size_t)(jl * NSB + seq) * 16 + h) * 64 + 16 * pq) * 128 : O_SP + (((size_t)(jl * NB + seq) * 16 + h) * 64 + 16 * pq) * 128);
#pragma unroll
          for (int e = 0; e < 4; ++e) so[(size_t)(4 * fq + e) * 128 + 16 * wave + fr] = accS[e]; }
    }
}

__device__ __forceinline__ void phase_gate(int wv, PR p, int jl) {
    const int tid = tid_of(wv), lane = tid & 63, wave = __builtin_amdgcn_readfirstlane(tid >> 6), gw = bid_here() * 8 + wave, NGW = gridDim.x * 8;
    const bf16* proj = (const bf16*)(p.ws + WS_PROJ); const bf16* yb = (const bf16*)(p.ws + WS_O); bf16* cat = (bf16*)(p.ws + WS_CAT);
    const float* gs = p.in[I_GSSD] + (size_t)jl * 1024;
    float gsv[2][8];
#pragma unroll
    for (int gg = 0; gg < 2; ++gg)
#pragma unroll
        for (int e = 0; e < 8; ++e) gsv[gg][e] = gs[gg * 512 + 8 * lane + e];
    for (int row0 = gw; row0 < TT; row0 += 2 * NGW) {
        int rows[2] = {row0, row0 + NGW}; const bool v1 = rows[1] < TT; if (!v1) rows[1] = row0;
        u32x4 yw[2][2], zw[2][2];
#pragma unroll
        for (int k = 0; k < 2; ++k)
#pragma unroll
            for (int gg = 0; gg < 2; ++gg) { const int c = gg * 512 + 8 * lane; yw[k][gg] = *(const u32x4*)(yb + (size_t)rows[k] * DM + c); zw[k][gg] = *(const u32x4*)(proj + (size_t)rows[k] * EVEN_N + 3072 + c); }
#pragma unroll
        for (int k = 0; k < 2; ++k) { if (k == 1 && !v1) break;
#pragma unroll
            for (int gg = 0; gg < 2; ++gg) { const int c = gg * 512 + 8 * lane; float y[8], z[8]; unpack8(yw[k][gg], y); unpack8(zw[k][gg], z);
                float ss = 0.f;
#pragma unroll
                for (int e = 0; e < 8; ++e) { y[e] *= silu_f(z[e]); ss += y[e] * y[e]; }
                const float r = rsqrtf(wave_sum(ss) * (1.f / 512.f) + EPS);
#pragma unroll
                for (int e = 0; e < 8; ++e) y[e] = y[e] * r * gsv[gg][e];
                *(u32x4*)(cat + (size_t)rows[k] * 2048 + 1024 + c) = pack8f(y); } }
    }
}

template <int PER, bool SAMP> __device__ __forceinline__ void cumsum_item(PR p, int jl, int bh, int tid, int lane, int wave, float* wsum, const float* flog, const float* bfg) {
    constexpr float INV_SCALE = 11.313708498984761f; constexpr int n = SAMP ? PAST + SSEQ : SEQ, tot = SAMP ? SKS : SEQ;
    const int b = bh >> 3, h = bh & 7, e0 = tid * PER; const float bfh = bfg[h];
    float lf[PER]; float sum = 0.f;
#pragma unroll
    for (int i = 0; i < PER; ++i) { const int e = e0 + i; float v = 0.f;
        if (e < n) { if (SAMP) v = (e < PAST) ? p.in[I_CLF][(((size_t)jl * NSB + b) * PAST + e) * 8 + h] : logsigmoid_f(flog[(size_t)(TP + b * SSEQ + e - PAST) * 8 + h] + bfh);
                     else v = logsigmoid_f(flog[(size_t)(b * SEQ + e) * 8 + h] + bfh); }
        if (e < n && (!SAMP || e >= PAST)) p.out[SAMP ? O_LS + ((size_t)jl * TS + b * SSEQ + (e - PAST)) * 8 + h : O_LP + ((size_t)jl * TP + b * SEQ + e) * 8 + h] = v;
        sum += v; lf[i] = sum; }
    float incl = sum;
#pragma unroll
    for (int o = 1; o < 64; o <<= 1) { const float t = __shfl_up(incl, o); if (lane >= o) incl += t; }
    __syncthreads();
    if (lane == 63) wsum[wave] = incl;
    __syncthreads();
    float off = incl - sum;
#pragma unroll
    for (int w8 = 0; w8 < 8; ++w8) off += (w8 < wave) ? wsum[w8] : 0.f;
    float* dst = (float*)(p.ws + (SAMP ? WS_NFS : WS_NFP)) + (size_t)bh * tot;
#pragma unroll
    for (int i = 0; i < PER; ++i) { const int e = e0 + i; if (e < tot) dst[e] = (e < n) ? -(off + lf[i]) * INV_SCALE : 0.f; }
}
__device__ __forceinline__ void phase_qk_cache(int wv, PR p, int jl, int first) {
    const int tid = tid_of(wv), lane = tid & 63, wave = __builtin_amdgcn_readfirstlane(tid >> 6); const int bid = bid_here(); if (bid < first) return;
    const int gw = (bid - first) * 8 + wave, NGW = ((int)gridDim.x - first) * 8;
    bf16* Ks = (bf16*)(p.ws + WS_KS); bf16* Vs = (bf16*)(p.ws + WS_VS);
    { const int NR = 2 * NSB * (PAST + 32), per = (NR + NGW - 1) / NGW, r0 = gw * per, r1 = (r0 + per < NR) ? r0 + per : NR;
      float mx = 0.f; int curb = -1;
      for (int r = r0; r < r1; ++r) { const int which = r / (NSB * (PAST + 32)), rr = r - which * (NSB * (PAST + 32)), b = rr / (PAST + 32), t = rr - b * (PAST + 32);
          if (b != curb) { if (curb >= 0 && (lane & 7) == 0) atomicMax((unsigned*)(p.ws + WS_KMAX) + jl * 128 + curb * 8 + (lane >> 3), __float_as_uint(mx)); mx = 0.f; curb = b; }
          bf16* dst = (which ? Vs : Ks) + ((size_t)b * SKS + (t < PAST ? t : t + 32)) * DM + 16 * lane;
          if (t < PAST) { const float* src = p.in[which ? I_CV : I_CK] + (((size_t)jl * NSB + b) * PAST + t) * DM + 16 * lane; float f[16];
#pragma unroll
              for (int e = 0; e < 16; e += 4) { const f32x4 v = *(const f32x4*)(src + e); f[e] = v.x; f[e + 1] = v.y; f[e + 2] = v.z; f[e + 3] = v.w; }
              if (which == 0) { float ss = 0.f;
#pragma unroll
                  for (int e = 0; e < 16; ++e) ss += f[e] * f[e];
                  ss += __shfl_xor(ss, 1); ss += __shfl_xor(ss, 2); ss += __shfl_xor(ss, 4); mx = fmaxf(mx, ss); }
              *(u32x4*)dst = pack8f(f); *(u32x4*)(dst + 8) = pack8f(f + 8); }
          else { *(u32x4*)dst = (u32x4){0u, 0u, 0u, 0u}; *(u32x4*)(dst + 8) = (u32x4){0u, 0u, 0u, 0u}; } }
      if (curb >= 0 && (lane & 7) == 0) atomicMax((unsigned*)(p.ws + WS_KMAX) + jl * 128 + curb * 8 + (lane >> 3), __float_as_uint(mx)); }
}
__device__ __forceinline__ void phase_qk_cumsum(int wv, PR p, int jl, char* lds) {
    const int tid = tid_of(wv), lane = tid & 63, wave = __builtin_amdgcn_readfirstlane(tid >> 6), gw = bid_here() * 8 + wave, NGW = gridDim.x * 8;
    const float* flog = (const float*)(p.ws + WS_FLOG); const float* bfg = p.in[I_BF] + jl * 8;
    { float* wsum = (float*)lds;
      for (int it = bid_here(); it < NB * 8; it += gridDim.x) cumsum_item<16, false>(p, jl, it, tid, lane, wave, wsum, flog, bfg);
      for (int it = (int)gridDim.x - 1 - bid_here(); it < NSB * 8; it += gridDim.x) cumsum_item<5, true>(p, jl, it, tid, lane, wave, wsum, flog, bfg); }
}

template <class PRT> __device__ __forceinline__ fa::BlockRef attn_ref(PRT p, int id, int jl, float traw_p, float qkb, float knew) {
    const bf16* proj = (const bf16*)(p.ws + WS_PROJ); bf16* yc = (bf16*)(p.ws + WS_CAT);
    fa::BlockRef r;
    if (id < 1024) { const int bh = id >> 5, qb = id & 31, b = bh >> 3, h = bh & 7; const size_t rq = (size_t)b * SEQ + qb * 256;
        r.Q = proj + rq * ODD_N + h * 128; r.K = proj + (size_t)b * SEQ * ODD_N + 1024 + h * 128; r.V = r.K + 1024; r.Bias = (const float*)(p.ws + WS_NFP) + (size_t)bh * SEQ;
        r.O = yc + rq * DM + h * 128; r.Z = proj + rq * ODD_N + 3072 + h * 128; r.P0 = qb * 256; r.qpitch = ODD_N; r.kvpitch = ODD_N; r.nvalid = 256; r.skv = SEQ; r.canskip = 1; r.traw = traw_p; }
    else { const int bh = id - 1024, b = bh >> 3, h = bh & 7; const size_t rq = (size_t)TP + b * SSEQ;
        r.Q = proj + rq * ODD_N + h * 128; r.K = (const bf16*)(p.ws + WS_KS) + (size_t)b * SKS * DM + h * 128; r.V = (const bf16*)(p.ws + WS_VS) + (size_t)b * SKS * DM + h * 128;
        r.Bias = (const float*)(p.ws + WS_NFS) + (size_t)bh * SKS; r.O = yc + rq * DM + h * 128; r.Z = proj + rq * ODD_N + 3072 + h * 128; r.P0 = PAST; r.qpitch = ODD_N; r.kvpitch = DM; r.nvalid = SSEQ; r.skv = SKS; r.canskip = 1;
        { const float kc = sqrtf(__uint_as_float(((const unsigned*)(p.ws + WS_KMAX))[jl * 128 + bh])) * 1.01f; const float kb = fmaxf(kc, knew);
          r.traw = (2.f * (qkb * kb) + 30.f) * 11.313708f; } }
    return r;
}
__device__ __forceinline__ int attn_item(int w, int G, int i) {
    if (G == 256) { if (w < 128) { if (i == 0) return 1024 + w; return i < 5 ? 4 * w + (i - 1) : -1; } return i < 4 ? 512 + 4 * (w - 128) + i : -1; }
    const int id = w + i * G; return id < 1152 ? id : -1;
}
__device__ __forceinline__ void phase_attn(int wv, PR p, int jl, char* lds) {
    const int w = vcu_here(), G = gridDim.x;
    int i = 0, id = attn_item(w, G, 0); if (id < 0) return;
    float traw, qkb, knew;
    { const int lane = tid_of(wv) & 63; const float* gq = p.in[I_GQ] + jl * 128; const float* gk = p.in[I_GK] + jl * 128;
      float mq = fmaxf(fabsf(gq[lane]), fabsf(gq[lane + 64])), mk = fmaxf(fabsf(gk[lane]), fabsf(gk[lane + 64]));
#pragma unroll
      for (int o = 1; o < 64; o <<= 1) { mq = fmaxf(mq, __shfl_xor(mq, o)); mk = fmaxf(mk, __shfl_xor(mk, o)); }
      const float B = 11.313708f * 1.02f * mq * mk; traw = __int_as_float(__builtin_amdgcn_readfirstlane(__float_as_int((2.f * B + 30.f) * 11.313708f)));
      qkb = __int_as_float(__builtin_amdgcn_readfirstlane(__float_as_int(11.313708f * 1.01f * mq * 0.08838834764831845f)));
      knew = __int_as_float(__builtin_amdgcn_readfirstlane(__float_as_int(11.313708f * 1.01f * mk))); }
    fa::Seam S; int jlo;
    { const fa::BlockRef cur = attn_ref<PR>(p, id, jl, traw, qkb, knew); jlo = fa::fox_jlo(cur, tid_of(wv) & 63); fa::fox_prime(cur, lds, S, wv, jlo); }
    for (;;) {
        int idn = attn_item(w, G, i + 1); const bool last = idn < 0; if (last) idn = id;
        int jlon = 0;
        fa::fox_block<PR>(p, id, jl, idn, jl, lds, S, wv, jlo, jlon, traw, qkb, knew);
        if (last) break;
        id = idn; jlo = jlon; ++i;
    }
}
#define LAS __attribute__((address_space(3)))
#define XB_TMO      128
#define XB_XCNT(j)  (256  + 64 * (j))
#define XB_XSUB(j)  (1280 + 64 * (j))
#define XB_XGEN(j)  (2304 + 64 * (j))
#define XB_TOP      3328
#define XB_TOPGEN   3392
#define XCD_BAR_WORDS 3456
#define XB_SPIN_CAP (1u << 18)

__device__ __forceinline__ unsigned xb_ld(unsigned* p)              { return __hip_atomic_load(p, __ATOMIC_RELAXED, __HIP_MEMORY_SCOPE_AGENT); }
__device__ __forceinline__ unsigned xb_add(unsigned* p, unsigned v) { return __hip_atomic_fetch_add(p, v, __ATOMIC_RELAXED, __HIP_MEMORY_SCOPE_AGENT); }
__device__ __forceinline__ unsigned xb_xcc_id() { return (unsigned)__builtin_amdgcn_s_getreg((3 << 11) | 20) & 0xFu; }
#define XB_SPIN(cond, bar) do { unsigned _sp = 0; while (cond) { __builtin_amdgcn_s_sleep(1); \
    if ((++_sp & 255u) == 0u) { if (xb_ld(&(bar)[XB_TMO])) break; if (_sp > XB_SPIN_CAP) { atomicAdd(&(bar)[XB_TMO], 1u); break; } } } } while (0)

struct XcdBarrier {
    unsigned* bar; unsigned x;
    volatile LAS unsigned* st;
};

__device__ __forceinline__ XcdBarrier xcd_barrier_post(unsigned* bar, volatile LAS unsigned* st, int xb_tid) {
    XcdBarrier b; b.bar = bar; b.x = xb_xcc_id(); b.st = st;
    if (xb_tid == 0) (void)xb_add(&bar[XB_XCNT(b.x)], 1u);
    return b;
}
__device__ __forceinline__ void xcd_barrier_complete(unsigned* bar, unsigned x, unsigned& nloc, unsigned& nx) {
    const unsigned G = gridDim.x * gridDim.y * gridDim.z;
    unsigned sum, cnt, mine, sp = 0u;
    for (;;) {
        sum = 0u; cnt = 0u; mine = 0u;
#pragma unroll
        for (unsigned j = 0; j < 16; ++j) { const unsigned c = xb_ld(&bar[XB_XCNT(j)]); sum += c; cnt += (c > 0u) ? 1u : 0u; mine = (j == x) ? c : mine; }
        if (sum == G) break;
        __builtin_amdgcn_s_sleep(1);
        if ((++sp & 255u) == 0u) { if (xb_ld(&bar[XB_TMO])) break; if (sp > XB_SPIN_CAP) { atomicAdd(&bar[XB_TMO], 1u); break; } }
    }
    nloc = mine > 0u ? mine : 1u; nx = cnt > 0u ? cnt : 1u;
}

__device__ __forceinline__ void xcd_barrier(const XcdBarrier& b, int wv_) {
    const int xb_tid = tid_of(wv_);
    asm volatile("s_waitcnt vmcnt(0)" ::: "memory");
    __syncthreads();
    if (xb_tid == 0) {
        unsigned* bar = b.bar;
        __builtin_amdgcn_s_waitcnt(0);
        unsigned nloc = b.st[0], nx = b.st[1];
        if (nloc == 0u) { xcd_barrier_complete(bar, b.x, nloc, nx); b.st[0] = nloc; b.st[1] = nx; }
        const unsigned old = xb_add(&bar[XB_XSUB(b.x)], 1u);
        const unsigned gen = old / nloc;
        if (old + 1u == (gen + 1u) * nloc) {
            __builtin_amdgcn_fence(__ATOMIC_RELEASE, "agent");
            asm volatile("s_waitcnt vmcnt(0)" ::: "memory");
            const unsigned og = xb_add(&bar[XB_TOP], 1u);
            const unsigned tg = og / nx;
            if (og + 1u == (tg + 1u) * nx) xb_add(&bar[XB_TOPGEN], 1u);
            else XB_SPIN(xb_ld(&bar[XB_TOPGEN]) == tg, bar);
            __builtin_amdgcn_fence(__ATOMIC_ACQUIRE, "agent");
            xb_add(&bar[XB_XGEN(b.x)], 1u);
            asm volatile("s_waitcnt vmcnt(0)" ::: "memory");
        } else {
            XB_SPIN(xb_ld(&bar[XB_XGEN(b.x)]) == gen, bar);
            __builtin_amdgcn_fence(__ATOMIC_ACQUIRE, "agent");
            asm volatile("s_waitcnt vmcnt(0)" ::: "memory");
        }
    }
    __syncthreads();
}
#ifndef PH_MASK
#define PH_MASK 0xFFFF
#endif
#ifndef DUP_MASK
#define DUP_MASK 0
#endif
#define PH(b) for (int rep_ = 0; rep_ < ((DUP_MASK >> (b)) & 1) + 1; ++rep_) if (PH_MASK & (1 << (b)))
#define PHX(b) PH(b)
template <int MODE> __device__ __forceinline__ void run_gemm(int wv, char* lds, PR p, const bf16* A, const bf16* Bt, int N, int K, int jl) {
    pg8::Gemm g{A, Bt, TT, N, K}; pg8::StaticOrder S; S.init(TT, N, (int)gridDim.x, bid_here());
    EpiProj<MODE> E{p.ws, p.out, MODE == 2 ? p.in[I_GQ] + jl * 128 : nullptr, MODE == 2 ? p.in[I_GK] + jl * 128 : nullptr, (float*)(lds + 131072 + 1024), jl};
    pg8::gemm_phase<EpiProj<MODE>, pg8::StaticOrder, true, true>((PG8_LAS unsigned char*)lds, g, S, E, wv);
}

template <int jl> __device__ __forceinline__ void layer_pair(int wv, char* lds, const XcdBarrier& xb) {
        PHX(2) { PR p = *params_here(); run_gemm<1>(wv, lds, p, (const bf16*)(p.ws + WS_H), (const bf16*)(p.ws + WS_WINE) + (size_t)jl * EVEN_NP * 1024, EVEN_NP, 1024, jl); }
        xcd_barrier(xb, wv);
        PHX(3) { PR p = *params_here(); phase_conv(wv, p, jl); }
        PHX(4) { PR p = *params_here(); phase_gmlp(wv, p, jl, lds); }
        xcd_barrier(xb, wv);
        PHX(5) { PR p = *params_here(); phase_scan(wv, p, jl, lds); }
        xcd_barrier(xb, wv);
        PHX(6) { PR p = *params_here(); phase_gate(wv, p, jl); }
        xcd_barrier(xb, wv);
        PHX(7) { PR p = *params_here(); run_gemm<0>(wv, lds, p, (const bf16*)(p.ws + WS_CAT), (const bf16*)(p.ws + WS_WOUTE) + (size_t)jl * 1024 * 2048, 1024, 2048, jl); }
        PHX(14) { PR p = *params_here(); const int G_ = (int)gridDim.x, nu_ = (TT / 256) * 4; phase_qk_cache(wv, p, jl, (nu_ > 2 * G_ && nu_ < 3 * G_) ? nu_ - 2 * G_ : 0); }
        xcd_barrier(xb, wv);
        PHX(8) { PR p = *params_here(); phase_norm(wv, p, 2 * jl + 1); }
        xcd_barrier(xb, wv);
        PHX(9) { PR p = *params_here(); run_gemm<2>(wv, lds, p, (const bf16*)(p.ws + WS_H), (const bf16*)(p.ws + WS_WINO) + (size_t)jl * ODD_NP * 1024, ODD_NP, 1024, jl); }
        xcd_barrier(xb, wv);
        PHX(10) { { PR p = *params_here(); phase_qk_cumsum(wv, p, jl, lds); } }
        xcd_barrier(xb, wv);
        PHX(11) { PR p = *params_here(); phase_attn(wv, p, jl, lds); }
        xcd_barrier(xb, wv);
        PHX(12) { PR p = *params_here(); run_gemm<0>(wv, lds, p, (const bf16*)(p.ws + WS_CAT), (const bf16*)(p.ws + WS_WOUTO) + (size_t)jl * 1024 * 1024, 1024, 1024, jl); }
        xcd_barrier(xb, wv);
        PHX(13) { PR p = *params_here(); phase_norm(wv, p, 2 * jl + 2); }
        if (jl == 0) xcd_barrier(xb, wv);
}

__global__ void __launch_bounds__(512, 2) hybrid_fwd(Params p_unused) {
    extern __shared__ __attribute__((aligned(16))) unsigned char lds_raw[];
    char* lds = (char*)lds_raw;
    cg::grid_group grid = cg::this_grid();
    const int wv = __builtin_amdgcn_readfirstlane((int)threadIdx.x >> 6);
    volatile LAS unsigned* xst = (volatile LAS unsigned*)((LAS unsigned char*)lds_raw + 131072 + 64);
    if (threadIdx.x < 2) xst[threadIdx.x] = 0u;
    __syncthreads();
    const XcdBarrier xb = xcd_barrier_post((unsigned*)(p_unused.ws + WS_BAR), xst, (int)threadIdx.x);

    PH(0) { PR p = *params_here(); phase_prologue(wv, p, lds); }
    PH(1) { PR p = *params_here(); phase_norm(wv, p, 0); }
    grid.sync();
    layer_pair<0>(wv, lds, xb);
    layer_pair<1>(wv, lds, xb);
}

extern "C" void kernel_launch(void* const* d_in, const int* in_sizes, int n_in, void* d_out, int out_size, void* d_ws, size_t ws_size, hipStream_t stream) {
    static int grid = 0;
    if (grid == 0) {
        if (n_in != 25 || (size_t)out_size != O_END || ws_size < WS_END) {
            fprintf(stderr, "kernel_launch: unexpected shapes: n_in %d out %d (want %zu) ws %zu (need %zu)\n", n_in, out_size, (size_t)O_END, ws_size, (size_t)WS_END);
            grid = -1; return; }
        int dev = 0, cus = 0, per_cu = 0;
        (void)hipGetDevice(&dev);
        (void)hipDeviceGetAttribute(&cus, hipDeviceAttributeMultiprocessorCount, dev);
        if (hipFuncSetAttribute((const void*)hybrid_fwd, hipFuncAttributeMaxDynamicSharedMemorySize, LDS_BYTES) != hipSuccess) fprintf(stderr, "kernel_launch: hipFuncSetAttribute failed\n");
        if (hipOccupancyMaxActiveBlocksPerMultiprocessor(&per_cu, (const void*)hybrid_fwd, 512, LDS_BYTES) != hipSuccess || per_cu < 1) { fprintf(stderr, "kernel_launch: occupancy query gave %d\n", per_cu); per_cu = 1; }
        (void)hipGetLastError();
        if (cus <= 0) cus = 256;
        grid = cus;
    }
    if (grid < 0) return;
    (void)hipMemsetAsync((char*)d_ws + WS_BAR, 0, 65536, stream);
    Params p{};
    for (int i = 0; i < 25; ++i) p.in[i] = (const float*)d_in[i];
    p.out = (float*)d_out; p.ws = (unsigned char*)d_ws;
    void* args[] = {&p};
    hipError_t e = hipLaunchCooperativeKernel((const void*)hybrid_fwd, dim3(grid), dim3(512), args, LDS_BYTES, stream);
    if (e != hipSuccess) fprintf(stderr, "kernel_launch: cooperative launch failed: %s (grid %d)\n", hipGetErrorString(e), grid);
}
```

```cpp
#include <hip/hip_runtime.h>
#include <hip/hip_cooperative_groups.h>
#include <hip/hip_bf16.h>
#include <cstdio>
#include <cstdint>
namespace cg = cooperative_groups;

constexpr int DM = 1024, NB = 4, SEQ = 8192, NSB = 16, SSEQ = 32, PAST = 2048;
constexpr int TP = NB * SEQ, TS = NSB * SSEQ, TT = TP + TS;
constexpr int EVEN_IN = 5648, EVEN_N = 5632, EVEN_NP = 5888;
constexpr int ODD_IN = 4104, ODD_N = 4096, ODD_NP = 4352;
constexpr int CONV_DIM = 1536, SKS = PAST + 64;
constexpr float EPS = 1e-6f;

constexpr size_t O_YP = 0;
constexpr size_t O_YS = O_YP + (size_t)TP * DM;
constexpr size_t O_KP = O_YS + (size_t)TS * DM;
constexpr size_t O_VP = O_KP + (size_t)2 * TP * DM;
constexpr size_t O_LP = O_VP + (size_t)2 * TP * DM;
constexpr size_t O_SP = O_LP + (size_t)2 * TP * 8;
constexpr size_t O_CP = O_SP + (size_t)2 * NB * 16 * 64 * 128;
constexpr size_t O_KS = O_CP + (size_t)2 * NB * 3 * CONV_DIM;
constexpr size_t O_VS = O_KS + (size_t)2 * TS * DM;
constexpr size_t O_LS = O_VS + (size_t)2 * TS * DM;
constexpr size_t O_SS = O_LS + (size_t)2 * TS * 8;
constexpr size_t O_CS = O_SS + (size_t)2 * NSB * 16 * 64 * 128;
constexpr size_t O_GV = O_CS + (size_t)2 * NSB * 3 * CONV_DIM;
constexpr size_t O_END = O_GV + (size_t)2 * TS * DM;

constexpr size_t MiB = 1u << 20;
constexpr size_t WS_WINE = 0, WS_WOUTE = 24 * MiB, WS_WINO = 32 * MiB, WS_WOUTO = 50 * MiB;
constexpr size_t WS_DTRAW = 54 * MiB, WS_FLOG = 57 * MiB, WS_NFP = 59 * MiB, WS_NFS = 60 * MiB;
constexpr size_t WS_BAR = 61 * MiB + 512 * 1024;
constexpr size_t WS_KMAX = WS_BAR + 32768;
constexpr size_t WS_H = 62 * MiB, WS_O = 127 * MiB, WS_CAT = 192 * MiB, WS_ACT = 322 * MiB, WS_Y = 420 * MiB;
constexpr size_t WS_KS = 322 * MiB, WS_VS = 388 * MiB;
constexpr size_t WS_PROJ = 485 * MiB, WS_RES = 843 * MiB, WS_END = 908 * MiB;
static_assert((size_t)2 * EVEN_NP * 1024 * 2 <= 24 * MiB && (size_t)2 * ODD_NP * 1024 * 2 <= 18 * MiB, "weights");
static_assert((size_t)TT * 16 * 4 <= 3 * MiB && (size_t)TT * 8 * 4 <= 2 * MiB && (size_t)128 * SKS * 4 <= 2 * MiB, "small");
static_assert((size_t)TT * 1024 * 2 <= 65 * MiB && (size_t)TT * 1536 * 2 <= 98 * MiB && (size_t)NSB * SKS * 1024 * 2 <= 66 * MiB, "act");
static_assert((size_t)TT * EVEN_N * 2 <= 358 * MiB, "proj");

constexpr int LDS_BYTES = 131072 + 1024 + 8192 + 1024;

typedef unsigned short bf16;
typedef float f32x4 __attribute__((ext_vector_type(4)));
typedef float f32x2 __attribute__((ext_vector_type(2)));
typedef float f32x16 __attribute__((ext_vector_type(16)));
typedef unsigned u32x4 __attribute__((ext_vector_type(4)));
typedef unsigned u32x2 __attribute__((ext_vector_type(2)));
typedef short bf16x8 __attribute__((ext_vector_type(8)));
typedef short s16x4 __attribute__((ext_vector_type(4)));

__device__ __forceinline__ float bf2f(unsigned b) { return __uint_as_float(b << 16); }
__device__ __forceinline__ float bflo(unsigned w) { return __uint_as_float(w << 16); }
__device__ __forceinline__ float bfhi(unsigned w) { return __uint_as_float(w & 0xffff0000u); }
typedef __bf16 bf16x2_t __attribute__((ext_vector_type(2)));
__device__ __forceinline__ unsigned cvtpk(float lo, float hi) { const f32x2 v = {lo, hi}; const bf16x2_t b = __builtin_convertvector(v, bf16x2_t); return __builtin_bit_cast(unsigned, b); }
__device__ __forceinline__ float wave_sum(float v) {
#pragma unroll
    for (int o = 1; o < 64; o <<= 1) v += __shfl_xor(v, o);
    return v;
}
__device__ __forceinline__ float silu_f(float x) { return x * __builtin_amdgcn_rcpf(1.f + __expf(-x)); }
__device__ __forceinline__ float softplus_f(float x) { return x > 20.f ? x : log1pf(__expf(x)); }
__device__ __forceinline__ float logsigmoid_f(float x) { return fminf(x, 0.f) - log1pf(__expf(-fabsf(x))); }
__device__ __forceinline__ void unpack8(u32x4 w, float* f) {
    f[0] = bflo(w.x); f[1] = bfhi(w.x); f[2] = bflo(w.y); f[3] = bfhi(w.y); f[4] = bflo(w.z); f[5] = bfhi(w.z); f[6] = bflo(w.w); f[7] = bfhi(w.w);
}
__device__ __forceinline__ u32x4 pack8f(const float* f) { u32x4 w; w.x = cvtpk(f[0], f[1]); w.y = cvtpk(f[2], f[3]); w.z = cvtpk(f[4], f[5]); w.w = cvtpk(f[6], f[7]); return w; }

__device__ __forceinline__ int tid_of(int wv) { asm volatile("" : "+s"(wv)); int l; asm volatile("v_mbcnt_lo_u32_b32 %0, -1, 0\n\tv_mbcnt_hi_u32_b32 %0, -1, %0" : "=v"(l)); int t = (wv << 6) | l; asm volatile("" : "+v"(t)); return t; }
__device__ __forceinline__ int bid_here() { int b = blockIdx.x; asm volatile("" : "+s"(b)); return b; }
__device__ __forceinline__ int vcu_here() { const int b = bid_here(), G = (int)gridDim.x; return (G % 8 == 0) ? (b % 8) * (G / 8) + b / 8 : b; }
namespace pg8 {
#define PG8_LAS __attribute__((address_space(3)))
typedef unsigned short bf16_t;
typedef short bf16x8 __attribute__((ext_vector_type(8)));
typedef float f32x4 __attribute__((ext_vector_type(4)));
typedef unsigned u32x4 __attribute__((ext_vector_type(4)));
constexpr int BM = 256, BK = 64, HALF = 128, HTB = HALF * BK * 2  , STAGE_BYTES = 8 * HTB, NXCD = 8, WGM = 8;

__host__ __device__ __forceinline__ int lds_byte(int r, int c) { const int st = (r >> 4) * 2 + (c >> 5), rr = r & 15, cc = c & 31, ob = rr * 64 + cc * 2; return st * 1024 + (ob ^ (((ob >> 9) & 1) << 5)); }
__host__ __device__ __forceinline__ void stage_rc(int b, int& R, int& C) { const int st = b / 1024, sb = b % 1024, swz = sb ^ (((sb >> 9) & 1) << 5); R = (st >> 1) * 16 + swz / 64; C = (st & 1) * 32 + (swz % 64) / 2; }
__host__ __device__ __forceinline__ int perm32(int rho) { const int n = rho >> 4, i = rho & 15; return 8 * (i >> 2) + 4 * n + (i & 3); }

struct Unit { int pm, pn; };
struct Gemm { const bf16_t* A; const bf16_t* Bt; int M, N, K; };

struct StaticOrder {
    int nM, nN, nwg, G, c;
    __host__ __device__ void init(int M, int N, int G_, int c_) { nM = M / BM; nN = N / BM; nwg = nM * nN; G = G_; c = c_; }
    __host__ __device__ bool next(int i, Unit& u) const {
        const long L = (long)i * G + c; if (L >= nwg) return false;
        int wgid = (int)L; { const int q = nwg / NXCD, r = nwg % NXCD, xcd = wgid % NXCD, off = wgid / NXCD; wgid = (xcd < r ? xcd * (q + 1) : r * (q + 1) + (xcd - r) * q) + off; }
        const int nig = WGM * nN, gid = wgid / nig, fm = gid * WGM, gsz = (nM - fm) < WGM ? (nM - fm) : WGM;
        u.pm = fm + ((wgid % nig) % gsz); u.pn = (wgid % nig) / gsz; return true;
    }
    __device__ __forceinline__ void a_ready(const Unit&) const {}
    __device__ __forceinline__ void done(const Unit&) const {}
};

__device__ __forceinline__ unsigned cvt_pk_bf16(float lo, float hi) { unsigned r; asm volatile("v_cvt_pk_bf16_f32 %0, %1, %2" : "=v"(r) : "v"(lo), "v"(hi)); return r; }
typedef float f32x2 __attribute__((ext_vector_type(2)));
__device__ __forceinline__ f32x2 gelu_pk(f32x2 v) {
    const f32x2 av = __builtin_elementwise_abs(v), d = av * 0.2316418882f + 1.0f;
    f32x2 t; t.x = __builtin_amdgcn_rcpf(d.x); t.y = __builtin_amdgcn_rcpf(d.y);
    f32x2 q = t * 0.5307027145f + (-0.7265760135f); q = q * t + 0.7107068705f; q = q * t + (-0.142248368f); q = q * t + 0.127414796f; q = q * t;
    const f32x2 s = (v * v) * (-0.72134752044f);
    f32x2 e; e.x = __builtin_amdgcn_exp2f(s.x); e.y = __builtin_amdgcn_exp2f(s.y);
    const f32x2 m = v * (q * e), r = v - m;
    f32x2 o; o.x = v.x < 0.f ? m.x : r.x; o.y = v.y < 0.f ? m.y : r.y; return o;
}
template <class Epi, class Sched, bool ALIGN_EPI = false, bool SP2 = false>
__device__ __forceinline__ void gemm_phase(PG8_LAS unsigned char* lds, const Gemm g, const Sched& S, const Epi& E, const int wv_in) {
    const int tid = tid_of(wv_in), wid = __builtin_amdgcn_readfirstlane(tid >> 6), lane = tid & 63, wr = wid >> 2, wc = wid & 3, fr = lane & 15, fq = lane >> 4;
    const int K = g.K, nt = K / BK;
    unsigned voffA[2], voffB[2];
#pragma unroll
    for (int i = 0; i < 2; ++i) { int R, C; stage_rc(tid * 16 + i * 8192, R, C); const int Rb = Epi::PERM ? ((R & ~31) + perm32(R & 31)) : R;
        voffA[i] = (unsigned)(R * K + C) * 2u; voffB[i] = (unsigned)(Rb * K + C) * 2u; }
    const size_t kstep = (size_t)(BK * 2);
    const size_t hstep = (size_t)HALF * K * 2;
    const size_t tstep = 2 * hstep;
    const unsigned ldsw = (unsigned)wid * 1024u;
    const int aoff = lds_byte(wr * 64 + fr, fq * 8), boff = lds_byte(wc * 32 + fr, fq * 8);
#define PG8_SA(b, h) (((b) * 2 + (h)) * HTB)
#define PG8_SB(b, h) ((4 + (b) * 2 + (h)) * HTB)
#define PG8_STAGE(bufoff, gbase, voff) do { _Pragma("unroll") for (int _i = 0; _i < 2; ++_i) \
        __builtin_amdgcn_global_load_lds((const unsigned*)((const char*)(gbase) + (voff)[_i]), (PG8_LAS unsigned*)(lds + (bufoff) + ldsw + _i * 8192), 16, 0, 0); } while (0)
#define PG8_LDA(dst, b, h) do { _Pragma("unroll") for (int m = 0; m < 4; ++m) _Pragma("unroll") for (int k = 0; k < 2; ++k) dst[m][k] = *(const PG8_LAS bf16x8*)(lds + PG8_SA(b, h) + aoff + m * 2048 + k * 1024); } while (0)
#define PG8_LDB(dst, b, h) do { _Pragma("unroll") for (int n = 0; n < 2; ++n) _Pragma("unroll") for (int k = 0; k < 2; ++k) dst[n][k] = *(const PG8_LAS bf16x8*)(lds + PG8_SB(b, h) + boff + n * 2048 + k * 1024); } while (0)
#define PG8_MMA(ai, bj, At, Bt) do { __builtin_amdgcn_s_setprio(1); _Pragma("unroll") for (int m = 0; m < 4; ++m) _Pragma("unroll") for (int n = 0; n < 2; ++n) _Pragma("unroll") for (int k = 0; k < 2; ++k) \
        acc[ai][bj][m][n] = __builtin_amdgcn_mfma_f32_16x16x32_bf16(Bt[n][k], At[m][k], acc[ai][bj][m][n], 0, 0, 0); __builtin_amdgcn_s_setprio(0); } while (0)
#define PG8_WAIT_V(n) asm volatile("s_waitcnt vmcnt(" #n ")" ::: "memory")
#define PG8_WAIT_L(n) asm volatile("s_waitcnt lgkmcnt(" #n ")" ::: "memory")
#define PG8_BAR __builtin_amdgcn_s_barrier()
#define PG8_SCHED __builtin_amdgcn_sched_barrier(0)
    Unit cur, nxt; int ui = 0;
    if (!S.next(0, cur)) return;
    f32x4 acc[2][2][4][2];
#pragma unroll
    for (int a = 0; a < 2; ++a)
#pragma unroll
        for (int b = 0; b < 2; ++b)
#pragma unroll
            for (int m = 0; m < 4; ++m)
#pragma unroll
                for (int n = 0; n < 2; ++n) acc[a][b][m][n] = (f32x4){0.f, 0.f, 0.f, 0.f};
    bf16x8 At[4][2], B0[2][2], B1[2][2];
    const char* cA = (const char*)g.A + (size_t)cur.pm * tstep; const char* cB = (const char*)g.Bt + (size_t)cur.pn * tstep;
    S.a_ready(cur);
    if constexpr (SP2) {
        PG8_STAGE(PG8_SB(0, 0), cB, voffB); PG8_STAGE(PG8_SB(0, 1), cB + hstep, voffB); PG8_STAGE(PG8_SA(0, 0), cA, voffA); PG8_STAGE(PG8_SA(0, 1), cA + hstep, voffA);
        if (wr == 1) PG8_BAR;
        PG8_WAIT_V(2); PG8_BAR;
        PG8_STAGE(PG8_SB(1, 0), cB + kstep, voffB); PG8_STAGE(PG8_SA(1, 0), cA + kstep, voffA); PG8_STAGE(PG8_SB(1, 1), cB + hstep + kstep, voffB);
        PG8_WAIT_V(6); PG8_BAR;
    } else {
        PG8_STAGE(PG8_SB(0, 0), cB, voffB); PG8_STAGE(PG8_SA(0, 0), cA, voffA); PG8_STAGE(PG8_SB(0, 1), cB + hstep, voffB); PG8_STAGE(PG8_SA(0, 1), cA + hstep, voffA);
        if (wr == 1) PG8_BAR;
        PG8_WAIT_V(4); PG8_BAR;
        PG8_STAGE(PG8_SB(1, 0), cB + kstep, voffB); PG8_STAGE(PG8_SA(1, 0), cA + kstep, voffA); PG8_STAGE(PG8_SB(1, 1), cB + hstep + kstep, voffB);
        PG8_WAIT_V(6); PG8_BAR;
    }
    for (;;) {
        const bool has_next = S.next(ui + 1, nxt);
        const char* nA = has_next ? (const char*)g.A + (size_t)nxt.pm * tstep : cA; const char* nB = has_next ? (const char*)g.Bt + (size_t)nxt.pn * tstep : cB;
        for (int t = 0; t < nt; t += 2) {
            const bool last = (t == nt - 2);
            const char* a1 = cA + (size_t)(t + 1) * kstep;
            const char* a2 = last ? nA : cA + (size_t)(t + 2) * kstep; const char* b2 = last ? nB : cB + (size_t)(t + 2) * kstep;
            const char* a3 = a2 + kstep; const char* b3 = b2 + kstep;
            if (last && has_next) S.a_ready(nxt);
            if constexpr (SP2) {
            PG8_LDB(B0, 0, 0); PG8_LDB(B1, 0, 1); PG8_SCHED; PG8_LDA(At, 0, 0); PG8_STAGE(PG8_SA(1, 1), a1 + hstep, voffA);
            PG8_WAIT_V(8); PG8_WAIT_L(0); PG8_BAR; PG8_MMA(0, 0, At, B0); PG8_MMA(0, 1, At, B1); PG8_BAR; PG8_SCHED;
            PG8_LDA(At, 0, 1); PG8_STAGE(PG8_SB(0, 0), b2, voffB); PG8_STAGE(PG8_SB(0, 1), b2 + hstep, voffB); PG8_STAGE(PG8_SA(0, 0), a2, voffA);
            PG8_WAIT_V(8); PG8_WAIT_L(0); PG8_BAR; PG8_MMA(1, 0, At, B0); PG8_MMA(1, 1, At, B1); PG8_BAR; PG8_SCHED;
            PG8_LDB(B0, 1, 0); PG8_LDB(B1, 1, 1); PG8_SCHED; PG8_LDA(At, 1, 0); PG8_STAGE(PG8_SA(0, 1), a2 + hstep, voffA);
            PG8_WAIT_V(8); PG8_WAIT_L(0); PG8_BAR; PG8_MMA(0, 0, At, B0); PG8_MMA(0, 1, At, B1); PG8_BAR; PG8_SCHED;
            PG8_LDA(At, 1, 1); PG8_STAGE(PG8_SB(1, 0), b3, voffB); PG8_STAGE(PG8_SB(1, 1), b3 + hstep, voffB); PG8_STAGE(PG8_SA(1, 0), a3, voffA);
            PG8_WAIT_V(8); PG8_WAIT_L(0); PG8_BAR; PG8_MMA(1, 0, At, B0); PG8_MMA(1, 1, At, B1); PG8_BAR; PG8_SCHED;
            } else {
            PG8_LDB(B0, 0, 0); PG8_SCHED; PG8_LDA(At, 0, 0); PG8_STAGE(PG8_SA(1, 1), a1 + hstep, voffA);
            PG8_WAIT_L(8); PG8_BAR; PG8_WAIT_L(0); PG8_MMA(0, 0, At, B0); PG8_BAR; PG8_SCHED;
            PG8_LDB(B1, 0, 1); PG8_STAGE(PG8_SB(0, 0), b2, voffB);
            PG8_BAR; PG8_WAIT_L(0); PG8_MMA(0, 1, At, B1); PG8_BAR;
            PG8_LDA(At, 0, 1); PG8_STAGE(PG8_SA(0, 0), a2, voffA);
            PG8_BAR; PG8_WAIT_L(0); PG8_MMA(1, 0, At, B0); PG8_BAR; PG8_SCHED;
            PG8_STAGE(PG8_SB(0, 1), b2 + hstep, voffB);
            PG8_WAIT_V(6); PG8_BAR; PG8_MMA(1, 1, At, B1); PG8_BAR;
            PG8_LDB(B0, 1, 0); PG8_SCHED; PG8_LDA(At, 1, 0); PG8_STAGE(PG8_SA(0, 1), a2 + hstep, voffA);
            PG8_WAIT_L(8); PG8_BAR; PG8_WAIT_L(0); PG8_MMA(0, 0, At, B0); PG8_BAR; PG8_SCHED;
            PG8_LDB(B1, 1, 1); PG8_STAGE(PG8_SB(1, 0), b3, voffB);
            PG8_BAR; PG8_WAIT_L(0); PG8_MMA(0, 1, At, B1); PG8_BAR;
            PG8_LDA(At, 1, 1); PG8_STAGE(PG8_SA(1, 0), a3, voffA);
            PG8_BAR; PG8_WAIT_L(0); PG8_MMA(1, 0, At, B0); PG8_BAR; PG8_SCHED;
            PG8_STAGE(PG8_SB(1, 1), b3 + hstep, voffB);
            PG8_WAIT_V(6); PG8_BAR; PG8_MMA(1, 1, At, B1); PG8_BAR;
            }
        }
        if constexpr (ALIGN_EPI) { if (wr == 0) PG8_BAR; }
        if constexpr (!Epi::AFTER_DRAIN) { E(acc, cur, wr, wc, fr, fq); S.done(cur); }
        if (!has_next) break;
#pragma unroll
        for (int a = 0; a < 2; ++a)
#pragma unroll
            for (int b = 0; b < 2; ++b)
#pragma unroll
                for (int m = 0; m < 4; ++m)
#pragma unroll
                    for (int n = 0; n < 2; ++n) acc[a][b][m][n] = (f32x4){0.f, 0.f, 0.f, 0.f};
        cur = nxt; cA = nA; cB = nB; ++ui;
        if constexpr (ALIGN_EPI) { if (wr == 1) PG8_BAR; }
    }
    PG8_WAIT_V(0);
    if constexpr (!ALIGN_EPI) { if (wr == 0) PG8_BAR; }
    PG8_BAR;
    if constexpr (Epi::AFTER_DRAIN) { E.fused(acc, cur, wr, wc, fr, fq, lds, wid, lane); S.done(cur); }
#undef PG8_SA
#undef PG8_SB
#undef PG8_STAGE
#undef PG8_LDA
#undef PG8_LDB
#undef PG8_MMA
#undef PG8_WAIT_V
#undef PG8_WAIT_L
#undef PG8_BAR
#undef PG8_SCHED
}
}
namespace fa {
constexpr float SCALE = 0.08838834764831845f;
constexpr float THR = 40.f;
constexpr int D = 128, NW = 8, QBLK = 32, KVBLK = 64, QB = NW * QBLK;
constexpr int SHM_V = KVBLK * D * 2, SHM_K = KVBLK * D * 2;
constexpr int OFF_WS = 2 * SHM_V + 2 * SHM_K, OFF_BIAS = OFF_WS + NW * 64 * 4, FA_LDS = OFF_BIAS + 2 * 64 * 4;
#define KSWZ(row, colB) ((row) * 256 + ((colB) ^ (((row) & 7) << 4)))
#define SBAR() __builtin_amdgcn_sched_barrier(0)
__device__ __forceinline__ int v_st(int k, int c) { const int kk = (k & ~0xC) | ((k & 4) << 1) | ((k & 8) >> 1); return ((kk >> 3) * 4 + (c >> 5)) * 512 + ((kk & 7) * 32 + (c & 31)) * 2; }
__device__ __forceinline__ int v_rd_base(int lane) { return ((lane & 3) << 3) | (((lane >> 2) & 3) << 6) | (((lane >> 4) & 1) << 5) | (((lane >> 5) & 1) << 8); }
constexpr int v_rd_off(int d0, int ks, int half) { return d0 * 512 + ks * 4096 + half * 2048; }
__device__ __forceinline__ int crow(int r, int hi) { return (r & 3) + 8 * (r >> 2) + 4 * hi; }
__device__ __forceinline__ bf16x8 load8(const bf16* p) { return *reinterpret_cast<const bf16x8*>(p); }
__device__ __forceinline__ void mask_tile(f32x16& p0, f32x16& p1, int dq) {
    const float NEG = -__builtin_inff();
#pragma unroll
    for (int r = 0; r < 16; ++r) {
        const int c = (r & 3) + 8 * (r >> 2);
        if (dq - c < 0) p0[r] = NEG;
        if (dq - c - 32 < 0) p1[r] = NEG;
    }
}
__device__ __forceinline__ void partialSM(f32x16& p0, f32x16& p1, float& m_reg, float& mn, float& alpha) {
    float pmax = p0[0];
#pragma unroll
    for (int r = 1; r < 16; ++r) pmax = fmaxf(pmax, p0[r]);
#pragma unroll
    for (int r = 0; r < 16; ++r) pmax = fmaxf(pmax, p1[r]);
    { auto rr = __builtin_amdgcn_permlane32_swap(__float_as_uint(pmax), __float_as_uint(pmax), false, false);
      pmax = fmaxf(__uint_as_float(rr[0]), __uint_as_float(rr[1])); }
    constexpr float C2 = 1.4426950408889634f * SCALE;
    if (__builtin_expect(__all((pmax - m_reg) * SCALE <= THR), 1)) { mn = m_reg; alpha = 1.f; }
    else { mn = fmaxf(m_reg, pmax); alpha = __builtin_amdgcn_exp2f((m_reg - mn) * C2); m_reg = mn; }
    const float mnL = -mn * C2;
#pragma unroll
    for (int r = 0; r < 16; ++r) p0[r] = fmaf(p0[r], C2, mnL);
#pragma unroll
    for (int r = 0; r < 16; ++r) p1[r] = fmaf(p1[r], C2, mnL);
#pragma unroll
    for (int r = 0; r < 16; ++r) p0[r] = __builtin_amdgcn_exp2f(p0[r]);
}
__device__ __forceinline__ void finishSM(f32x16& p0, f32x16& p1, float alpha, float& l_reg, bf16x8& pa0, bf16x8& pa1, bf16x8& pa2, bf16x8& pa3) {
#pragma unroll
    for (int r = 0; r < 16; ++r) p1[r] = __builtin_amdgcn_exp2f(p1[r]);
    float ps = 0;
#pragma unroll
    for (int r = 0; r < 16; ++r) ps += p0[r];
#pragma unroll
    for (int r = 0; r < 16; ++r) ps += p1[r];
    { auto rr = __builtin_amdgcn_permlane32_swap(__float_as_uint(ps), __float_as_uint(ps), false, false);
      ps = __uint_as_float(rr[0]) + __uint_as_float(rr[1]); }
    l_reg = l_reg * alpha + ps;
#define PK4(P, B_, OUT) do { unsigned a0 = cvtpk(P[B_+0], P[B_+1]), a1 = cvtpk(P[B_+2], P[B_+3]);                          \
        unsigned b0 = cvtpk(P[B_+4], P[B_+5]), b1 = cvtpk(P[B_+6], P[B_+7]);                                             \
        auto r0 = __builtin_amdgcn_permlane32_swap(a0, b0, false, false); auto r1 = __builtin_amdgcn_permlane32_swap(a1, b1, false, false); \
        u32x4 w = {r0[0], r1[0], r0[1], r1[1]}; OUT = *reinterpret_cast<bf16x8*>(&w); } while (0)
    PK4(p0, 0, pa0); PK4(p0, 8, pa1); PK4(p1, 0, pa2); PK4(p1, 8, pa3);
#undef PK4
}
template <int KB>
__device__ __forceinline__ void qkt(f32x16& p0, f32x16& p1, const char* K_lds, const float* B_lds, int r32, int hi, const bf16x8* qr) {
    { const float* bp = B_lds + KB * 64 + 4 * hi;
      const f32x4 a0 = *(const f32x4*)(bp), a1 = *(const f32x4*)(bp + 8), a2 = *(const f32x4*)(bp + 16), a3 = *(const f32x4*)(bp + 24);
      const f32x4 c0 = *(const f32x4*)(bp + 32), c1 = *(const f32x4*)(bp + 40), c2 = *(const f32x4*)(bp + 48), c3 = *(const f32x4*)(bp + 56);
      p0 = (f32x16){a0[0], a0[1], a0[2], a0[3], a1[0], a1[1], a1[2], a1[3], a2[0], a2[1], a2[2], a2[3], a3[0], a3[1], a3[2], a3[3]};
      p1 = (f32x16){c0[0], c0[1], c0[2], c0[3], c1[0], c1[1], c1[2], c1[3], c2[0], c2[1], c2[2], c2[3], c3[0], c3[1], c3[2], c3[3]}; }
    const char* kb[4];
#pragma unroll
    for (int dd = 0; dd < 4; ++dd) kb[dd] = K_lds + KB * SHM_K + KSWZ(r32, (dd * 16 + hi * 8) * 2);
#pragma unroll
    for (int d0 = 0; d0 < 8; ++d0) { const char* a = kb[d0 & 3] + (d0 >> 2) * 128;
        bf16x8 b0 = *reinterpret_cast<const bf16x8*>(a);
        bf16x8 b1 = *reinterpret_cast<const bf16x8*>(a + 32 * 256);
        p0 = __builtin_amdgcn_mfma_f32_32x32x16_bf16(b0, qr[d0], p0, 0, 0, 0);
        p1 = __builtin_amdgcn_mfma_f32_32x32x16_bf16(b1, qr[d0], p1, 0, 0, 0); }
}
template <int VB>
__device__ __forceinline__ void pv_tile(f32x16* o, int vb0, bf16x8 pa0, bf16x8 pa1, bf16x8 pa2, bf16x8 pa3) {
#define TRRD(dst, off) asm volatile("ds_read_b64_tr_b16 %0, %1 offset:%2" : "=&v"(dst) : "v"(vb0), "i"(off) : "memory")
#define PV_D0(d0) do { s16x4 l0, l1, l2, l3, h0, h1, h2, h3; constexpr int b_ = VB * SHM_V + v_rd_off(d0, 0, 0); \
        TRRD(l0, b_); TRRD(h0, b_ + 2048); TRRD(l1, b_ + 4096); TRRD(h1, b_ + 6144); TRRD(l2, b_ + 8192); TRRD(h2, b_ + 10240); TRRD(l3, b_ + 12288); TRRD(h3, b_ + 14336); \
        asm volatile("s_waitcnt lgkmcnt(0)" ::: "memory"); SBAR();   \
        o[d0] = __builtin_amdgcn_mfma_f32_32x32x16_bf16(pa0, (bf16x8){l0[0], l0[1], l0[2], l0[3], h0[0], h0[1], h0[2], h0[3]}, o[d0], 0, 0, 0);   \
        o[d0] = __builtin_amdgcn_mfma_f32_32x32x16_bf16(pa1, (bf16x8){l1[0], l1[1], l1[2], l1[3], h1[0], h1[1], h1[2], h1[3]}, o[d0], 0, 0, 0);   \
        o[d0] = __builtin_amdgcn_mfma_f32_32x32x16_bf16(pa2, (bf16x8){l2[0], l2[1], l2[2], l2[3], h2[0], h2[1], h2[2], h2[3]}, o[d0], 0, 0, 0);   \
        o[d0] = __builtin_amdgcn_mfma_f32_32x32x16_bf16(pa3, (bf16x8){l3[0], l3[1], l3[2], l3[3], h3[0], h3[1], h3[2], h3[3]}, o[d0], 0, 0, 0); } while (0)
    PV_D0(0); PV_D0(1); PV_D0(2); PV_D0(3);
#undef PV_D0
#undef TRRD
}
struct BlockRef { const bf16* Q; const bf16* K; const bf16* V; const float* Bias; bf16* O; const bf16* Z; int P0, qpitch, kvpitch, nvalid, skv, canskip; float traw; };
__device__ __forceinline__ int fox_jlo(const BlockRef& r, int lane) { const float traw = r.traw;
    if (!r.canskip) return 0;
    const float bi = r.Bias[r.P0]; const int nt = r.P0 / KVBLK; int cnt = 0;
    for (int t0 = 0; t0 < nt; t0 += 64) { const int t = t0 + lane; const bool c = (t < nt) && (bi - r.Bias[(t < nt ? t : 0) * KVBLK + KVBLK - 1] > traw); cnt += __popcll(__ballot(c)); }
    return __builtin_amdgcn_readfirstlane(cnt);
}
}
struct Params;
template <class PRT> __device__ __forceinline__ fa::BlockRef attn_ref(PRT p, int L, int pass, float traw_p, float qkb, float knew);
namespace fa {
struct Seam { bf16x8 qr[8]; bf16x8 st_v0, st_v1, st_k0, st_k1; float st_b; };
#define VMW() asm volatile("s_waitcnt vmcnt(0)" ::: "memory")
#define VMWN(n) asm volatile("s_waitcnt vmcnt(%0)" :: "i"(n) : "memory")
#define SLOAD_H(Kp, Vp, Bp, pitch, k0) do { const unsigned vo_ = (unsigned)(sr * (pitch) + sc) * 2u; \
        const char* kb_ = (const char*)(Kp) + (size_t)(k0) * (size_t)(pitch) * 2; const char* vb_ = (const char*)(Vp) + (size_t)(k0) * (size_t)(pitch) * 2; const size_t r32_ = (size_t)(pitch) * 64; \
        S.st_v0 = *(const bf16x8*)(vb_ + vo_); S.st_v1 = *(const bf16x8*)(vb_ + r32_ + vo_);              \
        S.st_k0 = *(const bf16x8*)(kb_ + vo_); S.st_k1 = *(const bf16x8*)(kb_ + r32_ + vo_); S.st_b = *(const float*)((const char*)((Bp) + (k0)) + (unsigned)((tid & 63) * 4)); } while (0)
#define SWRITE_HK(bf) do { *(bf16x8*)(K_lds + (bf) * SHM_K + kws) = S.st_k0; *(bf16x8*)(K_lds + (bf) * SHM_K + kws + 32 * 256) = S.st_k1; if (tid < 64) B_lds[(bf) * 64 + tid] = S.st_b; } while (0)
#define SWRITE_HV(bf) do { *(bf16x8*)(V_lds + (bf) * SHM_V + vst0) = S.st_v0; *(bf16x8*)(V_lds + (bf) * SHM_V + vst1) = S.st_v1; } while (0)
#define SWRITE_H(bf) do { SWRITE_HV(bf); SWRITE_HK(bf); } while (0)
#define QLOAD(ref) do { const int qrow_ = wid * QBLK + r32; \
        _Pragma("unroll") for (int d0 = 0; d0 < 8; ++d0) S.qr[d0] = load8((ref).Q + (size_t)qrow_ * (ref).qpitch + d0 * 16 + hi * 8); } while (0)
__device__ __forceinline__ void fox_prime(const BlockRef& cur, char* lds, Seam& S, int wv, int jlo) {
    const int tid = tid_of(wv), wid = __builtin_amdgcn_readfirstlane(tid >> 6), lane = tid & 63, r32 = lane & 31, hi = lane >> 5;
    const int sr = tid >> 4, sc = (tid & 15) * 8, kws = KSWZ(sr, sc * 2); char* K_lds = lds + 2 * SHM_V; float* B_lds = (float*)(lds + OFF_BIAS);
    QLOAD(cur);
    SLOAD_H(cur.K, cur.V, cur.Bias, cur.kvpitch, jlo * KVBLK); VMW(); SWRITE_HK(0);
    __syncthreads();
}
template <class PRT> __device__ __forceinline__ void fox_block(PRT p, int L, int pass, int Ln, int passn, char* lds, Seam& S, int wv, int j_lo, int& jlo_next, float traw, float qkb, float knew) {
    const BlockRef cur = attn_ref<PRT>(p, L, pass, traw, qkb, knew);
    const int tid = tid_of(wv), wid = __builtin_amdgcn_readfirstlane(tid >> 6), lane = tid & 63, r32 = lane & 31, hi = lane >> 5;
    int j_hi = (cur.P0 + QB - 1) / KVBLK + 1; if (j_hi > cur.skv / KVBLK) j_hi = cur.skv / KVBLK;
    const int NT = j_hi - j_lo;
    const int qlo = cur.P0 + wid * QBLK, qm = qlo + r32 - 4 * hi;
    char* V_lds = lds; char* K_lds = lds + 2 * SHM_V;
    float* ws = (float*)(lds + OFF_WS) + wid * 64; float* li_l = ws, * al_l = ws + 32; float* B_lds = (float*)(lds + OFF_BIAS);
    float m_reg = -1e30f, l_reg = 0; f32x16 o[4] = {};
    const int sr = tid >> 4, sc = (tid & 15) * 8, vst0 = v_st(sr, sc), vst1 = v_st(32 + sr, sc), kws = KSWZ(sr, sc * 2);
    const int vb0 = (int)(uintptr_t)V_lds + v_rd_base(lane);
    const bf16* Kh = cur.K; const bf16* Vh = cur.V; const float* Bh = cur.Bias; const int kvp = cur.kvpitch;
#define RESC(a) do { if (__any((a) < 1.f)) { if (hi == 0) al_l[r32] = (a); asm volatile("s_waitcnt lgkmcnt(0)" ::: "memory");              \
                     _Pragma("unroll") for (int d_ = 0; d_ < 4; ++d_) _Pragma("unroll") for (int r = 0; r < 16; ++r) o[d_][r] *= al_l[crow(r, hi)]; } } while (0)
#define KBASE(t) ((j_lo + (t)) * KVBLK)
#define MASKT(P0_, P1_, t) do { const int kb_ = KBASE(t); if (kb_ + KVBLK - 1 > qlo) mask_tile(P0_, P1_, qm - kb_); } while (0)
    f32x16 pA0, pA1, pB0, pB1; float mnA, mnB, alA, alB; bf16x8 pa0, pa1, pa2, pa3;
    SWRITE_HV(0); SBAR();
    if (NT > 1) { SLOAD_H(Kh, Vh, Bh, kvp, KBASE(1)); }
    SBAR(); qkt<0>(pA0, pA1, K_lds, B_lds, r32, hi, S.qr);
    MASKT(pA0, pA1, 0); partialSM(pA0, pA1, m_reg, mnA, alA);
    if (NT > 1) { VMW(); SWRITE_H(1); }
    __syncthreads();
#define HALF_STEP(PX0, PX1, mnX, alX, PY0, PY1, alY, t, KB, VB, SB) do {                                                      \
        SBAR(); qkt<KB>(PX0, PX1, K_lds, B_lds, r32, hi, S.qr);                                             \
        finishSM(PY0, PY1, alY, l_reg, pa0, pa1, pa2, pa3); SBAR();                                                           \
        if ((t) + 1 < NT) { SLOAD_H(Kh, Vh, Bh, kvp, KBASE((t) + 1)); SBAR(); }                                               \
        pv_tile<VB>(o, vb0, pa0, pa1, pa2, pa3); MASKT(PX0, PX1, (t)); partialSM(PX0, PX1, m_reg, mnX, alX);                                        \
        __syncthreads();                                                                                                      \
        if ((t) + 1 < NT) { VMW(); SWRITE_H(SB); }                                                                          \
        RESC(alX); __syncthreads(); } while (0)
    for (int t = 1; t + 1 < NT; t += 2) {
        HALF_STEP(pB0, pB1, mnB, alB, pA0, pA1, alA, t, 1, 0, 0);
        HALF_STEP(pA0, pA1, mnA, alA, pB0, pB1, alB, t + 1, 0, 1, 1);
    }
    const bool even = (NT & 1) == 0;
    if (even) { SBAR(); qkt<1>(pB0, pB1, K_lds, B_lds, r32, hi, S.qr); SBAR(); }
    { int Ln_ = __builtin_amdgcn_readfirstlane(Ln), pn_ = __builtin_amdgcn_readfirstlane(passn); asm volatile("" : "+s"(Ln_), "+s"(pn_)); const BlockRef nxt = attn_ref<PRT>(p, Ln_, pn_, traw, qkb, knew);
      const int jn_ = fox_jlo(nxt, lane); jlo_next = jn_;
      SLOAD_H(nxt.K, nxt.V, nxt.Bias, nxt.kvpitch, jn_ * KVBLK); SBAR();
      QLOAD(nxt); }
    SBAR();
    finishSM(pA0, pA1, alA, l_reg, pa0, pa1, pa2, pa3); SBAR();
    pv_tile<0>(o, vb0, pa0, pa1, pa2, pa3);
    if (even) { MASKT(pB0, pB1, NT - 1); partialSM(pB0, pB1, m_reg, mnB, alB); __syncthreads(); RESC(alB);
        finishSM(pB0, pB1, alB, l_reg, pa0, pa1, pa2, pa3); SBAR(); pv_tile<1>(o, vb0, pa0, pa1, pa2, pa3); }
    SBAR(); VMWN(8); SWRITE_HK(0); SBAR();
    if (hi == 0) li_l[r32] = l_reg; asm volatile("s_waitcnt lgkmcnt(0)" ::: "memory");
    float rli[16];
#pragma unroll
    for (int r = 0; r < 16; ++r) rli[r] = __builtin_amdgcn_rcpf(li_l[crow(r, hi)]);
    int Le_ = __builtin_amdgcn_readfirstlane(L), pe_ = __builtin_amdgcn_readfirstlane(pass); asm volatile("" : "+s"(Le_), "+s"(pe_)); const BlockRef ce = attn_ref<PRT>(p, Le_, pe_, traw, qkb, knew);
#pragma unroll
    for (int r = 0; r < 16; ++r) { const int orow = wid * QBLK + crow(r, hi);
#pragma unroll
        for (int d0 = 0; d0 < 4; ++d0) { const float v = o[d0][r] * rli[r];
            const float vn = __shfl_xor(v, 1);
            if ((r32 & 1) == 0 && orow < ce.nvalid) {
                const unsigned zz = *(const unsigned*)(ce.Z + (size_t)orow * ODD_N + d0 * 32 + r32);
                *(unsigned*)(ce.O + (size_t)orow * DM + d0 * 32 + r32) = cvtpk(v * silu_f(bflo(zz)), vn * silu_f(bfhi(zz))); } } }
    __syncthreads();
#undef RESC
#undef KBASE
#undef MASKT
#undef HALF_STEP
}
#undef ROWP
#undef VMW
#undef VMWN
#undef SLOAD_H
#undef SWRITE_HK
#undef SWRITE_HV
#undef SWRITE_H
#undef QLOAD
#undef SBAR
}
struct Params { const float* in[25]; float* out; unsigned char* ws; };
typedef const __attribute__((address_space(4))) Params& PR;
__device__ __forceinline__ const __attribute__((address_space(4))) Params* params_here() { const __attribute__((address_space(4))) Params* q = (const __attribute__((address_space(4))) Params*)__builtin_amdgcn_kernarg_segment_ptr(); asm volatile("" : "+s"(q)); return q; }
enum { I_XP = 0, I_XS, I_CK, I_CV, I_CLF, I_SSD, I_SCONV, I_NPRE, I_NPOST, I_WINE, I_WOUTE, I_GWS, I_GBS, I_GGV, I_CW, I_CB, I_DTB, I_ALOG, I_DSK, I_GSSD, I_WINO, I_BF, I_WOUTO, I_GQ, I_GK };

template <int MODE> struct EpiProj {
    static constexpr bool PERM = true, AFTER_DRAIN = false;
    unsigned char* ws; float* out; const float* gq; const float* gk; float* xl; int jl;
    __device__ __forceinline__ void operator()(const pg8::f32x4 (&acc)[2][2][4][2], const pg8::Unit& u, int wr, int wc, int fr, int fq) const {
        constexpr int ldc = MODE == 0 ? 1024 : (MODE == 1 ? EVEN_N : ODD_N), n_main = ldc / 256, thin_cols = MODE == 1 ? 16 : 8;
        bf16* O = (bf16*)(ws + (MODE == 0 ? WS_O : WS_PROJ));
        const int row0 = u.pm * 256 + wr * 64 + fr;
        if (MODE == 0 || u.pn < n_main) {
            const int col0 = u.pn * 256 + wc * 32 + 8 * fq;
            const bool isv = MODE == 2 && u.pn >= 8 && u.pn < 12, isqk = MODE == 2 && u.pn < 8, isk = isqk && u.pn >= 4;
            float rs[2][2][4];
            pg8::f32x4 g0 = {1.f, 1.f, 1.f, 1.f}, g1 = {1.f, 1.f, 1.f, 1.f};
            if (MODE == 2 && isqk) {
#pragma unroll
                for (int ai = 0; ai < 2; ++ai)
#pragma unroll
                    for (int bj = 0; bj < 2; ++bj)
#pragma unroll
                        for (int m = 0; m < 4; ++m) { const pg8::f32x4 a = acc[ai][bj][m][0], b = acc[ai][bj][m][1];
                            float s = (a[0] * a[0] + a[1] * a[1]) + (a[2] * a[2] + a[3] * a[3]) + (b[0] * b[0] + b[1] * b[1]) + (b[2] * b[2] + b[3] * b[3]);
                            s += __shfl_xor(s, 16); s += __shfl_xor(s, 32);
                            if (fq == 0) xl[((((wr * 4 + wc) * 2 + ai) * 2 + bj) * 4 + m) * 16 + fr] = s; }
                asm volatile("s_waitcnt lgkmcnt(0)" ::: "memory"); __builtin_amdgcn_s_barrier(); asm volatile("" ::: "memory");
#pragma unroll
                for (int ai = 0; ai < 2; ++ai)
#pragma unroll
                    for (int bj = 0; bj < 2; ++bj)
#pragma unroll
                        for (int m = 0; m < 4; ++m) { float t = 0.f;
#pragma unroll
                            for (int w4 = 0; w4 < 4; ++w4) t += xl[((((wr * 4 + w4) * 2 + ai) * 2 + bj) * 4 + m) * 16 + fr];
                            rs[ai][bj][m] = rsqrtf(t * (1.f / 128.f) + EPS); }
                const float* gp = (isk ? gk : gq) + wc * 32 + 8 * fq; g0 = *(const pg8::f32x4*)gp; g1 = *(const pg8::f32x4*)(gp + 4);
            }
#pragma unroll
            for (int ai = 0; ai < 2; ++ai)
#pragma unroll
                for (int m = 0; m < 4; ++m) { const int row = row0 + ai * 128 + m * 16; bf16* rowp = O + (size_t)row * ldc + col0;
#pragma unroll
                    for (int bj = 0; bj < 2; ++bj) { pg8::f32x4 v0 = acc[ai][bj][m][0], v1 = acc[ai][bj][m][1];
                        if (MODE == 2 && isqk) { v0 = v0 * rs[ai][bj][m] * g0; v1 = v1 * rs[ai][bj][m] * g1; }
                        u32x4 w; w.x = cvtpk(v0[0], v0[1]); w.y = cvtpk(v0[2], v0[3]); w.z = cvtpk(v1[0], v1[1]); w.w = cvtpk(v1[2], v1[3]);
                        *(u32x4*)(rowp + bj * 128) = w;
                        if (MODE == 2 && (isv || isk)) { const int vc = col0 - (isv ? 2048 : 1024) + bj * 128; const bool samp = row >= TP;
                            float* vo = out + (isv ? (samp ? O_VS + ((size_t)jl * TS + (row - TP)) * DM : O_VP + ((size_t)jl * TP + row) * DM)
                                                   : (samp ? O_KS + ((size_t)jl * TS + (row - TP)) * DM : O_KP + ((size_t)jl * TP + row) * DM)) + vc;
                            *(pg8::f32x4*)vo = v0; *(pg8::f32x4*)(vo + 4) = v1;
                            if (samp) { const int sr = row - TP; *(u32x4*)((bf16*)(ws + (isv ? WS_VS : WS_KS)) + ((size_t)(sr / SSEQ) * SKS + PAST + (sr % SSEQ)) * DM + vc) = w; } } } }
        } else if (MODE != 0) {
            if (wc == 0 && 8 * fq < thin_cols) { float* thin = (float*)(ws + (MODE == 1 ? WS_DTRAW : WS_FLOG));
#pragma unroll
                for (int ai = 0; ai < 2; ++ai)
#pragma unroll
                    for (int m = 0; m < 4; ++m) { float* tp = thin + (size_t)(row0 + ai * 128 + m * 16) * thin_cols + 8 * fq;
                        *(pg8::f32x4*)tp = acc[ai][0][m][0]; *(pg8::f32x4*)(tp + 4) = acc[ai][0][m][1]; }
            }
        }
    }
};

__device__ __forceinline__ void transpose_item(const float* W, int K, int N, bf16* WT, float* scr, int item, int nblk, int lane) {
    const int kb = item / nblk, nb = item % nblk, k0 = 64 * kb, n0 = 32 * nb;
    const int ncol = n0 + (lane & 31);
#pragma unroll 8
    for (int i = 0; i < 32; ++i) { const int kk = 2 * i + (lane >> 5); scr[kk * 33 + (lane & 31)] = (ncol < N) ? W[(size_t)(k0 + kk) * N + ncol] : 0.f; }
    asm volatile("s_waitcnt lgkmcnt(0)" ::: "memory");
    const int c = lane & 7;
#pragma unroll
    for (int j = 0; j < 4; ++j) { const int n = (lane >> 3) + 8 * j; const float* s = scr + (8 * c) * 33 + n;
        u32x4 o; o.x = cvtpk(s[0 * 33], s[1 * 33]); o.y = cvtpk(s[2 * 33], s[3 * 33]); o.z = cvtpk(s[4 * 33], s[5 * 33]); o.w = cvtpk(s[6 * 33], s[7 * 33]);
        *(u32x4*)(WT + (size_t)(n0 + n) * K + k0 + 8 * c) = o; }
    asm volatile("s_waitcnt lgkmcnt(0)" ::: "memory");
}
__device__ __forceinline__ void phase_prologue(int wv, PR p, char* lds) {
    const int tid = tid_of(wv), lane = tid & 63, wave = __builtin_amdgcn_readfirstlane(tid >> 6), gw = bid_here() * 8 + wave, NGW = gridDim.x * 8;
    float* scr = (float*)(lds + wave * 8704);
    constexpr int I0 = 16 * (EVEN_NP / 32), I1 = 32 * 32, I2 = 16 * (ODD_NP / 32), I3 = 16 * 32;
    constexpr int NIT = 2 * (I0 + I1 + I2 + I3);
    for (int it = gw; it < NIT; it += NGW) {
        int r = it; const int j = r & 1; r >>= 1;
        if (r < I0) { transpose_item(p.in[I_WINE] + (size_t)j * 1024 * EVEN_IN, 1024, EVEN_IN, (bf16*)(p.ws + WS_WINE) + (size_t)j * EVEN_NP * 1024, scr, r, EVEN_NP / 32, lane); continue; } r -= I0;
        if (r < I1) { transpose_item(p.in[I_WOUTE] + (size_t)j * 2048 * 1024, 2048, 1024, (bf16*)(p.ws + WS_WOUTE) + (size_t)j * 1024 * 2048, scr, r, 32, lane); continue; } r -= I1;
        if (r < I2) { transpose_item(p.in[I_WINO] + (size_t)j * 1024 * ODD_IN, 1024, ODD_IN, (bf16*)(p.ws + WS_WINO) + (size_t)j * ODD_NP * 1024, scr, r, ODD_NP / 32, lane); continue; } r -= I2;
        transpose_item(p.in[I_WOUTO] + (size_t)j * 1024 * 1024, 1024, 1024, (bf16*)(p.ws + WS_WOUTO) + (size_t)j * 1024 * 1024, scr, r, 32, lane);
    }
}

__device__ __forceinline__ void phase_norm(int wv, PR p, int li) {
    const int tid = tid_of(wv), lane = tid & 63, wave = __builtin_amdgcn_readfirstlane(tid >> 6), gw = bid_here() * 8 + wave, NGW = gridDim.x * 8;
    bf16* resb = (bf16*)(p.ws + WS_RES); const bf16* ob = (const bf16*)(p.ws + WS_O); bf16* hb = (bf16*)(p.ws + WS_H);
    const float* gpost = p.in[I_NPOST] + (li > 0 ? (li - 1) * DM : 0); const float* gpre = p.in[I_NPRE] + (li < 4 ? li * DM : 0);
    f32x4 gpo[4], gpr[4];
#pragma unroll
    for (int j = 0; j < 4; ++j) { gpo[j] = *(const f32x4*)(gpost + 4 * lane + 256 * j); gpr[j] = *(const f32x4*)(gpre + 4 * lane + 256 * j); }
    for (int row0 = gw; row0 < TT; row0 += 2 * NGW) {
        int rows[2] = {row0, row0 + NGW}; const bool v1 = rows[1] < TT; if (!v1) rows[1] = row0;
        f32x4 x[2][4]; u32x2 ow[2][4];
#pragma unroll
        for (int k = 0; k < 2; ++k) { const int row = rows[k];
            if (li <= 1) { const float* xin = row < TP ? p.in[I_XP] + (size_t)row * DM : p.in[I_XS] + (size_t)(row - TP) * DM;
#pragma unroll
                for (int j = 0; j < 4; ++j) x[k][j] = *(const f32x4*)(xin + 4 * lane + 256 * j); }
            else {
#pragma unroll
                for (int j = 0; j < 4; ++j) { const u32x2 w = *(const u32x2*)(resb + (size_t)row * DM + 4 * lane + 256 * j); x[k][j] = (f32x4){bflo(w.x), bfhi(w.x), bflo(w.y), bfhi(w.y)}; } }
            if (li > 0) {
#pragma unroll
                for (int j = 0; j < 4; ++j) ow[k][j] = *(const u32x2*)(ob + (size_t)row * DM + 4 * lane + 256 * j); } }
#pragma unroll
        for (int k = 0; k < 2; ++k) { const int row = rows[k]; if (k == 1 && !v1) break;
            if (li > 0) {
                f32x4 o[4]; float s = 0.f;
#pragma unroll
                for (int j = 0; j < 4; ++j) { const u32x2 w = ow[k][j];
                    o[j] = (f32x4){bflo(w.x), bfhi(w.x), bflo(w.y), bfhi(w.y)}; s += (o[j].x * o[j].x + o[j].y * o[j].y) + (o[j].z * o[j].z + o[j].w * o[j].w); }
                const float r = rsqrtf(wave_sum(s) * (1.f / DM) + EPS);
#pragma unroll
                for (int j = 0; j < 4; ++j) { x[k][j] = x[k][j] + o[j] * r * gpo[j];
                    if (li == 4) *(f32x4*)(p.out + (size_t)row * DM + 4 * lane + 256 * j) = x[k][j];
                    else { u32x2 w; w.x = cvtpk(x[k][j].x, x[k][j].y); w.y = cvtpk(x[k][j].z, x[k][j].w); *(u32x2*)(resb + (size_t)row * DM + 4 * lane + 256 * j) = w;
                           x[k][j] = (f32x4){bflo(w.x), bfhi(w.x), bflo(w.y), bfhi(w.y)}; } }
            }
            if (li < 4) {
                float s = 0.f;
#pragma unroll
                for (int j = 0; j < 4; ++j) s += (x[k][j].x * x[k][j].x + x[k][j].y * x[k][j].y) + (x[k][j].z * x[k][j].z + x[k][j].w * x[k][j].w);
                const float r = rsqrtf(wave_sum(s) * (1.f / DM) + EPS);
#pragma unroll
                for (int j = 0; j < 4; ++j) { const f32x4 h = x[k][j] * r * gpr[j];
                    u32x2 w; w.x = cvtpk(h.x, h.y); w.y = cvtpk(h.z, h.w); *(u32x2*)(hb + (size_t)row * DM + 4 * lane + 256 * j) = w; }
            }
        }
    }
}

constexpr int NCHP = TP / 64, NCH = NCHP + NSB;
constexpr size_t A_XT = 0, A_B = A_XT + (size_t)NCH * 16 * 64 * 64 * 2, A_C = A_B + (size_t)NCH * 64 * 256 * 2, A_BT = A_C + (size_t)NCH * 64 * 256 * 2;
constexpr size_t A_DT = A_BT + (size_t)NCH * 2 * 128 * 64 * 2, A_ACS = A_DT + (size_t)NCH * 16 * 64 * 4, A_W = A_ACS + (size_t)NCH * 16 * 64 * 4, A_END = A_W + (size_t)NCH * 16 * 64 * 4;
static_assert(A_END <= 163 * MiB, "act layouts");
__device__ __forceinline__ void phase_conv(int wv, PR p, int jl) {
    const int tid = tid_of(wv), lane = tid & 63, wave = __builtin_amdgcn_readfirstlane(tid >> 6);
    const int gtid = bid_here() * 512 + tid, gthreads = gridDim.x * 512;
    const bf16* proj = (const bf16*)(p.ws + WS_PROJ);
    bf16* XT = (bf16*)(p.ws + WS_ACT + A_XT); bf16* Bact = (bf16*)(p.ws + WS_ACT + A_B); bf16* Cact = (bf16*)(p.ws + WS_ACT + A_C); bf16* BT = (bf16*)(p.ws + WS_ACT + A_BT);
    const float* cw = p.in[I_CW] + (size_t)jl * CONV_DIM * 4; const float* cb = p.in[I_CB] + (size_t)jl * CONV_DIM;
    constexpr int NCG = CONV_DIM / 8;
    for (int idx = gtid; idx < NCH * NCG; idx += gthreads) {
        const int ch = idx / NCG, cgp = idx - ch * NCG, c0 = cgp * 8;
        int row0, Lv, b; bool samp, first, lastc;
        if (ch < NCHP) { b = ch >> 7; const int t0 = (ch & 127) * 64; row0 = b * SEQ + t0; Lv = 64; samp = false; first = (t0 == 0); lastc = (t0 + 64 == SEQ); }
        else { b = ch - NCHP; row0 = TP + b * SSEQ; Lv = SSEQ; samp = true; first = true; lastc = true; }
        float w[8][4], bias[8], xm3[8], xm2[8], xm1[8];
#pragma unroll
        for (int e = 0; e < 8; ++e) { const f32x4 t = *(const f32x4*)(cw + (size_t)(c0 + e) * 4); w[e][0] = t.x; w[e][1] = t.y; w[e][2] = t.z; w[e][3] = t.w; bias[e] = cb[c0 + e]; }
        if (first) {
            if (samp) { const float* sc = p.in[I_SCONV] + ((size_t)(jl * NSB + b) * 3) * CONV_DIM + c0;
#pragma unroll
                for (int e = 0; e < 8; ++e) { xm3[e] = sc[e]; xm2[e] = sc[CONV_DIM + e]; xm1[e] = sc[2 * CONV_DIM + e]; } }
            else {
#pragma unroll
                for (int e = 0; e < 8; ++e) { xm3[e] = 0.f; xm2[e] = 0.f; xm1[e] = 0.f; } }
        } else {
            unpack8(*(const u32x4*)(proj + (size_t)(row0 - 3) * EVEN_N + 4096 + c0), xm3);
            unpack8(*(const u32x4*)(proj + (size_t)(row0 - 2) * EVEN_N + 4096 + c0), xm2);
            unpack8(*(const u32x4*)(proj + (size_t)(row0 - 1) * EVEN_N + 4096 + c0), xm1);
        }
        u32x4 nx[8];
#pragma unroll
        for (int t = 0; t < 8; ++t) nx[t] = *(const u32x4*)(proj + (size_t)(row0 + t) * EVEN_N + 4096 + c0);
#pragma unroll 1
        for (int tb = 0; tb < 8; ++tb) {
            float v[8][8];
            if (8 * tb < Lv) {
                u32x4 cur[8];
#pragma unroll
                for (int t = 0; t < 8; ++t) cur[t] = nx[t];
                if (8 * (tb + 1) < Lv) {
#pragma unroll
                    for (int t = 0; t < 8; ++t) nx[t] = *(const u32x4*)(proj + (size_t)(row0 + 8 * (tb + 1) + t) * EVEN_N + 4096 + c0); }
#pragma unroll
                for (int t = 0; t < 8; ++t) { float x[8]; unpack8(cur[t], x);
#pragma unroll
                    for (int e = 0; e < 8; ++e) { const float y = bias[e] + xm3[e] * w[e][0] + xm2[e] * w[e][1] + xm1[e] * w[e][2] + x[e] * w[e][3]; v[t][e] = silu_f(y); xm3[e] = xm2[e]; xm2[e] = xm1[e]; xm1[e] = x[e]; } }
            } else {
#pragma unroll
                for (int t = 0; t < 8; ++t)
#pragma unroll
                    for (int e = 0; e < 8; ++e) v[t][e] = 0.f;
            }
            if (c0 < 1024 || (c0 >= 1024 && c0 < 1280)) {
                bf16* dst = (c0 < 1024) ? XT + ((((size_t)ch * 16 + (c0 >> 6)) * 8 + tb) * 64 + (c0 & 63)) * 8 : BT + ((((size_t)ch * 2 + ((c0 - 1024) >> 7)) * 8 + tb) * 128 + ((c0 - 1024) & 127)) * 8;
#pragma unroll
                for (int e = 0; e < 8; ++e) { u32x4 o; o.x = cvtpk(v[0][e], v[1][e]); o.y = cvtpk(v[2][e], v[3][e]); o.z = cvtpk(v[4][e], v[5][e]); o.w = cvtpk(v[6][e], v[7][e]); *(u32x4*)(dst + (size_t)e * 8) = o; }
            }
            if (c0 >= 1024) {
                bf16* dst = (c0 < 1280 ? Bact + (c0 - 1024) : Cact + (c0 - 1280)) + ((size_t)ch * 64 + 8 * tb) * 256;
#pragma unroll
                for (int t = 0; t < 8; ++t) *(u32x4*)(dst + (size_t)t * 256) = pack8f(v[t]);
            }
        }
        if (lastc) {
            float* co = p.out + (samp ? O_CS + ((size_t)(jl * NSB + b) * 3) * CONV_DIM : O_CP + ((size_t)(jl * NB + b) * 3) * CONV_DIM) + c0;
#pragma unroll
            for (int e = 0; e < 8; ++e) { co[e] = xm3[e]; co[CONV_DIM + e] = xm2[e]; co[2 * CONV_DIM + e] = xm1[e]; }
        }
    }
    { const float* dtraw = (const float*)(p.ws + WS_DTRAW); float* DT = (float*)(p.ws + WS_ACT + A_DT); float* ACS = (float*)(p.ws + WS_ACT + A_ACS); float* WW = (float*)(p.ws + WS_ACT + A_W);
      const int gw = bid_here() * 8 + wave, NGW = gridDim.x * 8;
      for (int it = gw; it < NCH * 16; it += NGW) { const int ch = it >> 4, h = it & 15;
          const int row = (ch < NCHP) ? ch * 64 + lane : TP + (ch - NCHP) * SSEQ + lane; const bool valid = (ch < NCHP) || lane < SSEQ;
          float dt = 0.f; if (valid) dt = softplus_f(dtraw[(size_t)row * 16 + h] + p.in[I_DTB][jl * 16 + h]);
          const float a_h = -__expf(p.in[I_ALOG][jl * 16 + h]);
          float acs = dt * a_h;
#pragma unroll
          for (int o = 1; o < 64; o <<= 1) { const float t = __shfl_up(acs, o); if (lane >= o) acs += t; }
          const float alast = __shfl(acs, 63);
          DT[(size_t)it * 64 + lane] = dt; ACS[(size_t)it * 64 + lane] = acs; WW[(size_t)it * 64 + lane] = dt * __expf(alast - acs); } }
}

constexpr int GM_WSTR = 136;
__device__ __forceinline__ void phase_gmlp(int wv, PR p, int jl, char* lds) {
    const int tid = tid_of(wv), lane = tid & 63, wave = tid >> 6;
    const bf16* proj = (const bf16*)(p.ws + WS_PROJ); bf16* cat = (bf16*)(p.ws + WS_CAT);
    bf16* Wl = (bf16*)lds; bf16* vT = (bf16*)(lds + 128 * GM_WSTR * 2);
    constexpr int NU = (TP / 128 + NSB) * 4;
    for (int u = bid_here(); u < NU; u += gridDim.x) {
        const int g = u & 3, cu = u >> 2;
        int row0, n; bool samp; int sb = 0;
        if (cu < TP / 128) { row0 = cu * 128; n = 128; samp = false; } else { sb = cu - TP / 128; row0 = TP + sb * SSEQ; n = SSEQ; samp = true; }
        __syncthreads();
        { const int j = tid >> 2, q = tid & 3; const bool valid = j < n;
          float v[64]; float ss = 0.f;
          const float* gv = p.in[I_GGV] + (size_t)(jl * 4 + g) * 256;
#pragma unroll
          for (int i = 0; i < 8; ++i) { const int cc = (q + 4 * i) * 8;
              u32x4 w = {0u, 0u, 0u, 0u}; if (valid) w = *(const u32x4*)(proj + (size_t)(row0 + j) * EVEN_N + 1024 + g * 256 + cc);
              float f[8]; unpack8(w, f);
#pragma unroll
              for (int e = 0; e < 8; e += 2) { const f32x2 gg = pg8::gelu_pk((f32x2){f[e], f[e + 1]}); v[i * 8 + e] = gg.x; v[i * 8 + e + 1] = gg.y; ss += gg.x * gg.x + gg.y * gg.y; } }
          ss += __shfl_xor(ss, 1); ss += __shfl_xor(ss, 2);
          const float r = rsqrtf(ss * (1.f / 256.f) + EPS);
#pragma unroll
          for (int i = 0; i < 8; ++i) { const int cc = (q + 4 * i) * 8;
#pragma unroll
              for (int e = 0; e < 8; ++e) v[i * 8 + e] = v[i * 8 + e] * r * gv[cc + e];
              if (samp && valid) { float* go = p.out + O_GV + ((size_t)(jl * NSB + sb) * SSEQ + j) * DM + g * 256 + cc;
                  *(f32x4*)go = (f32x4){v[i * 8], v[i * 8 + 1], v[i * 8 + 2], v[i * 8 + 3]}; *(f32x4*)(go + 4) = (f32x4){v[i * 8 + 4], v[i * 8 + 5], v[i * 8 + 6], v[i * 8 + 7]}; }
#pragma unroll
              for (int e = 0; e < 8; e += 2) { const unsigned pk = cvtpk(v[i * 8 + e], v[i * 8 + e + 1]); vT[(cc + e) * GM_WSTR + j] = (bf16)(pk & 0xffffu); vT[(cc + e + 1) * GM_WSTR + j] = (bf16)(pk >> 16); } }
        }
        { const int i = tid >> 2, jq = tid & 3; const float* wsrc = p.in[I_GWS] + ((size_t)(jl * 4 + g) * 128 + i) * 128 + jq * 32;
#pragma unroll
          for (int c = 0; c < 4; ++c) { float f[8];
              const f32x4 a = *(const f32x4*)(wsrc + c * 8), b = *(const f32x4*)(wsrc + c * 8 + 4);
              f[0] = a.x; f[1] = a.y; f[2] = a.z; f[3] = a.w; f[4] = b.x; f[5] = b.y; f[6] = b.z; f[7] = b.w;
              const int j0 = jq * 32 + c * 8;
              const bool keep = (i < n) && (j0 < n) && ((j0 >> 6) <= (i >> 6));
              if (!keep) {
#pragma unroll
                  for (int e = 0; e < 8; ++e) f[e] = 0.f; }
              *(u32x4*)(Wl + i * GM_WSTR + j0) = pack8f(f); } }
        __syncthreads();
        const int wi = wave >> 2, wj = wave & 3, fr = lane & 15, fq = lane >> 4;
        f32x4 acc[4][4];
#pragma unroll
        for (int a = 0; a < 4; ++a)
#pragma unroll
            for (int b = 0; b < 4; ++b) acc[a][b] = (f32x4){0.f, 0.f, 0.f, 0.f};
        const int nks = (wi == 0) ? 2 : 4;
        for (int ks = 0; ks < nks; ++ks) {
            bf16x8 af[4], bfr[4];
#pragma unroll
            for (int mi = 0; mi < 4; ++mi) af[mi] = *(const bf16x8*)(Wl + (64 * wi + 16 * mi + fr) * GM_WSTR + ks * 32 + fq * 8);
#pragma unroll
            for (int ni = 0; ni < 4; ++ni) bfr[ni] = *(const bf16x8*)(vT + (64 * wj + 16 * ni + fr) * GM_WSTR + ks * 32 + fq * 8);
#pragma unroll
            for (int ni = 0; ni < 4; ++ni)
#pragma unroll
                for (int mi = 0; mi < 4; ++mi) acc[ni][mi] = __builtin_amdgcn_mfma_f32_16x16x32_bf16(bfr[ni], af[mi], acc[ni][mi], 0, 0, 0);
        }
        const float* bs = p.in[I_GBS] + (size_t)(jl * 4 + g) * 128;
#pragma unroll
        for (int mi = 0; mi < 4; ++mi) { const int i = 64 * wi + 16 * mi + fr;
            if (i < n) { const float bsi = bs[i]; const size_t rb = (size_t)(row0 + i) * EVEN_N;
#pragma unroll
                for (int ni = 0; ni < 4; ++ni) { const int col = g * 256 + 64 * wj + 16 * ni + 4 * fq;
                    const u32x2 uu = *(const u32x2*)(proj + rb + col), zz = *(const u32x2*)(proj + rb + 2048 + col);
                    const f32x2 g0 = pg8::gelu_pk((f32x2){bflo(uu.x), bfhi(uu.x)}), g1 = pg8::gelu_pk((f32x2){bflo(uu.y), bfhi(uu.y)});
                    const f32x4 s = acc[ni][mi] + bsi;
                    u32x2 o; o.x = cvtpk(silu_f(bflo(zz.x)) * g0.x * s.x, silu_f(bfhi(zz.x)) * g0.y * s.y); o.y = cvtpk(silu_f(bflo(zz.y)) * g1.x * s.z, silu_f(bfhi(zz.y)) * g1.y * s.w);
                    *(u32x2*)(cat + (size_t)(row0 + i) * 2048 + col) = o; } } }
    }
}

__device__ __forceinline__ void phase_scan(int wv, PR p, int jl, char* lds) {
    const int tid = tid_of(wv), lane = tid & 63, wave = __builtin_amdgcn_readfirstlane(tid >> 6), fr = lane & 15, fq = lane >> 4;
    const bf16* XT = (const bf16*)(p.ws + WS_ACT + A_XT); const bf16* Bact = (const bf16*)(p.ws + WS_ACT + A_B); const bf16* Cact = (const bf16*)(p.ws + WS_ACT + A_C); const bf16* BT = (const bf16*)(p.ws + WS_ACT + A_BT);
    const float* DT = (const float*)(p.ws + WS_ACT + A_DT); const float* ACS = (const float*)(p.ws + WS_ACT + A_ACS); const float* WW = (const float*)(p.ws + WS_ACT + A_W);
    bf16* yb = (bf16*)(p.ws + WS_O);
    bf16* Cs = (bf16*)lds; bf16* Bs = Cs + 64 * 136; bf16* BTs = Bs + 64 * 136; bf16* XTs = BTs + 128 * 72; bf16* Ms = XTs + 16 * 72; bf16* Sb = Ms + 64 * 72;
    float* DTs = (float*)(Sb + 2 * 16 * 136); float* ACSs = DTs + 64; float* Ws = ACSs + 64;
    constexpr int NITEM = NB * 64 + NSB * 64;
    for (int it = vcu_here(); it < NITEM; it += gridDim.x) {
        int seq, h, pq, ch0, nch; bool samp;
        if (it < NB * 64) { seq = it >> 6; h = (it >> 2) & 15; pq = it & 3; ch0 = seq * 128; nch = 128; samp = false; }
        else { const int r = it - NB * 64; seq = r >> 6; h = (r >> 2) & 15; pq = r & 3; ch0 = NCHP + seq; nch = 1; samp = true; }
        const int g = h >> 3; const float dsk = p.in[I_DSK][jl * 16 + h];
        f32x4 accS = {0.f, 0.f, 0.f, 0.f};
        __syncthreads();
        { float* st = nullptr; if (samp) st = (float*)p.in[I_SSD] + (((size_t)(jl * NSB + seq) * 16 + h) * 64 + 16 * pq) * 128;
#pragma unroll
          for (int e = 0; e < 4; ++e) { if (samp) accS[e] = st[(size_t)(4 * fq + e) * 128 + 16 * wave + fr]; Sb[(4 * fq + e) * 136 + 16 * wave + fr] = (bf16)(cvtpk(accS[e], 0.f) & 0xffffu); } }
        u32x4 rC0, rC1, rB0, rB1, rT0, rT1, rX; float rS = 0.f;
#define SSD_LOAD(ch) do { const size_t cb_ = (size_t)(ch) * 64 * 256 + g * 128; \
        rC0 = *(const u32x4*)(Cact + cb_ + (size_t)(tid >> 4) * 256 + (tid & 15) * 8); rC1 = *(const u32x4*)(Cact + cb_ + (size_t)(32 + (tid >> 4)) * 256 + (tid & 15) * 8); \
        rB0 = *(const u32x4*)(Bact + cb_ + (size_t)(tid >> 4) * 256 + (tid & 15) * 8); rB1 = *(const u32x4*)(Bact + cb_ + (size_t)(32 + (tid >> 4)) * 256 + (tid & 15) * 8); \
        const bf16* bt_ = BT + ((size_t)(ch) * 2 + g) * 128 * 64; rT0 = *(const u32x4*)(bt_ + ((size_t)(tid & 7) * 128 + (tid >> 3)) * 8); rT1 = *(const u32x4*)(bt_ + ((size_t)(tid & 7) * 128 + 64 + (tid >> 3)) * 8); \
        if (tid < 128) rX = *(const u32x4*)(XT + ((((size_t)(ch) * 16 + h) * 8 + (tid & 7)) * 64 + 16 * pq + (tid >> 3)) * 8); \
        else if (tid < 320) { const int k_ = (tid - 128) >> 6; const float* src_ = k_ == 0 ? DT : (k_ == 1 ? ACS : WW); rS = src_[((size_t)(ch) * 16 + h) * 64 + (tid & 63)]; } } while (0)
        SSD_LOAD(ch0);
        for (int c = 0; c < nch; ++c) {
            const int ch = ch0 + c;
            __syncthreads();
            *(u32x4*)(Cs + (tid >> 4) * 136 + (tid & 15) * 8) = rC0; *(u32x4*)(Cs + (32 + (tid >> 4)) * 136 + (tid & 15) * 8) = rC1;
            *(u32x4*)(Bs + (tid >> 4) * 136 + (tid & 15) * 8) = rB0; *(u32x4*)(Bs + (32 + (tid >> 4)) * 136 + (tid & 15) * 8) = rB1;
            *(u32x4*)(BTs + (tid >> 3) * 72 + (tid & 7) * 8) = rT0; *(u32x4*)(BTs + (64 + (tid >> 3)) * 72 + (tid & 7) * 8) = rT1;
            if (tid < 128) *(u32x4*)(XTs + (tid >> 3) * 72 + (tid & 7) * 8) = rX;
            else if (tid < 320) DTs[tid - 128] = rS;
            __syncthreads();
            if (c + 1 < nch) SSD_LOAD(ch + 1);
            { const int lt = wave >> 1, sth = wave & 1;
              f32x4 a0 = {0.f, 0.f, 0.f, 0.f}, a1 = {0.f, 0.f, 0.f, 0.f};
              if (2 * sth <= lt) {
#pragma unroll
                  for (int kk = 0; kk < 4; ++kk) { const bf16x8 yf = *(const bf16x8*)(Cs + (16 * lt + fr) * 136 + 32 * kk + 8 * fq);
                      const bf16x8 x0 = *(const bf16x8*)(Bs + (32 * sth + fr) * 136 + 32 * kk + 8 * fq), x1 = *(const bf16x8*)(Bs + (32 * sth + 16 + fr) * 136 + 32 * kk + 8 * fq);
                      a0 = __builtin_amdgcn_mfma_f32_16x16x32_bf16(x0, yf, a0, 0, 0, 0); a1 = __builtin_amdgcn_mfma_f32_16x16x32_bf16(x1, yf, a1, 0, 0, 0); } }
              const int l = 16 * lt + fr; const float al = ACSs[l];
#pragma unroll
              for (int j = 0; j < 2; ++j) { const int s0 = 32 * sth + 16 * j + 4 * fq; const f32x4 as = *(const f32x4*)(ACSs + s0), ds = *(const f32x4*)(DTs + s0); const f32x4 ga = j ? a1 : a0; float m[4];
#pragma unroll
                  for (int e = 0; e < 4; ++e) m[e] = (s0 + e <= l) ? ga[e] * __expf(al - as[e]) * ds[e] : 0.f;
                  u32x2 o; o.x = cvtpk(m[0], m[1]); o.y = cvtpk(m[2], m[3]); *(u32x2*)(Ms + l * 72 + s0) = o; } }
            { const float dec = __expf(ACSs[63]);
#pragma unroll
              for (int e = 0; e < 4; ++e) accS[e] *= dec;
#pragma unroll
              for (int kk = 0; kk < 2; ++kk) { float xf[8]; unpack8(*(const u32x4*)(XTs + fr * 72 + 32 * kk + 8 * fq), xf);
                  const f32x4 w0 = *(const f32x4*)(Ws + 32 * kk + 8 * fq), w1 = *(const f32x4*)(Ws + 32 * kk + 8 * fq + 4);
                  xf[0] *= w0.x; xf[1] *= w0.y; xf[2] *= w0.z; xf[3] *= w0.w; xf[4] *= w1.x; xf[5] *= w1.y; xf[6] *= w1.z; xf[7] *= w1.w;
                  const u32x4 xw = pack8f(xf); const bf16x8 bfrag = *(const bf16x8*)(BTs + (16 * wave + fr) * 72 + 32 * kk + 8 * fq);
                  accS = __builtin_amdgcn_mfma_f32_16x16x32_bf16(*(const bf16x8*)&xw, bfrag, accS, 0, 0, 0); }
              bf16* sbn = Sb + ((c + 1) & 1) * 16 * 136;
#pragma unroll
              for (int e = 0; e < 4; ++e) sbn[(4 * fq + e) * 136 + 16 * wave + fr] = (bf16)(cvtpk(accS[e], 0.f) & 0xffffu); }
            __syncthreads();
            if (wave < 4) { const bf16* sbc = Sb + (c & 1) * 16 * 136; f32x4 ay = {0.f, 0.f, 0.f, 0.f};
#pragma unroll
                for (int kk = 0; kk < 4; ++kk) ay = __builtin_amdgcn_mfma_f32_16x16x32_bf16(*(const bf16x8*)(sbc + fr * 136 + 32 * kk + 8 * fq), *(const bf16x8*)(Cs + (16 * wave + fr) * 136 + 32 * kk + 8 * fq), ay, 0, 0, 0);
                const float el = __expf(ACSs[16 * wave + fr]);
#pragma unroll
                for (int e = 0; e < 4; ++e) ay[e] *= el;
                ay = __builtin_amdgcn_mfma_f32_16x16x32_bf16(*(const bf16x8*)(XTs + fr * 72 + 8 * fq), *(const bf16x8*)(Ms + (16 * wave + fr) * 72 + 8 * fq), ay, 0, 0, 0);
                if (wave >= 2) ay = __builtin_amdgcn_mfma_f32_16x16x32_bf16(*(const bf16x8*)(XTs + fr * 72 + 32 + 8 * fq), *(const bf16x8*)(Ms + (16 * wave + fr) * 72 + 32 + 8 * fq), ay, 0, 0, 0);
                const int l = 16 * wave + fr;
#pragma unroll
                for (int e = 0; e < 4; ++e) ay[e] += dsk * bf2f(XTs[(4 * fq + e) * 72 + l]);
                if (!samp || l < SSEQ) { const size_t row = samp ? (size_t)TP + seq * SSEQ + l : (size_t)ch * 64 + l;
                    u32x2 o; o.x = cvtpk(ay[0], ay[1]); o.y = cvtpk(ay[2], ay[3]); *(u32x2*)(yb + row * DM + h * 64 + 16 * pq + 4 * fq) = o; } }
        }
#undef SSD_LOAD
        { float* so = p.out + (samp ? O_SS + (((size_t)(jl * NSB + seq) * 16 + h) * 64 + 16 * pq) * 128 : O_SP + (((size_t)(jl * NB + seq) * 16 + h) * 64 + 16 * pq) * 128);
#pragma unroll
          for (int e = 0; e < 4; ++e) so[(size_t)(4 * fq + e) * 128 + 16 * wave + fr] = accS[e]; }
    }
}

__device__ __forceinline__ void phase_gate(int wv, PR p, int jl) {
    const int tid = tid_of(wv), lane = tid & 63, wave = __builtin_amdgcn_readfirstlane(tid >> 6), gw = bid_here() * 8 + wave, NGW = gridDim.x * 8;
    const bf16* proj = (const bf16*)(p.ws + WS_PROJ); const bf16* yb = (const bf16*)(p.ws + WS_O); bf16* cat = (bf16*)(p.ws + WS_CAT);
    const float* gs = p.in[I_GSSD] + (size_t)jl * 1024;
    float gsv[2][8];
#pragma unroll
    for (int gg = 0; gg < 2; ++gg)
#pragma unroll
        for (int e = 0; e < 8; ++e) gsv[gg][e] = gs[gg * 512 + 8 * lane + e];
    for (int row0 = gw; row0 < TT; row0 += 2 * NGW) {
        int rows[2] = {row0, row0 + NGW}; const bool v1 = rows[1] < TT; if (!v1) rows[1] = row0;
        u32x4 yw[2][2], zw[2][2];
#pragma unroll
        for (int k = 0; k < 2; ++k)
#pragma unroll
            for (int gg = 0; gg < 2; ++gg) { const int c = gg * 512 + 8 * lane; yw[k][gg] = *(const u32x4*)(yb + (size_t)rows[k] * DM + c); zw[k][gg] = *(const u32x4*)(proj + (size_t)rows[k] * EVEN_N + 3072 + c); }
#pragma unroll
        for (int k = 0; k < 2; ++k) { if (k == 1 && !v1) break;
#pragma unroll
            for (int gg = 0; gg < 2; ++gg) { const int c = gg * 512 + 8 * lane; float y[8], z[8]; unpack8(yw[k][gg], y); unpack8(zw[k][gg], z);
                float ss = 0.f;
#pragma unroll
                for (int e = 0; e < 8; ++e) { y[e] *= silu_f(z[e]); ss += y[e] * y[e]; }
                const float r = rsqrtf(wave_sum(ss) * (1.f / 512.f) + EPS);
#pragma unroll
                for (int e = 0; e < 8; ++e) y[e] = y[e] * r * gsv[gg][e];
                *(u32x4*)(cat + (size_t)rows[k] * 2048 + 1024 + c) = pack8f(y); } }
    }
}

template <int PER, bool SAMP> __device__ __forceinline__ void cumsum_item(PR p, int jl, int bh, int tid, int lane, int wave, float* wsum, const float* flog, const float* bfg) {
    constexpr float INV_SCALE = 11.313708498984761f; constexpr int n = SAMP ? PAST + SSEQ : SEQ, tot = SAMP ? SKS : SEQ;
    const int b = bh >> 3, h = bh & 7, e0 = tid * PER; const float bfh = bfg[h];
    float lf[PER]; float sum = 0.f;
#pragma unroll
    for (int i = 0; i < PER; ++i) { const int e = e0 + i; float v = 0.f;
        if (e < n) { if (SAMP) v = (e < PAST) ? p.in[I_CLF][(((size_t)jl * NSB + b) * PAST + e) * 8 + h] : logsigmoid_f(flog[(size_t)(TP + b * SSEQ + e - PAST) * 8 + h] + bfh);
                     else v = logsigmoid_f(flog[(size_t)(b * SEQ + e) * 8 + h] + bfh); }
        if (e < n && (!SAMP || e >= PAST)) p.out[SAMP ? O_LS + ((size_t)jl * TS + b * SSEQ + (e - PAST)) * 8 + h : O_LP + ((size_t)jl * TP + b * SEQ + e) * 8 + h] = v;
        sum += v; lf[i] = sum; }
    float incl = sum;
#pragma unroll
    for (int o = 1; o < 64; o <<= 1) { const float t = __shfl_up(incl, o); if (lane >= o) incl += t; }
    __syncthreads();
    if (lane == 63) wsum[wave] = incl;
    __syncthreads();
    float off = incl - sum;
#pragma unroll
    for (int w8 = 0; w8 < 8; ++w8) off += (w8 < wave) ? wsum[w8] : 0.f;
    float* dst = (float*)(p.ws + (SAMP ? WS_NFS : WS_NFP)) + (size_t)bh * tot;
#pragma unroll
    for (int i = 0; i < PER; ++i) { const int e = e0 + i; if (e < tot) dst[e] = (e < n) ? -(off + lf[i]) * INV_SCALE : 0.f; }
}
__device__ __forceinline__ void phase_qk_cache(int wv, PR p, int jl, int first) {
    const int tid = tid_of(wv), lane = tid & 63, wave = __builtin_amdgcn_readfirstlane(tid >> 6); const int bid = bid_here(); if (bid < first) return;
    const int gw = (bid - first) * 8 + wave, NGW = ((int)gridDim.x - first) * 8;
    bf16* Ks = (bf16*)(p.ws + WS_KS); bf16* Vs = (bf16*)(p.ws + WS_VS);
    { const int NR = 2 * NSB * (PAST + 32), per = (NR + NGW - 1) / NGW, r0 = gw * per, r1 = (r0 + per < NR) ? r0 + per : NR;
      float mx = 0.f; int curb = -1;
      for (int r = r0; r < r1; ++r) { const int which = r / (NSB * (PAST + 32)), rr = r - which * (NSB * (PAST + 32)), b = rr / (PAST + 32), t = rr - b * (PAST + 32);
          if (b != curb) { if (curb >= 0 && (lane & 7) == 0) atomicMax((unsigned*)(p.ws + WS_KMAX) + jl * 128 + curb * 8 + (lane >> 3), __float_as_uint(mx)); mx = 0.f; curb = b; }
          bf16* dst = (which ? Vs : Ks) + ((size_t)b * SKS + (t < PAST ? t : t + 32)) * DM + 16 * lane;
          if (t < PAST) { const float* src = p.in[which ? I_CV : I_CK] + (((size_t)jl * NSB + b) * PAST + t) * DM + 16 * lane; float f[16];
#pragma unroll
              for (int e = 0; e < 16; e += 4) { const f32x4 v = *(const f32x4*)(src + e); f[e] = v.x; f[e + 1] = v.y; f[e + 2] = v.z; f[e + 3] = v.w; }
              if (which == 0) { float ss = 0.f;
#pragma unroll
                  for (int e = 0; e < 16; ++e) ss += f[e] * f[e];
                  ss += __shfl_xor(ss, 1); ss += __shfl_xor(ss, 2); ss += __shfl_xor(ss, 4); mx = fmaxf(mx, ss); }
              *(u32x4*)dst = pack8f(f); *(u32x4*)(dst + 8) = pack8f(f + 8); }
          else { *(u32x4*)dst = (u32x4){0u, 0u, 0u, 0u}; *(u32x4*)(dst + 8) = (u32x4){0u, 0u, 0u, 0u}; } }
      if (curb >= 0 && (lane & 7) == 0) atomicMax((unsigned*)(p.ws + WS_KMAX) + jl * 128 + curb * 8 + (lane >> 3), __float_as_uint(mx)); }
}
__device__ __forceinline__ void phase_qk_cumsum(int wv, PR p, int jl, char* lds) {
    const int tid = tid_of(wv), lane = tid & 63, wave = __builtin_amdgcn_readfirstlane(tid >> 6), gw = bid_here() * 8 + wave, NGW = gridDim.x * 8;
    const float* flog = (const float*)(p.ws + WS_FLOG); const float* bfg = p.in[I_BF] + jl * 8;
    { float* wsum = (float*)lds;
      for (int it = bid_here(); it < NB * 8; it += gridDim.x) cumsum_item<16, false>(p, jl, it, tid, lane, wave, wsum, flog, bfg);
      for (int it = (int)gridDim.x - 1 - bid_here(); it < NSB * 8; it += gridDim.x) cumsum_item<5, true>(p, jl, it, tid, lane, wave, wsum, flog, bfg); }
}

template <class PRT> __device__ __forceinline__ fa::BlockRef attn_ref(PRT p, int id, int jl, float traw_p, float qkb, float knew) {
    const bf16* proj = (const bf16*)(p.ws + WS_PROJ); bf16* yc = (bf16*)(p.ws + WS_CAT);
    fa::BlockRef r;
    if (id < 1024) { const int bh = id >> 5, qb = id & 31, b = bh >> 3, h = bh & 7; const size_t rq = (size_t)b * SEQ + qb * 256;
        r.Q = proj + rq * ODD_N + h * 128; r.K = proj + (size_t)b * SEQ * ODD_N + 1024 + h * 128; r.V = r.K + 1024; r.Bias = (const float*)(p.ws + WS_NFP) + (size_t)bh * SEQ;
        r.O = yc + rq * DM + h * 128; r.Z = proj + rq * ODD_N + 3072 + h * 128; r.P0 = qb * 256; r.qpitch = ODD_N; r.kvpitch = ODD_N; r.nvalid = 256; r.skv = SEQ; r.canskip = 1; r.traw = traw_p; }
    else { const int bh = id - 1024, b = bh >> 3, h = bh & 7; const size_t rq = (size_t)TP + b * SSEQ;
        r.Q = proj + rq * ODD_N + h * 128; r.K = (const bf16*)(p.ws + WS_KS) + (size_t)b * SKS * DM + h * 128; r.V = (const bf16*)(p.ws + WS_VS) + (size_t)b * SKS * DM + h * 128;
        r.Bias = (const float*)(p.ws + WS_NFS) + (size_t)bh * SKS; r.O = yc + rq * DM + h * 128; r.Z = proj + rq * ODD_N + 3072 + h * 128; r.P0 = PAST; r.qpitch = ODD_N; r.kvpitch = DM; r.nvalid = SSEQ; r.skv = SKS; r.canskip = 1;
        { const float kc = sqrtf(__uint_as_float(((const unsigned*)(p.ws + WS_KMAX))[jl * 128 + bh])) * 1.01f; const float kb = fmaxf(kc, knew);
          r.traw = (2.f * (qkb * kb) + 30.f) * 11.313708f; } }
    return r;
}
__device__ __forceinline__ int attn_item(int w, int G, int i) {
    if (G == 256) { if (w < 128) { if (i == 0) return 1024 + w; return i < 5 ? 4 * w + (i - 1) : -1; } return i < 4 ? 512 + 4 * (w - 128) + i : -1; }
    const int id = w + i * G; return id < 1152 ? id : -1;
}
__device__ __forceinline__ void phase_attn(int wv, PR p, int jl, char* lds) {
    const int w = vcu_here(), G = gridDim.x;
    int i = 0, id = attn_item(w, G, 0); if (id < 0) return;
    float traw, qkb, knew;
    { const int lane = tid_of(wv) & 63; const float* gq = p.in[I_GQ] + jl * 128; const float* gk = p.in[I_GK] + jl * 128;
      float mq = fmaxf(fabsf(gq[lane]), fabsf(gq[lane + 64])), mk = fmaxf(fabsf(gk[lane]), fabsf(gk[lane + 64]));
#pragma unroll
      for (int o = 1; o < 64; o <<= 1) { mq = fmaxf(mq, __shfl_xor(mq, o)); mk = fmaxf(mk, __shfl_xor(mk, o)); }
      const float B = 11.313708f * 1.02f * mq * mk; traw = __int_as_float(__builtin_amdgcn_readfirstlane(__float_as_int((2.f * B + 30.f) * 11.313708f)));
      qkb = __int_as_float(__builtin_amdgcn_readfirstlane(__float_as_int(11.313708f * 1.01f * mq * 0.08838834764831845f)));
      knew = __int_as_float(__builtin_amdgcn_readfirstlane(__float_as_int(11.313708f * 1.01f * mk))); }
    fa::Seam S; int jlo;
    { const fa::BlockRef cur = attn_ref<PR>(p, id, jl, traw, qkb, knew); jlo = fa::fox_jlo(cur, tid_of(wv) & 63); fa::fox_prime(cur, lds, S, wv, jlo); }
    for (;;) {
        int idn = attn_item(w, G, i + 1); const bool last = idn < 0; if (last) idn = id;
        int jlon = 0;
        fa::fox_block<PR>(p, id, jl, idn, jl, lds, S, wv, jlo, jlon, traw, qkb, knew);
        if (last) break;
        id = idn; jlo = jlon; ++i;
    }
}
#define LAS __attribute__((address_space(3)))
#define XB_TMO      128
#define XB_XCNT(j)  (256  + 64 * (j))
#define XB_XSUB(j)  (1280 + 64 * (j))
#define XB_XGEN(j)  (2304 + 64 * (j))
#define XB_TOP      3328
#define XB_TOPGEN   3392
#define XCD_BAR_WORDS 3456
#define XB_SPIN_CAP (1u << 18)

__device__ __forceinline__ unsigned xb_ld(unsigned* p)              { return __hip_atomic_load(p, __ATOMIC_RELAXED, __HIP_MEMORY_SCOPE_AGENT); }
__device__ __forceinline__ unsigned xb_add(unsigned* p, unsigned v) { return __hip_atomic_fetch_add(p, v, __ATOMIC_RELAXED, __HIP_MEMORY_SCOPE_AGENT); }
__device__ __forceinline__ unsigned xb_xcc_id() { return (unsigned)__builtin_amdgcn_s_getreg((3 << 11) | 20) & 0xFu; }
#define XB_SPIN(cond, bar) do { unsigned _sp = 0; while (cond) { __builtin_amdgcn_s_sleep(1); \
    if ((++_sp & 255u) == 0u) { if (xb_ld(&(bar)[XB_TMO])) break; if (_sp > XB_SPIN_CAP) { atomicAdd(&(bar)[XB_TMO], 1u); break; } } } } while (0)

struct XcdBarrier {
    unsigned* bar; unsigned x;
    volatile LAS unsigned* st;
};

__device__ __forceinline__ XcdBarrier xcd_barrier_post(unsigned* bar, volatile LAS unsigned* st, int xb_tid) {
    XcdBarrier b; b.bar = bar; b.x = xb_xcc_id(); b.st = st;
    if (xb_tid == 0) (void)xb_add(&bar[XB_XCNT(b.x)], 1u);
    return b;
}
__device__ __forceinline__ void xcd_barrier_complete(unsigned* bar, unsigned x, unsigned& nloc, unsigned& nx) {
    const unsigned G = gridDim.x * gridDim.y * gridDim.z;
    unsigned sum, cnt, mine, sp = 0u;
    for (;;) {
        sum = 0u; cnt = 0u; mine = 0u;
#pragma unroll
        for (unsigned j = 0; j < 16; ++j) { const unsigned c = xb_ld(&bar[XB_XCNT(j)]); sum += c; cnt += (c > 0u) ? 1u : 0u; mine = (j == x) ? c : mine; }
        if (sum == G) break;
        __builtin_amdgcn_s_sleep(1);
        if ((++sp & 255u) == 0u) { if (xb_ld(&bar[XB_TMO])) break; if (sp > XB_SPIN_CAP) { atomicAdd(&bar[XB_TMO], 1u); break; } }
    }
    nloc = mine > 0u ? mine : 1u; nx = cnt > 0u ? cnt : 1u;
}

__device__ __forceinline__ void xcd_barrier(const XcdBarrier& b, int wv_) {
    const int xb_tid = tid_of(wv_);
    asm volatile("s_waitcnt vmcnt(0)" ::: "memory");
    __syncthreads();
    if (xb_tid == 0) {
        unsigned* bar = b.bar;
        __builtin_amdgcn_s_waitcnt(0);
        unsigned nloc = b.st[0], nx = b.st[1];
        if (nloc == 0u) { xcd_barrier_complete(bar, b.x, nloc, nx); b.st[0] = nloc; b.st[1] = nx; }
        const unsigned old = xb_add(&bar[XB_XSUB(b.x)], 1u);
        const unsigned gen = old / nloc;
        if (old + 1u == (gen + 1u) * nloc) {
            __builtin_amdgcn_fence(__ATOMIC_RELEASE, "agent");
            asm volatile("s_waitcnt vmcnt(0)" ::: "memory");
            const unsigned og = xb_add(&bar[XB_TOP], 1u);
            const unsigned tg = og / nx;
            if (og + 1u == (tg + 1u) * nx) xb_add(&bar[XB_TOPGEN], 1u);
            else XB_SPIN(xb_ld(&bar[XB_TOPGEN]) == tg, bar);
            __builtin_amdgcn_fence(__ATOMIC_ACQUIRE, "agent");
            xb_add(&bar[XB_XGEN(b.x)], 1u);
            asm volatile("s_waitcnt vmcnt(0)" ::: "memory");
        } else {
            XB_SPIN(xb_ld(&bar[XB_XGEN(b.x)]) == gen, bar);
            __builtin_amdgcn_fence(__ATOMIC_ACQUIRE, "agent");
            asm volatile("s_waitcnt vmcnt(0)" ::: "memory");
        }
    }
    __syncthreads();
}
#ifndef PH_MASK
#define PH_MASK 0xFFFF
#endif
#ifndef DUP_MASK
#define DUP_MASK 0
#endif
#define PH(b) for (int rep_ = 0; rep_ < ((DUP_MASK >> (b)) & 1) + 1; ++rep_) if (PH_MASK & (1 << (b)))
#define PHX(b) PH(b)
template <int MODE> __device__ __forceinline__ void run_gemm(int wv, char* lds, PR p, const bf16* A, const bf16* Bt, int N, int K, int jl) {
    pg8::Gemm g{A, Bt, TT, N, K}; pg8::StaticOrder S; S.init(TT, N, (int)gridDim.x, bid_here());
    EpiProj<MODE> E{p.ws, p.out, MODE == 2 ? p.in[I_GQ] + jl * 128 : nullptr, MODE == 2 ? p.in[I_GK] + jl * 128 : nullptr, (float*)(lds + 131072 + 1024), jl};
    pg8::gemm_phase<EpiProj<MODE>, pg8::StaticOrder, true, true>((PG8_LAS unsigned char*)lds, g, S, E, wv);
}

template <int jl> __device__ __forceinline__ void layer_pair(int wv, char* lds, const XcdBarrier& xb) {
        PHX(2) { PR p = *params_here(); run_gemm<1>(wv, lds, p, (const bf16*)(p.ws + WS_H), (const bf16*)(p.ws + WS_WINE) + (size_t)jl * EVEN_NP * 1024, EVEN_NP, 1024, jl); }
        xcd_barrier(xb, wv);
        PHX(3) { PR p = *params_here(); phase_conv(wv, p, jl); }
        PHX(4) { PR p = *params_here(); phase_gmlp(wv, p, jl, lds); }
        xcd_barrier(xb, wv);
        PHX(5) { PR p = *params_here(); phase_scan(wv, p, jl, lds); }
        xcd_barrier(xb, wv);
        PHX(6) { PR p = *params_here(); phase_gate(wv, p, jl); }
        xcd_barrier(xb, wv);
        PHX(7) { PR p = *params_here(); run_gemm<0>(wv, lds, p, (const bf16*)(p.ws + WS_CAT), (const bf16*)(p.ws + WS_WOUTE) + (size_t)jl * 1024 * 2048, 1024, 2048, jl); }
        PHX(14) { PR p = *params_here(); const int G_ = (int)gridDim.x, nu_ = (TT / 256) * 4; phase_qk_cache(wv, p, jl, (nu_ > 2 * G_ && nu_ < 3 * G_) ? nu_ - 2 * G_ : 0); }
        xcd_barrier(xb, wv);
        PHX(8) { PR p = *params_here(); phase_norm(wv, p, 2 * jl + 1); }
        xcd_barrier(xb, wv);
        PHX(9) { PR p = *params_here(); run_gemm<2>(wv, lds, p, (const bf16*)(p.ws + WS_H), (const bf16*)(p.ws + WS_WINO) + (size_t)jl * ODD_NP * 1024, ODD_NP, 1024, jl); }
        xcd_barrier(xb, wv);
        PHX(10) { { PR p = *params_here(); phase_qk_cumsum(wv, p, jl, lds); } }
        xcd_barrier(xb, wv);
        PHX(11) { PR p = *params_here(); phase_attn(wv, p, jl, lds); }
        xcd_barrier(xb, wv);
        PHX(12) { PR p = *params_here(); run_gemm<0>(wv, lds, p, (const bf16*)(p.ws + WS_CAT), (const bf16*)(p.ws + WS_WOUTO) + (size_t)jl * 1024 * 1024, 1024, 1024, jl); }
        xcd_barrier(xb, wv);
        PHX(13) { PR p = *params_here(); phase_norm(wv, p, 2 * jl + 2); }
        if (jl == 0) xcd_barrier(xb, wv);
}

__global__ void __launch_bounds__(512, 2) hybrid_fwd(Params p_unused) {
    extern __shared__ __attribute__((aligned(16))) unsigned char lds_raw[];
    char* lds = (char*)lds_raw;
    cg::grid_group grid = cg::this_grid();
    const int wv = __builtin_amdgcn_readfirstlane((int)threadIdx.x >> 6);
    volatile LAS unsigned* xst = (volatile LAS unsigned*)((LAS unsigned char*)lds_raw + 131072 + 64);
    if (threadIdx.x < 2) xst[threadIdx.x] = 0u;
    __syncthreads();
    const XcdBarrier xb = xcd_barrier_post((unsigned*)(p_unused.ws + WS_BAR), xst, (int)threadIdx.x);

    PH(0) { PR p = *params_here(); phase_prologue(wv, p, lds); }
    PH(1) { PR p = *params_here(); phase_norm(wv, p, 0); }
    if (p_unused.out == nullptr) grid.sync();
    xcd_barrier(xb, wv);
    layer_pair<0>(wv, lds, xb);
    layer_pair<1>(wv, lds, xb);
}

extern "C" void kernel_launch(void* const* d_in, const int* in_sizes, int n_in, void* d_out, int out_size, void* d_ws, size_t ws_size, hipStream_t stream) {
    static int grid = 0;
    if (grid == 0) {
        if (n_in != 25 || (size_t)out_size != O_END || ws_size < WS_END) {
            fprintf(stderr, "kernel_launch: unexpected shapes: n_in %d out %d (want %zu) ws %zu (need %zu)\n", n_in, out_size, (size_t)O_END, ws_size, (size_t)WS_END);
            grid = -1; return; }
        int dev = 0, cus = 0, per_cu = 0;
        (void)hipGetDevice(&dev);
        (void)hipDeviceGetAttribute(&cus, hipDeviceAttributeMultiprocessorCount, dev);
        if (hipFuncSetAttribute((const void*)hybrid_fwd, hipFuncAttributeMaxDynamicSharedMemorySize, LDS_BYTES) != hipSuccess) fprintf(stderr, "kernel_launch: hipFuncSetAttribute failed\n");
        if (hipOccupancyMaxActiveBlocksPerMultiprocessor(&per_cu, (const void*)hybrid_fwd, 512, LDS_BYTES) != hipSuccess || per_cu < 1) { fprintf(stderr, "kernel_launch: occupancy query gave %d\n", per_cu); per_cu = 1; }
        (void)hipGetLastError();
        if (cus <= 0) cus = 256;
        grid = cus;
    }
    if (grid < 0) return;
    (void)hipMemsetAsync((char*)d_ws + WS_BAR, 0, 65536, stream);
    Params p{};
    for (int i = 0; i < 25; ++i) p.in[i] = (const float*)d_in[i];
    p.out = (float*)d_out; p.ws = (unsigned char*)d_ws;
    void* args[] = {&p};
    hipError_t e = hipLaunchCooperativeKernel((const void*)hybrid_fwd, dim3(grid), dim3(512), args, LDS_BYTES, stream);
    if (e != hipSuccess) fprintf(stderr, "kernel_launch: cooperative launch failed: %s (grid %d)\n", hipGetErrorString(e), grid);
}
```
